# Optimizing an MI355X kernel written in HIP

```python
import jax, jax.numpy as jnp
from jax import lax
import numpy as np

D_MODEL = 1024
BATCH = 8
SEQ = 4096
DEPTH = 1

GRID_W = 64
CTX_LEN = 256
N_MOD = 6
EPS = 1e-6
MLA_HEADS = 4
MLA_Q_RANK = 256
MLA_KV_RANK = 128
MLA_NOPE = 128
MLA_ROPE = 64
MLA_V = 128
MLA_QK = MLA_NOPE + MLA_ROPE
ROPE_AXIS = MLA_ROPE // 2
ROPE_BASE = 10000.0
Q_BLOCK = 128
ML_HEADS = 4
ML_QK = 64
ML_V = 128
ML_CHUNK = 64
CONV_W = 3
FGATE_BIAS_LO = 3.0
FGATE_BIAS_HI = 6.0
MLA_COLS = MLA_Q_RANK + MLA_KV_RANK + MLA_ROPE
ML_COLS = 2 * ML_HEADS * ML_QK + 2 * ML_HEADS * ML_V + 4 * ML_HEADS
IN_COLS = MLA_COLS + ML_COLS
MIX_WIDTH = MLA_HEADS * MLA_V + ML_HEADS * ML_V
PEER_HEADS = 8
N_KEYS = 128
N_EXPERTS = N_KEYS * N_KEYS
PEER_DK = 256
PEER_DKH = PEER_DK // 2
PEER_TOPK = 16
PEER_BLOCK = 128

kernel_name = 'hybrid_mla_mlstm_peer_dit_block'


def rmsnorm(x, g):
    xf = x.astype(jnp.float32)
    y = xf * lax.rsqrt(jnp.mean(xf * xf, axis=-1, keepdims=True) + EPS)
    return (y * g.astype(jnp.float32)).astype(x.dtype)


def rope_tables(rows):
    row = jnp.repeat(jnp.arange(rows, dtype=jnp.float32), GRID_W)
    col = jnp.tile(jnp.arange(GRID_W, dtype=jnp.float32), rows)
    inv = ROPE_BASE ** (-jnp.arange(ROPE_AXIS // 2, dtype=jnp.float32) * (2.0 / ROPE_AXIS))
    ang_r = row[:, None] * inv
    ang_c = col[:, None] * inv
    return (jnp.cos(ang_r), jnp.sin(ang_r), jnp.cos(ang_c), jnp.sin(ang_c))


def rotate(t, cos, sin):
    half = t.shape[-1] // 2
    t1, t2 = t[..., :half], t[..., half:]
    cos = cos.astype(t.dtype)
    sin = sin.astype(t.dtype)
    return jnp.concatenate([t1 * cos - t2 * sin, t2 * cos + t1 * sin], axis=-1)


def apply_rope2d(t, rope):
    cos_r, sin_r, cos_c, sin_c = rope
    t_row = rotate(t[..., MLA_NOPE:MLA_NOPE + ROPE_AXIS], cos_r, sin_r)
    t_col = rotate(t[..., MLA_NOPE + ROPE_AXIS:], cos_c, sin_c)
    return jnp.concatenate([t[..., :MLA_NOPE], t_row, t_col], axis=-1)


def split_heads(t, n_heads):
    b, n, _ = t.shape
    return t.reshape(b, n, n_heads, -1).transpose(0, 2, 1, 3)


def merge_heads(t):
    b, h, n, d = t.shape
    return t.transpose(0, 2, 1, 3).reshape(b, n, h * d)


def mla_prep(cols, g_cq, w_uq, g_ckv, w_ukv, g_qn, g_kn, rope):
    b, n, _ = cols.shape
    c_q = cols[..., :MLA_Q_RANK]
    c_kv = cols[..., MLA_Q_RANK:MLA_Q_RANK + MLA_KV_RANK]
    k_rope = cols[..., MLA_Q_RANK + MLA_KV_RANK:]
    q = (rmsnorm(c_q, g_cq) @ w_uq).reshape(b, n, MLA_HEADS, MLA_QK)
    kv = (rmsnorm(c_kv, g_ckv) @ w_ukv).reshape(b, n, MLA_HEADS, MLA_NOPE + MLA_V)
    k = jnp.concatenate([kv[..., :MLA_NOPE],
                         jnp.broadcast_to(k_rope[:, :, None, :], (b, n, MLA_HEADS, MLA_ROPE))], axis=-1)
    v = kv[..., MLA_NOPE:].transpose(0, 2, 1, 3)
    q = rmsnorm(q, g_qn).transpose(0, 2, 1, 3)
    k = rmsnorm(k, g_kn).transpose(0, 2, 1, 3)
    if rope is not None:
        q = apply_rope2d(q, rope)
        k = apply_rope2d(k, rope)
    return q, k, v


def attend(q, k, v):
    s = jnp.einsum('bhqd,bhkd->bhqk', q, k).astype(jnp.float32) * (MLA_QK ** -0.5)
    p = jax.nn.softmax(s, axis=-1).astype(v.dtype)
    return jnp.einsum('bhqk,bhkd->bhqd', p, v)


def attend_blocked(q, k, v):
    b, h, n, dk = q.shape
    nb = n // Q_BLOCK
    qb = jnp.moveaxis(q.reshape(b, h, nb, Q_BLOCK, dk), 2, 0)
    ob = lax.map(lambda q_blk: attend(q_blk, k, v), qb)
    return jnp.moveaxis(ob, 0, 2).reshape(b, h, n, -1)


def mla_mixer(cols_lat, cols_ctx, g_cq, w_uq, g_ckv, w_ukv, g_qn, g_kn, rope, need_ctx_out):
    q_l, k_l, v_l = mla_prep(cols_lat, g_cq, w_uq, g_ckv, w_ukv, g_qn, g_kn, rope)
    q_c, k_c, v_c = mla_prep(cols_ctx, g_cq, w_uq, g_ckv, w_ukv, g_qn, g_kn, None)
    k_all = jnp.concatenate([k_c, k_l], axis=2)
    v_all = jnp.concatenate([v_c, v_l], axis=2)
    out_lat = merge_heads(attend_blocked(q_l, k_all, v_all))
    out_ctx = merge_heads(attend(q_c, k_c, v_c)) if need_ctx_out else None
    return out_lat, out_ctx


def centred_conv(u, w):
    k = w.shape[0]
    p = k // 2
    n = u.shape[1]
    up = jnp.pad(u, ((0, 0), (p, p), (0, 0)))
    return sum(up[:, j:j + n] * w[j] for j in range(k))


def mlstm_prep(cols, conv_w, b_i, b_f):
    b, n, _ = cols.shape
    n_qk = ML_HEADS * ML_QK
    n_v = ML_HEADS * ML_V
    qk = jax.nn.silu(centred_conv(cols[..., :2 * n_qk], conv_w))
    q = split_heads(qk[..., :n_qk], ML_HEADS).astype(jnp.float32) * (ML_QK ** -0.5)
    k = split_heads(qk[..., n_qk:], ML_HEADS).astype(jnp.float32)
    v = split_heads(cols[..., 2 * n_qk:2 * n_qk + n_v], ML_HEADS).astype(jnp.float32)
    o = cols[..., 2 * n_qk + n_v:2 * n_qk + 2 * n_v]
    gates = cols[..., 2 * n_qk + 2 * n_v:].astype(jnp.float32).reshape(b, n, 2, 2, ML_HEADS)
    ig = (gates[:, :, 0] + b_i.astype(jnp.float32)).transpose(2, 0, 3, 1)
    lf = jax.nn.log_sigmoid(gates[:, :, 1] + b_f.astype(jnp.float32)).transpose(2, 0, 3, 1)
    return q, k, v, o, ig, lf


def mlstm_scan(q, k, v, ig, lf, state, need_out):
    b, h, n_tok, _ = q.shape
    nc = n_tok // ML_CHUNK

    def chunks(a):
        return jnp.moveaxis(a.reshape(a.shape[:2] + (nc, ML_CHUNK) + a.shape[3:]), 2, 0)

    tri = jnp.tril(jnp.ones((ML_CHUNK, ML_CHUNK), dtype=bool))

    def body(carry, inp):
        c_mat, n_vec, m_prev = carry
        qc, kc, vc, ic, fc = inp
        cum_f = jnp.cumsum(fc, axis=-1)
        dmat = jnp.where(tri, cum_f[..., :, None] - cum_f[..., None, :] + ic[..., None, :], -jnp.inf)
        inter = cum_f + m_prev[..., None]
        m_t = jnp.maximum(inter, jnp.max(dmat, axis=-1))
        m_new = m_t[..., -1]
        w_s = jnp.exp(dmat[..., -1, :] - m_new[..., None])
        decay = jnp.exp(inter[..., -1] - m_new)
        c_new = decay[..., None, None] * c_mat + jnp.einsum('bhs,bhsv,bhsd->bhvd', w_s, vc, kc)
        n_new = decay[..., None] * n_vec + jnp.einsum('bhs,bhsd->bhd', w_s, kc)
        if not need_out:
            return (c_new, n_new, m_new), None
        wmat = jnp.exp(dmat - m_t[..., None]) * jnp.einsum('bhtd,bhsd->bhts', qc, kc)
        scale_inter = jnp.exp(inter - m_t)
        num = jnp.einsum('bhts,bhsv->bhtv', wmat, vc) + scale_inter[..., None] * jnp.einsum('bhvd,bhtd->bhtv', c_mat, qc)
        den = jnp.sum(wmat, axis=-1) + scale_inter * jnp.einsum('bhd,bhtd->bht', n_vec, qc)
        h_out = num / jnp.maximum(jnp.abs(den), jnp.exp(-m_t))[..., None]
        return (c_new, n_new, m_new), h_out

    state, hs = lax.scan(body, state, (chunks(q), chunks(k), chunks(v), chunks(ig), chunks(lf)))
    h_seq = jnp.moveaxis(hs, 0, 2).reshape(b, h, n_tok, -1) if need_out else None
    return state, h_seq


def mlstm_output(h_sum, o, g_out):
    b, h, n, dv = h_sum.shape
    hn = rmsnorm(h_sum.transpose(0, 2, 1, 3), g_out.reshape(h, dv)).reshape(b, n, h * dv)
    return (jax.nn.sigmoid(o.astype(jnp.float32)) * hn).astype(o.dtype)


def mlstm_mixer(cols_lat, cols_ctx, conv_w, b_i, b_f, g_out, need_ctx_out):
    q_l, k_l, v_l, o_l, ig_l, lf_l = mlstm_prep(cols_lat, conv_w, b_i, b_f)
    q_c, k_c, v_c, o_c, ig_c, lf_c = mlstm_prep(cols_ctx, conv_w, b_i, b_f)
    b = q_l.shape[0]
    outs_lat, outs_ctx = [], []
    for d in range(2):
        rev = d == 1

        def fl(a):
            return jnp.flip(a, axis=2) if rev else a

        state0 = (jnp.zeros((b, ML_HEADS, ML_V, ML_QK), jnp.float32),
                  jnp.zeros((b, ML_HEADS, ML_QK), jnp.float32),
                  jnp.zeros((b, ML_HEADS), jnp.float32))
        st_ctx, h_c = mlstm_scan(fl(q_c), fl(k_c), fl(v_c), fl(ig_c[d]), fl(lf_c[d]), state0, need_ctx_out)
        _, h_l = mlstm_scan(fl(q_l), fl(k_l), fl(v_l), fl(ig_l[d]), fl(lf_l[d]), st_ctx, True)
        outs_lat.append(fl(h_l))
        if need_ctx_out:
            outs_ctx.append(fl(h_c))
    out_lat = mlstm_output(outs_lat[0] + outs_lat[1], o_l, g_out)
    out_ctx = mlstm_output(outs_ctx[0] + outs_ctx[1], o_c, g_out) if need_ctx_out else None
    return out_lat, out_ctx


def peer(h, w_pq, sub_keys, expert_u, expert_v):
    b, n, d = h.shape
    xb_all = h.reshape(-1, PEER_BLOCK, d)

    def one(xb):
        q = (xb @ w_pq).reshape(PEER_BLOCK, PEER_HEADS, 2, PEER_DKH)
        s = jnp.einsum('thpd,hpkd->thpk', q, sub_keys).astype(jnp.float32)
        sv, si = lax.top_k(s, PEER_TOPK)
        cand = (sv[:, :, 0, :, None] + sv[:, :, 1, None, :]).reshape(PEER_BLOCK, PEER_HEADS, -1)
        cidx = (si[:, :, 0, :, None] * N_KEYS + si[:, :, 1, None, :]).reshape(PEER_BLOCK, PEER_HEADS, -1)
        best, pos = lax.top_k(cand, PEER_TOPK)
        eidx = jnp.take_along_axis(cidx, pos, axis=-1)
        g = jax.nn.softmax(best, axis=-1)
        act = jax.nn.gelu(jnp.einsum('thkd,td->thk', expert_u[eidx], xb).astype(jnp.float32), approximate=False)
        return jnp.einsum('thk,thkd->td', (g * act).astype(xb.dtype), expert_v[eidx])

    return lax.map(one, xb_all).reshape(b, n, d)


def setup_inputs(seed: int = 0) -> dict:
    key = jax.random.key(seed)
    ks = jax.random.split(key, 24)

    def nrm(k, shape, s):
        return jax.random.normal(k, shape, jnp.float32) * s

    def gain(k, shape):
        return 1.0 + nrm(k, shape, 0.01)

    D, L = D_MODEL, DEPTH
    fgate = jnp.linspace(FGATE_BIAS_LO, FGATE_BIAS_HI, ML_HEADS, dtype=jnp.float32)
    return {
        'x': nrm(ks[0], (BATCH, SEQ, D), 1.0),
        'c': nrm(ks[1], (BATCH, D), 1.0),
        'ctx': nrm(ks[2], (BATCH, CTX_LEN, D), 1.0),
        'c_ctx': nrm(ks[3], (D,), 1.0),
        'w_ada': nrm(ks[4], (L, D, N_MOD * D), 0.5 * D ** -0.5),
        'b_ada': nrm(ks[5], (L, N_MOD * D), 0.01),
        'g_norm1': gain(ks[6], (L, D)),
        'w_in': nrm(ks[7], (L, D, IN_COLS), D ** -0.5),
        'g_cq': gain(ks[8], (L, MLA_Q_RANK)),
        'w_uq': nrm(ks[9], (L, MLA_Q_RANK, MLA_HEADS * MLA_QK), MLA_Q_RANK ** -0.5),
        'g_ckv': gain(ks[10], (L, MLA_KV_RANK)),
        'w_ukv': nrm(ks[11], (L, MLA_KV_RANK, MLA_HEADS * (MLA_NOPE + MLA_V)), MLA_KV_RANK ** -0.5),
        'g_qn': gain(ks[12], (L, MLA_QK)),
        'g_kn': gain(ks[13], (L, MLA_QK)),
        'conv_qk': nrm(ks[14], (L, CONV_W, 2 * ML_HEADS * ML_QK), CONV_W ** -0.5),
        'b_igate': nrm(ks[15], (L, 2, ML_HEADS), 0.01),
        'b_fgate': fgate[None, None, :] + nrm(ks[16], (L, 2, ML_HEADS), 0.01),
        'g_mlstm': gain(ks[17], (L, ML_HEADS * ML_V)),
        'w_out': nrm(ks[18], (L, MIX_WIDTH, D), MIX_WIDTH ** -0.5),
        'g_norm2': gain(ks[19], (L, D)),
        'w_pq': nrm(ks[20], (L, D, PEER_HEADS * PEER_DK), D ** -0.5),
        'sub_keys': nrm(ks[21], (L, PEER_HEADS, 2, N_KEYS, PEER_DKH), PEER_DKH ** -0.5),
        'expert_u': nrm(ks[22], (L, N_EXPERTS, D), D ** -0.5),
        'expert_v': nrm(ks[23], (L, N_EXPERTS, D), PEER_HEADS ** -0.5),
    }


def reference(x, c, ctx, c_ctx, w_ada, b_ada, g_norm1, w_in, g_cq, w_uq, g_ckv, w_ukv, g_qn, g_kn,
              conv_qk, b_igate, b_fgate, g_mlstm, w_out, g_norm2, w_pq, sub_keys, expert_u, expert_v):
    n_lat = x.shape[1]
    ROWS = n_lat // GRID_W
    rope = rope_tables(ROWS)
    s_c = jax.nn.silu(c)
    s_cc = jax.nn.silu(c_ctx)
    for l in range(DEPTH):
        last = l == DEPTH - 1
        mod_lat = (s_c @ w_ada[l] + b_ada[l])[:, None, :]
        mod_ctx = s_cc @ w_ada[l] + b_ada[l]
        sh1, sc1, gt1, sh2, sc2, gt2 = jnp.split(mod_lat, N_MOD, axis=-1)
        csh1, csc1, cgt1, csh2, csc2, cgt2 = jnp.split(mod_ctx, N_MOD, axis=-1)
        h_lat = rmsnorm(x, g_norm1[l]) * (1.0 + sc1) + sh1
        h_ctx = rmsnorm(ctx, g_norm1[l]) * (1.0 + csc1) + csh1
        cols_lat = h_lat @ w_in[l]
        cols_ctx = h_ctx @ w_in[l]
        mla_lat, mla_ctx = mla_mixer(cols_lat[..., :MLA_COLS], cols_ctx[..., :MLA_COLS],
                                     g_cq[l], w_uq[l], g_ckv[l], w_ukv[l], g_qn[l], g_kn[l], rope, not last)
        ml_lat, ml_ctx = mlstm_mixer(cols_lat[..., MLA_COLS:], cols_ctx[..., MLA_COLS:],
                                     conv_qk[l], b_igate[l], b_fgate[l], g_mlstm[l], not last)
        x = x + gt1 * (jnp.concatenate([mla_lat, ml_lat], axis=-1) @ w_out[l])
        h2 = rmsnorm(x, g_norm2[l]) * (1.0 + sc2) + sh2
        x = x + gt2 * peer(h2, w_pq[l], sub_keys[l], expert_u[l], expert_v[l])
        if not last:
            ctx = ctx + cgt1 * (jnp.concatenate([mla_ctx, ml_ctx], axis=-1) @ w_out[l])
            hc2 = rmsnorm(ctx, g_norm2[l]) * (1.0 + csc2) + csh2
            ctx = ctx + cgt2 * peer(hc2, w_pq[l], sub_keys[l], expert_u[l], expert_v[l])
    return x
```

```cpp
#include <hip/hip_runtime.h>
#include <hip/hip_cooperative_groups.h>
#include <cstdio>
#include <cstdint>
namespace cg = cooperative_groups;

#ifndef MK_MULTI
#define MK_MULTI 0
#endif
#ifndef MK_CGSYNC
#define MK_CGSYNC 0
#endif
#ifndef DUP_MASK
#define DUP_MASK 0
#endif
#ifndef DUP_SUB
#define DUP_SUB 0
#endif
#define DBG_CHECK 0
#define DBG_SEL 4
#ifndef DBG_MODE
#define DBG_MODE 0
#endif
#ifndef DBG_PSCALE
#define DBG_PSCALE 1.0f
#endif

#define LAS __attribute__((address_space(3)))
typedef unsigned short bf16_t;
typedef short bf16x8 __attribute__((ext_vector_type(8)));
typedef short s16x4 __attribute__((ext_vector_type(4)));
typedef float f32x4 __attribute__((ext_vector_type(4)));
typedef float f32x2 __attribute__((ext_vector_type(2)));
typedef float f32x16 __attribute__((ext_vector_type(16)));
typedef unsigned u32x4 __attribute__((ext_vector_type(4)));
typedef unsigned u32x2 __attribute__((ext_vector_type(2)));
typedef __bf16 bf16v2 __attribute__((ext_vector_type(2)));

constexpr int NB = 8, T = 4096, TC = 256, D = 1024;
constexpr int NLAT = NB * T, NCTX = NB * TC, NTOK = NLAT + NCTX;
constexpr int NMOD = 6 * D;
constexpr int INC = 2000, INCP = 2048;
constexpr int C_CQ = 0, C_CKV = 256, C_KR = 384, C_MQ = 448, C_MK = 704, C_MV = 960, C_MO = 1472, C_G = 1984;
constexpr int NH = 4, DQK = 192, DNOPE = 128, DROPE = 64, DV = 128;
constexpr int NKEY = TC + T;
constexpr int MH = 4, MDK = 64, MDV = 128, MCH = 256, NBLK = T / MCH;
constexpr int PH = 8, NKEYS = 128, PDK = 256, PTOP = 16, NEXP = NKEYS * NKEYS;
constexpr float EPS = 1e-6f;
constexpr int NTHREADS = 512, NWAVES = 8;

constexpr size_t MiB = 1u << 20;
constexpr size_t WS_ZERO = 0;
constexpr size_t WS_MOD = 0;
constexpr size_t WS_SSQ = 18 * MiB + 512 * 1024;
constexpr size_t ZERO_BYTES = 1 * MiB;
constexpr size_t WS_BAR = 512 * 1024;
constexpr size_t WS_ROPE = 1 * MiB;
constexpr size_t WS_SKB = WS_ROPE + 64 * 1024;
constexpr size_t WS_MSCAL = WS_SKB + 512 * 1024;
constexpr size_t WS_MST = WS_MSCAL + 64 * 1024;
constexpr size_t WS_NST = WS_MST + 64 * 1024;
constexpr size_t WS_NL = WS_NST + 512 * 1024;
constexpr size_t WS_WIN = 4 * MiB;
constexpr size_t WS_WUQ = 8 * MiB;
constexpr size_t WS_WUKV = 9 * MiB;
constexpr size_t WS_WOUT = 10 * MiB;
constexpr size_t WS_WPQ = 12 * MiB;
constexpr size_t WS_GATES = 16 * MiB;
constexpr size_t WS_R1 = 20 * MiB;
constexpr size_t WS_HB = WS_R1, WS_Q = WS_R1, WS_CST = WS_R1 + 48 * MiB, WS_H2 = WS_R1;
constexpr size_t WS_COLS = 88 * MiB;
constexpr size_t WS_QP = WS_COLS;
constexpr size_t WS_R2 = 224 * MiB;
constexpr size_t WS_QRAW = WS_R2, WS_KVRAW = WS_R2 + 48 * MiB, WS_MIX = WS_R2;
constexpr size_t WS_EIDX = WS_R2 + 64 * MiB, WS_GW = WS_R2 + 80 * MiB;
constexpr size_t WS_CE = WS_EIDX;
constexpr size_t WS_SUE = WS_R2 + 96 * MiB;
constexpr size_t WS_U = 340 * MiB;
constexpr size_t WS_K = 376 * MiB;
constexpr size_t WS_VT = 428 * MiB;
constexpr size_t WS_EU = 376 * MiB;
constexpr size_t WS_EV = 408 * MiB;
constexpr size_t WS_EU8 = 464 * MiB;
constexpr size_t WS_EV8 = 480 * MiB;
constexpr size_t WS_H2Q = 408 * MiB;
constexpr size_t WS_SU = 3 * MiB;
constexpr size_t WS_SV = 3 * MiB + 64 * 1024;
constexpr size_t WS_HS = 3 * MiB + 128 * 1024;
constexpr size_t WS_OFFS = 3 * MiB + 256 * 1024;
constexpr size_t WS_END = 496 * MiB;
constexpr size_t WS_DBGP = 340 * MiB;
constexpr size_t WS_DBGR = 342 * MiB;

__device__ __forceinline__ unsigned cvt_pk_bf16(float lo, float hi) { unsigned r; asm volatile("v_cvt_pk_bf16_f32 %0, %1, %2" : "=v"(r) : "v"(lo), "v"(hi)); return r; }
__device__ __forceinline__ int lane_id_v() { int l; asm volatile("v_mbcnt_lo_u32_b32 %0, -1, 0\n\tv_mbcnt_hi_u32_b32 %0, -1, %0" : "=v"(l)); return l; }
__device__ __forceinline__ float bf_lo(unsigned w) { return __uint_as_float(w << 16); }
__device__ __forceinline__ float bf_hi(unsigned w) { return __uint_as_float(w & 0xffff0000u); }
__device__ __forceinline__ float bf2f(bf16_t v) { return __uint_as_float((unsigned)v << 16); }
__device__ __forceinline__ bf16_t f2bf(float f) { return (bf16_t)(cvt_pk_bf16(f, 0.f) & 0xffffu); }
__device__ __forceinline__ float wave_sum(float v) {
#pragma unroll
    for (int o = 1; o < 64; o <<= 1) v += __shfl_xor(v, o);
    return v;
}
__device__ __forceinline__ float siluf(float v) { return v / (1.f + __expf(-v)); }
__device__ __forceinline__ float sigmoidf_(float v) { return 1.f / (1.f + __expf(-v)); }
__device__ __forceinline__ float logsigmoidf_(float v) { return fminf(v, 0.f) - log1pf(__expf(-fabsf(v))); }
__device__ __forceinline__ int crow(int r, int hi) { return (r & 3) + 8 * (r >> 2) + 4 * hi; }

struct Params {
    const float *x, *c, *ctx, *c_ctx, *w_ada, *b_ada, *g_norm1, *w_in, *g_cq, *w_uq, *g_ckv, *w_ukv, *g_qn, *g_kn, *conv_qk, *b_igate, *b_fgate, *g_mlstm, *w_out, *g_norm2,
        *w_pq, *sub_keys, *expert_u, *expert_v;
    float* out; unsigned char* ws;
    int ph_lo, ph_hi, dup, pad_;
};

namespace pg8 {
constexpr int BM = 256, BK = 64, HALF = 128, HTB = HALF * BK * 2, STAGE_BYTES = 8 * HTB, NXCD = 8, WGM = 8;
__host__ __device__ __forceinline__ int lds_byte(int r, int c) { const int st = (r >> 4) * 2 + (c >> 5), rr = r & 15, cc = c & 31, ob = rr * 64 + cc * 2; return st * 1024 + (ob ^ (((ob >> 9) & 1) << 5)); }
__host__ __device__ __forceinline__ void stage_rc(int b, int& R, int& C) { const int st = b / 1024, sb = b % 1024, swz = sb ^ (((sb >> 9) & 1) << 5); R = (st >> 1) * 16 + swz / 64; C = (st & 1) * 32 + (swz % 64) / 2; }
__host__ __device__ __forceinline__ int perm32(int rho) { const int n = rho >> 4, i = rho & 15; return 8 * (i >> 2) + 4 * n + (i & 3); }
struct Unit { int pm, pn; };
struct Gemm { const bf16_t* A; const bf16_t* Bt; int M, N, K, lda, ldb, a_pn_off; };
struct StaticOrder {
    int nM, nN, nwg, G, c;
    __host__ __device__ void init(int M, int N, int G_, int c_) { nM = M / BM; nN = N / BM; nwg = nM * nN; G = G_; c = c_; }
    __host__ __device__ bool next(int i, Unit& u) const {
        const long L = (long)i * G + c; if (L >= nwg) return false;
        int wgid = (int)L; { const int q = nwg / NXCD, r = nwg % NXCD, xcd = wgid % NXCD, off = wgid / NXCD; wgid = (xcd < r ? xcd * (q + 1) : r * (q + 1) + (xcd - r) * q) + off; }
        const int nig = WGM * nN, gid = wgid / nig, fm = gid * WGM, gsz = (nM - fm) < WGM ? (nM - fm) : WGM;
        u.pm = fm + ((wgid % nig) % gsz); u.pn = (wgid % nig) / gsz; return true;
    }
};
template <class Epi, class Sched>
__device__ __forceinline__ void gemm_phase(LAS unsigned char* lds, const Gemm g, const Sched& S, const Epi& E, const int tidx) {
    const int tid = tidx, wid = __builtin_amdgcn_readfirstlane(tid >> 6), lane = tid & 63, wr = wid >> 2, wc = wid & 3, fr = lane & 15, fq = lane >> 4;
    const int K = g.K, nt = K / BK;
    unsigned voffA[2], voffB[2];
#pragma unroll
    for (int i = 0; i < 2; ++i) { int R, C; stage_rc(tid * 16 + i * 8192, R, C); const int Rb = Epi::PERM ? ((R & ~31) + perm32(R & 31)) : R;
        voffA[i] = (unsigned)(R * g.lda + C) * 2u; voffB[i] = (unsigned)(Rb * g.ldb + C) * 2u; }
    const size_t kstep = (size_t)(BK * 2);
    const size_t hstepA = (size_t)HALF * g.lda * 2, hstepB = (size_t)HALF * g.ldb * 2;
    const size_t tstepA = 2 * hstepA, tstepB = 2 * hstepB;
    const unsigned ldsw = (unsigned)wid * 1024u;
    const int aoff = lds_byte(wr * 64 + fr, fq * 8), boff = lds_byte(wc * 32 + fr, fq * 8);
#define PG8_SA(b, h) (((b) * 2 + (h)) * HTB)
#define PG8_SB(b, h) ((4 + (b) * 2 + (h)) * HTB)
#define PG8_STAGE(bufoff, gbase, voff) do { _Pragma("unroll") for (int _i = 0; _i < 2; ++_i) \
        __builtin_amdgcn_global_load_lds((const unsigned*)((const char*)(gbase) + (voff)[_i]), (LAS unsigned*)(lds + (bufoff) + ldsw + _i * 8192), 16, 0, 0); } while (0)
#define PG8_LDA(dst, b, h) do { _Pragma("unroll") for (int m = 0; m < 4; ++m) _Pragma("unroll") for (int k = 0; k < 2; ++k) dst[m][k] = *(const LAS bf16x8*)(lds + PG8_SA(b, h) + aoff + m * 2048 + k * 1024); } while (0)
#define PG8_LDB(dst, b, h) do { _Pragma("unroll") for (int n = 0; n < 2; ++n) _Pragma("unroll") for (int k = 0; k < 2; ++k) dst[n][k] = *(const LAS bf16x8*)(lds + PG8_SB(b, h) + boff + n * 2048 + k * 1024); } while (0)
#define PG8_MMA(ai, bj, At, Bt) do { __builtin_amdgcn_s_setprio(1); _Pragma("unroll") for (int m = 0; m < 4; ++m) _Pragma("unroll") for (int n = 0; n < 2; ++n) _Pragma("unroll") for (int k = 0; k < 2; ++k) \
        acc[ai][bj][m][n] = __builtin_amdgcn_mfma_f32_16x16x32_bf16(Bt[n][k], At[m][k], acc[ai][bj][m][n], 0, 0, 0); __builtin_amdgcn_s_setprio(0); } while (0)
#define PG8_WAIT_V(n) asm volatile("s_waitcnt vmcnt(" #n ")" ::: "memory")
#define PG8_WAIT_L(n) asm volatile("s_waitcnt lgkmcnt(" #n ")" ::: "memory")
#define PG8_BAR __builtin_amdgcn_s_barrier()
#define PG8_SCHED __builtin_amdgcn_sched_barrier(0)
    Unit cur, nxt; int ui = 0;
    if (!S.next(0, cur)) return;
    f32x4 acc[2][2][4][2];
#pragma unroll
    for (int a = 0; a < 2; ++a)
#pragma unroll
        for (int b = 0; b < 2; ++b)
#pragma unroll
            for (int m = 0; m < 4; ++m)
#pragma unroll
                for (int n = 0; n < 2; ++n) acc[a][b][m][n] = (f32x4){0.f, 0.f, 0.f, 0.f};
    bf16x8 At[4][2], B0[2][2], B1[2][2];
    const char* cA = (const char*)g.A + (size_t)cur.pm * tstepA + (size_t)cur.pn * g.a_pn_off * 2; const char* cB = (const char*)g.Bt + (size_t)cur.pn * tstepB;
    PG8_STAGE(PG8_SB(0, 0), cB, voffB); PG8_STAGE(PG8_SB(0, 1), cB + hstepB, voffB); PG8_STAGE(PG8_SA(0, 0), cA, voffA); PG8_STAGE(PG8_SA(0, 1), cA + hstepA, voffA);
    if (wr == 1) PG8_BAR;
    PG8_WAIT_V(2); PG8_BAR;
    PG8_STAGE(PG8_SB(1, 0), cB + kstep, voffB); PG8_STAGE(PG8_SA(1, 0), cA + kstep, voffA); PG8_STAGE(PG8_SB(1, 1), cB + hstepB + kstep, voffB);
    PG8_WAIT_V(6); PG8_BAR;
    for (;;) {
        const bool has_next = S.next(ui + 1, nxt);
        const char* nA = has_next ? (const char*)g.A + (size_t)nxt.pm * tstepA + (size_t)nxt.pn * g.a_pn_off * 2 : cA; const char* nB = has_next ? (const char*)g.Bt + (size_t)nxt.pn * tstepB : cB;
        for (int t = 0; t < nt; t += 2) {
            const bool last = (t == nt - 2);
            const char* a1 = cA + (size_t)(t + 1) * kstep;
            const char* a2 = last ? nA : cA + (size_t)(t + 2) * kstep; const char* b2 = last ? nB : cB + (size_t)(t + 2) * kstep;
            const char* a3 = a2 + kstep; const char* b3 = b2 + kstep;
            PG8_LDB(B0, 0, 0); PG8_LDB(B1, 0, 1); PG8_SCHED; PG8_LDA(At, 0, 0); PG8_STAGE(PG8_SA(1, 1), a1 + hstepA, voffA);
            PG8_WAIT_V(8); PG8_WAIT_L(0); PG8_BAR; PG8_MMA(0, 0, At, B0); PG8_MMA(0, 1, At, B1); PG8_BAR; PG8_SCHED;
            PG8_LDA(At, 0, 1); PG8_STAGE(PG8_SB(0, 0), b2, voffB); PG8_STAGE(PG8_SB(0, 1), b2 + hstepB, voffB); PG8_STAGE(PG8_SA(0, 0), a2, voffA);
            PG8_WAIT_V(8); PG8_WAIT_L(0); PG8_BAR; PG8_MMA(1, 0, At, B0); PG8_MMA(1, 1, At, B1); PG8_BAR; PG8_SCHED;
            PG8_LDB(B0, 1, 0); PG8_LDB(B1, 1, 1); PG8_SCHED; PG8_LDA(At, 1, 0); PG8_STAGE(PG8_SA(0, 1), a2 + hstepA, voffA);
            PG8_WAIT_V(8); PG8_WAIT_L(0); PG8_BAR; PG8_MMA(0, 0, At, B0); PG8_MMA(0, 1, At, B1); PG8_BAR; PG8_SCHED;
            PG8_LDA(At, 1, 1); PG8_STAGE(PG8_SB(1, 0), b3, voffB); PG8_STAGE(PG8_SB(1, 1), b3 + hstepB, voffB); PG8_STAGE(PG8_SA(1, 0), a3, voffA);
            PG8_WAIT_V(8); PG8_WAIT_L(0); PG8_BAR; PG8_MMA(1, 0, At, B0); PG8_MMA(1, 1, At, B1); PG8_BAR; PG8_SCHED;
        }
        if (wr == 0) PG8_BAR;
        E(acc, cur, wr, wc, fr, fq);
        if (!has_next) break;
#pragma unroll
        for (int a = 0; a < 2; ++a)
#pragma unroll
            for (int b = 0; b < 2; ++b)
#pragma unroll
                for (int m = 0; m < 4; ++m)
#pragma unroll
                    for (int n = 0; n < 2; ++n) acc[a][b][m][n] = (f32x4){0.f, 0.f, 0.f, 0.f};
        cur = nxt; cA = nA; cB = nB; ++ui;
        if (wr == 1) PG8_BAR;
    }
    PG8_WAIT_V(0);
    PG8_BAR;
#undef PG8_SA
#undef PG8_SB
#undef PG8_STAGE
#undef PG8_LDA
#undef PG8_LDB
#undef PG8_MMA
#undef PG8_WAIT_V
#undef PG8_WAIT_L
#undef PG8_BAR
#undef PG8_SCHED
}

struct EpiBf16 {
    static constexpr bool PERM = true;
    bf16_t* O; int ldc;
    __device__ __forceinline__ void operator()(const f32x4 (&acc)[2][2][4][2], const Unit& u, int wr, int wc, int fr, int fq) const {
        const int row0 = u.pm * BM + wr * 64 + fr, col0 = u.pn * BM + wc * 32 + 8 * fq;
#pragma unroll
        for (int ai = 0; ai < 2; ++ai)
#pragma unroll
            for (int m = 0; m < 4; ++m) { bf16_t* rowp = O + (size_t)(row0 + ai * HALF + m * 16) * ldc + col0;
#pragma unroll
                for (int bj = 0; bj < 2; ++bj) { const f32x4 v0 = acc[ai][bj][m][0], v1 = acc[ai][bj][m][1]; u32x4 w;
                    w.x = cvt_pk_bf16(v0[0], v0[1]); w.y = cvt_pk_bf16(v0[2], v0[3]); w.z = cvt_pk_bf16(v1[0], v1[1]); w.w = cvt_pk_bf16(v1[2], v1[3]);
                    *(u32x4*)(rowp + bj * HALF) = w; } }
    }
};
struct EpiCols {
    static constexpr bool PERM = true;
    bf16_t* O; float* gates; float* ssq;
    __device__ __forceinline__ void operator()(const f32x4 (&acc)[2][2][4][2], const Unit& u, int wr, int wc, int fr, int fq) const {
        const int row0 = u.pm * BM + wr * 64 + fr, col0 = u.pn * BM + wc * 32 + 8 * fq;
#pragma unroll
        for (int ai = 0; ai < 2; ++ai)
#pragma unroll
            for (int m = 0; m < 4; ++m) { const int row = row0 + ai * HALF + m * 16; bf16_t* rowp = O + (size_t)row * INCP + col0;
                float s0 = 0.f, s1 = 0.f;
#pragma unroll
                for (int bj = 0; bj < 2; ++bj) { const f32x4 v0 = acc[ai][bj][m][0], v1 = acc[ai][bj][m][1]; u32x4 w;
                    w.x = cvt_pk_bf16(v0[0], v0[1]); w.y = cvt_pk_bf16(v0[2], v0[3]); w.z = cvt_pk_bf16(v1[0], v1[1]); w.w = cvt_pk_bf16(v1[2], v1[3]);
                    *(u32x4*)(rowp + bj * HALF) = w;
                    const float s = (v0[0] * v0[0] + v0[1] * v0[1]) + (v0[2] * v0[2] + v0[3] * v0[3]) + (v1[0] * v1[0] + v1[1] * v1[1]) + (v1[2] * v1[2] + v1[3] * v1[3]);
                    if (bj == 0) s0 = s; else s1 = s; }
                if (u.pn == 0) { float s = s0 + s1; s += __shfl_xor(s, 16); s += __shfl_xor(s, 32); if (fq == 0) ssq[row * 8 + wc] = s; }
                if (u.pn == 1) { float s = s0; s += __shfl_xor(s, 16); s += __shfl_xor(s, 32); if (fq == 0) ssq[row * 8 + 4 + wc] = s; }
                if (u.pn == 7 && wc == 2 && fq < 2) { *(f32x4*)(gates + (size_t)row * 16 + 8 * fq) = acc[ai][1][m][0]; *(f32x4*)(gates + (size_t)row * 16 + 8 * fq + 4) = acc[ai][1][m][1]; }
            }
    }
};
struct EpiResid {
    static constexpr bool PERM = false;
    const float* base; float* out; const float* mod; int gate_off; float gscale;
    __device__ __forceinline__ void operator()(const f32x4 (&acc)[2][2][4][2], const Unit& u, int wr, int wc, int fr, int fq) const {
        const int row0 = u.pm * BM + wr * 64 + fr, col0 = u.pn * BM + wc * 32 + 4 * fq;
        const int b = (u.pm * BM) / T;
        f32x4 gv[2][2];
#pragma unroll
        for (int bj = 0; bj < 2; ++bj)
#pragma unroll
            for (int n = 0; n < 2; ++n) gv[bj][n] = *(const f32x4*)(mod + (size_t)b * NMOD + gate_off + col0 + bj * HALF + n * 16) * gscale;
#pragma unroll
        for (int ai = 0; ai < 2; ++ai)
#pragma unroll
            for (int m = 0; m < 4; ++m) { const size_t off = (size_t)(row0 + ai * HALF + m * 16) * D + col0;
#pragma unroll
                for (int bj = 0; bj < 2; ++bj)
#pragma unroll
                    for (int n = 0; n < 2; ++n) { const f32x4 bs = *(const f32x4*)(base + off + bj * HALF + n * 16); *(f32x4*)(out + off + bj * HALF + n * 16) = bs + gv[bj][n] * acc[ai][bj][m][n]; } }
    }
};
struct EpiKV {
    static constexpr bool PERM = true;
    const bf16_t* cols; const float* ssq; const float* g_kn; const float* rt; bf16_t* Kb; bf16_t* Vb; LAS unsigned char* xl; int tidx;
    __device__ __forceinline__ void operator()(const f32x4 (&acc)[2][2][4][2], const Unit& u, int wr_, int wc_, int fr_, int fq_) const {
        int fr = fr_, fq = fq_, tix = tidx, wr = wr_, wc = wc_; asm volatile("" : "+v"(fr), "+v"(fq), "+v"(tix), "+s"(wr), "+s"(wc));
        LAS float* P = (LAS float*)xl;
        LAS float* KR = P + 1024;
        LAS float* RK = KR + 256;
        LAS float* RKV = RK + 256;
        const int h = u.pn, rowbase = u.pm * BM;
        const bool lat = rowbase < NLAT; const int b = lat ? rowbase / T : (rowbase - NLAT) / TC; const int key0 = lat ? TC + rowbase % T : 0, t0 = lat ? rowbase % T : 0;
#pragma unroll
        for (int ai = 0; ai < 2; ++ai)
#pragma unroll
            for (int m = 0; m < 4; ++m) { const f32x4 v0 = acc[ai][0][m][0], v1 = acc[ai][0][m][1];
                float s = (v0[0] * v0[0] + v0[1] * v0[1]) + (v0[2] * v0[2] + v0[3] * v0[3]) + (v1[0] * v1[0] + v1[1] * v1[1]) + (v1[2] * v1[2] + v1[3] * v1[3]);
                s += __shfl_xor(s, 16); s += __shfl_xor(s, 32);
                if (fq == 0) P[(ai * HALF + wr * 64 + m * 16 + fr) * 4 + wc] = s; }
        const int rrow = tix >> 1, half = tix & 1;
        const bf16_t* krp = cols + (size_t)(rowbase + rrow) * INCP + C_KR + 32 * half;
        { float ss = 0.f;
#pragma unroll
          for (int c4 = 0; c4 < 4; ++c4) { const u32x4 kk = *(const u32x4*)(krp + 8 * c4);
#pragma unroll
              for (int q = 0; q < 4; ++q) { const float lo = bf_lo(kk[q]), hi = bf_hi(kk[q]); ss += lo * lo + hi * hi; } }
          ss += __shfl_xor(ss, 1); if (half == 0) KR[rrow] = ss; }
        asm volatile("s_waitcnt lgkmcnt(0)" ::: "memory"); __builtin_amdgcn_s_barrier(); asm volatile("" ::: "memory");
        if (tix < 256) { const f32x4 sk4 = *(const f32x4*)(ssq + (size_t)(rowbase + tix) * 8 + 4);
            const float rkv = rsqrtf(((sk4[0] + sk4[1]) + (sk4[2] + sk4[3])) * (1.f / 128.f) + EPS);
            const float sn = ((P[tix * 4] + P[tix * 4 + 1]) + (P[tix * 4 + 2] + P[tix * 4 + 3])) * rkv * rkv;
            RKV[tix] = rkv; RK[tix] = rsqrtf((sn + KR[tix]) * (1.f / 192.f) + EPS); }
        asm volatile("s_waitcnt lgkmcnt(0)" ::: "memory"); __builtin_amdgcn_s_barrier(); asm volatile("" ::: "memory");
        const int col0 = wc * 32 + 8 * fq;
        f32x4 g0 = *(const f32x4*)(g_kn + col0), g1 = *(const f32x4*)(g_kn + col0 + 4);
#pragma unroll
        for (int ai = 0; ai < 2; ++ai)
#pragma unroll
            for (int m = 0; m < 4; ++m) { const int r = ai * HALF + wr * 64 + m * 16 + fr; const float rkv = RKV[r], sk = rkv * RK[r];
                const size_t kvrow = ((size_t)b * NH + h) * NKEY + key0 + r;
                { const f32x4 v0 = acc[ai][0][m][0] * sk * g0, v1 = acc[ai][0][m][1] * sk * g1; u32x4 w;
                  w.x = cvt_pk_bf16(v0[0], v0[1]); w.y = cvt_pk_bf16(v0[2], v0[3]); w.z = cvt_pk_bf16(v1[0], v1[1]); w.w = cvt_pk_bf16(v1[2], v1[3]); *(u32x4*)(Kb + kvrow * DQK + col0) = w; }
                { const f32x4 v0 = acc[ai][1][m][0] * rkv, v1 = acc[ai][1][m][1] * rkv; u32x4 w;
                  w.x = cvt_pk_bf16(v0[0], v0[1]); w.y = cvt_pk_bf16(v0[2], v0[3]); w.z = cvt_pk_bf16(v1[0], v1[1]); w.w = cvt_pk_bf16(v1[2], v1[3]); *(u32x4*)(Vb + kvrow * DV + col0) = w; } }
        { const float rk = RK[rrow]; const int t = t0 + rrow; const int pos = half ? (t & 63) : (t >> 6);
          const float* gk = g_kn + 128 + 32 * half;
          bf16_t* kp = Kb + (((size_t)b * NH + h) * NKEY + key0 + rrow) * DQK + 128 + 32 * half;
#pragma unroll
          for (int hf = 0; hf < 2; ++hf) {
              const u32x4 ka = *(const u32x4*)(krp + 8 * hf), kb2 = *(const u32x4*)(krp + 16 + 8 * hf);
              float oa[8], ob[8];
#pragma unroll
              for (int q = 0; q < 8; ++q) { const int j = 8 * hf + q; float cs = 1.f, sn = 0.f; if (lat) { cs = rt[(pos * 16 + j) * 2]; sn = rt[(pos * 16 + j) * 2 + 1]; }
                  const float av = ((q & 1) ? bf_hi(ka[q >> 1]) : bf_lo(ka[q >> 1])) * rk * gk[j], cv = ((q & 1) ? bf_hi(kb2[q >> 1]) : bf_lo(kb2[q >> 1])) * rk * gk[16 + j];
                  oa[q] = av * cs - cv * sn; ob[q] = cv * cs + av * sn; }
              u32x4 w; w.x = cvt_pk_bf16(oa[0], oa[1]); w.y = cvt_pk_bf16(oa[2], oa[3]); w.z = cvt_pk_bf16(oa[4], oa[5]); w.w = cvt_pk_bf16(oa[6], oa[7]); *(u32x4*)(kp + 8 * hf) = w;
              w.x = cvt_pk_bf16(ob[0], ob[1]); w.y = cvt_pk_bf16(ob[2], ob[3]); w.z = cvt_pk_bf16(ob[4], ob[5]); w.w = cvt_pk_bf16(ob[6], ob[7]); *(u32x4*)(kp + 16 + 8 * hf) = w; } }
        asm volatile("s_waitcnt lgkmcnt(0)" ::: "memory"); __builtin_amdgcn_s_barrier(); asm volatile("" ::: "memory");
    }
};
struct EpiQ {
    static constexpr bool PERM = true;
    const float* ssq; const float* g_qn; const float* rt; bf16_t* Q; LAS unsigned char* xl; int tidx;
    __device__ __forceinline__ void operator()(const f32x4 (&acc)[2][2][4][2], const Unit& u, int wr_, int wc_, int fr_, int fq_) const {
        int fr = fr_, fq = fq_, tix = tidx, wr = wr_, wc = wc_; asm volatile("" : "+v"(fr), "+v"(fq), "+v"(tix), "+s"(wr), "+s"(wc));
        LAS float* P = (LAS float*)xl;
        LAS float* RS = P + 1024;
        const int h = u.pn, rowbase = u.pm * BM; const int b = rowbase / T, t0 = rowbase % T;
#pragma unroll
        for (int ai = 0; ai < 2; ++ai)
#pragma unroll
            for (int m = 0; m < 4; ++m) { float s = 0.f;
#pragma unroll
                for (int bj = 0; bj < 2; ++bj) { const f32x4 v0 = acc[ai][bj][m][0], v1 = acc[ai][bj][m][1];
                    s += (v0[0] * v0[0] + v0[1] * v0[1]) + (v0[2] * v0[2] + v0[3] * v0[3]) + (v1[0] * v1[0] + v1[1] * v1[1]) + (v1[2] * v1[2] + v1[3] * v1[3]); }
                s += __shfl_xor(s, 16); s += __shfl_xor(s, 32);
                if (fq == 0) P[(ai * HALF + wr * 64 + m * 16 + fr) * 4 + wc] = s; }
        asm volatile("s_waitcnt lgkmcnt(0)" ::: "memory"); __builtin_amdgcn_s_barrier(); asm volatile("" ::: "memory");
        if (tix < 256) { const f32x4 sq4 = *(const f32x4*)(ssq + (size_t)(rowbase + tix) * 8);
            const float rq = rsqrtf(((sq4[0] + sq4[1]) + (sq4[2] + sq4[3])) * (1.f / 256.f) + EPS);
            const float sn = ((P[tix * 4] + P[tix * 4 + 1]) + (P[tix * 4 + 2] + P[tix * 4 + 3])) * rq * rq;
            RS[tix] = rq * rsqrtf(sn * (1.f / 192.f) + EPS); }
        asm volatile("s_waitcnt lgkmcnt(0)" ::: "memory"); __builtin_amdgcn_s_barrier(); asm volatile("" ::: "memory");
        const int col0 = wc * 32 + 8 * fq;
        { const f32x4 g0 = *(const f32x4*)(g_qn + col0), g1 = *(const f32x4*)(g_qn + col0 + 4);
#pragma unroll
          for (int ai = 0; ai < 2; ++ai)
#pragma unroll
            for (int m = 0; m < 4; ++m) { const int r = ai * HALF + wr * 64 + m * 16 + fr; const float sc = RS[r];
                const f32x4 v0 = acc[ai][0][m][0] * sc * g0, v1 = acc[ai][0][m][1] * sc * g1; u32x4 w;
                w.x = cvt_pk_bf16(v0[0], v0[1]); w.y = cvt_pk_bf16(v0[2], v0[3]); w.z = cvt_pk_bf16(v1[0], v1[1]); w.w = cvt_pk_bf16(v1[2], v1[3]);
                *(u32x4*)(Q + (((size_t)b * NH + h) * T + t0 + r) * DQK + col0) = w; } }
        if (wc < 2) {
            const f32x4 g0 = *(const f32x4*)(g_qn + 128 + col0), g1 = *(const f32x4*)(g_qn + 128 + col0 + 4);
            const bool second = fq >= 2; const int fi0 = (8 * fq) & 15;
#pragma unroll
            for (int ai = 0; ai < 2; ++ai)
#pragma unroll
                for (int m = 0; m < 4; ++m) { const int r = ai * HALF + wr * 64 + m * 16 + fr; const float sc = RS[r];
                    const int t = t0 + r; const int pos = wc ? (t & 63) : (t >> 6);
                    const f32x4 v0 = acc[ai][1][m][0] * sc * g0, v1 = acc[ai][1][m][1] * sc * g1; float o[8];
#pragma unroll
                    for (int q = 0; q < 8; ++q) { const float own = q < 4 ? v0[q & 3] : v1[q & 3];
                        auto r_ = __builtin_amdgcn_permlane32_swap(__float_as_uint(own), __float_as_uint(own), false, false);
                        const float oth = second ? __uint_as_float(r_[0]) : __uint_as_float(r_[1]);
                        const f32x2 cs = *(const f32x2*)(rt + (pos * 16 + fi0 + q) * 2);
                        o[q] = second ? (own * cs[0] + oth * cs[1]) : (own * cs[0] - oth * cs[1]); }
                    u32x4 w; w.x = cvt_pk_bf16(o[0], o[1]); w.y = cvt_pk_bf16(o[2], o[3]); w.z = cvt_pk_bf16(o[4], o[5]); w.w = cvt_pk_bf16(o[6], o[7]);
                    *(u32x4*)(Q + (((size_t)b * NH + h) * T + t0 + r) * DQK + 128 + col0) = w; } }
        asm volatile("s_waitcnt lgkmcnt(0)" ::: "memory"); __builtin_amdgcn_s_barrier(); asm volatile("" ::: "memory");
    }
};
}

template <int CTRL> __device__ __forceinline__ int dppi(int v) { return __builtin_amdgcn_update_dpp(0, v, CTRL, 0xf, 0xf, true); }
template <int CTRL> __device__ __forceinline__ float dppf(float v) { return __int_as_float(__builtin_amdgcn_update_dpp(0, __float_as_int(v), CTRL, 0xf, 0xf, true)); }
__device__ __forceinline__ int row_sum_i(int d) { d += dppi<0xB1>(d); d += dppi<0x4E>(d); d += dppi<0x141>(d); d += dppi<0x140>(d); return d; }
__device__ __forceinline__ float row_sum_f(float d) { d += dppf<0xB1>(d); d += dppf<0x4E>(d); d += dppf<0x141>(d); d += dppf<0x140>(d); return d; }
__device__ __forceinline__ float wave_sum_fast(float v) {
    v = row_sum_f(v);
    { auto r = __builtin_amdgcn_permlane16_swap(__float_as_uint(v), __float_as_uint(v), false, false); v = __uint_as_float(r[0]) + __uint_as_float(r[1]); }
    { auto r = __builtin_amdgcn_permlane32_swap(__float_as_uint(v), __float_as_uint(v), false, false); v = __uint_as_float(r[0]) + __uint_as_float(r[1]); }
    return v;
}
__device__ __forceinline__ float wave_max_fast(float v) {
    v = fmaxf(v, dppf<0xB1>(v)); v = fmaxf(v, dppf<0x4E>(v)); v = fmaxf(v, dppf<0x141>(v)); v = fmaxf(v, dppf<0x140>(v));
    { auto r = __builtin_amdgcn_permlane16_swap(__float_as_uint(v), __float_as_uint(v), false, false); v = fmaxf(__uint_as_float(r[0]), __uint_as_float(r[1])); }
    { auto r = __builtin_amdgcn_permlane32_swap(__float_as_uint(v), __float_as_uint(v), false, false); v = fmaxf(__uint_as_float(r[0]), __uint_as_float(r[1])); }
    return v;
}
__device__ __forceinline__ float wave_max(float v) {
#pragma unroll
    for (int o = 1; o < 64; o <<= 1) v = fmaxf(v, __shfl_xor(v, o));
    return v;
}
__device__ __forceinline__ unsigned q8pack(f32x4 v, float inv, int bias) {
    int a = __float2int_rn(v[0] * inv), b = __float2int_rn(v[1] * inv), c = __float2int_rn(v[2] * inv), d = __float2int_rn(v[3] * inv);
    a = min(127, max(-127, a)) + bias; b = min(127, max(-127, b)) + bias; c = min(127, max(-127, c)) + bias; d = min(127, max(-127, d)) + bias;
    return (unsigned)(a & 0xff) | ((unsigned)(b & 0xff) << 8) | ((unsigned)(c & 0xff) << 16) | ((unsigned)(d & 0xff) << 24);
}
template <bool SLICED> __device__ __forceinline__ void quant_row(const float* src, unsigned* dst, float* scale, int bias, int lane, int row) {
    f32x4 v[4]; float m = 0.f;
#pragma unroll
    for (int j = 0; j < 4; ++j) { v[j] = ((const f32x4*)src)[lane + 64 * j]; m = fmaxf(m, fmaxf(fmaxf(fabsf(v[j][0]), fabsf(v[j][1])), fmaxf(fabsf(v[j][2]), fabsf(v[j][3])))); }
    m = fmaxf(wave_max(m), 1e-30f); const float inv = 127.f / m;
#pragma unroll
    for (int j = 0; j < 4; ++j) { if (SLICED) dst[(size_t)(2 * j + (lane >> 5)) * (NEXP * 32) + (size_t)row * 32 + (lane & 31)] = q8pack(v[j], inv, bias); else dst[(size_t)row * 256 + lane + 64 * j] = q8pack(v[j], inv, bias); }
    if (lane == 0) *scale = m * (1.f / 127.f);
}
template <bool QPAD = false> __device__ __forceinline__ void transpose_item(const float* W, int K, int N, int Npad, const float* kscale, bf16_t* WT, LAS float* scr, int item, int lane) {
    const int nblk = Npad / 32, kb = item / nblk, nb = item % nblk, k0 = 64 * kb, n0 = 32 * nb;
    const int d0 = QPAD ? (nb / 6) * 256 + (nb % 6) * 32 : n0;
#pragma unroll 8
    for (int i = 0; i < 32; ++i) { const int kk = 2 * i + (lane >> 5); const int n = n0 + (lane & 31);
        float v = (n < N) ? W[(size_t)(k0 + kk) * N + n] : 0.f; if (kscale) v *= kscale[k0 + kk]; scr[kk * 33 + (lane & 31)] = v; }
    asm volatile("s_waitcnt lgkmcnt(0)" ::: "memory");
    const int c = lane & 7;
#pragma unroll
    for (int j = 0; j < 4; ++j) { const int n = (lane >> 3) + 8 * j; const LAS float* s = scr + (8 * c) * 33 + n;
        u32x4 o; o.x = cvt_pk_bf16(s[0 * 33], s[1 * 33]); o.y = cvt_pk_bf16(s[2 * 33], s[3 * 33]); o.z = cvt_pk_bf16(s[4 * 33], s[5 * 33]); o.w = cvt_pk_bf16(s[6 * 33], s[7 * 33]);
        *(u32x4*)(WT + (size_t)(d0 + n) * K + k0 + 8 * c) = o; }
    asm volatile("s_waitcnt lgkmcnt(0)" ::: "memory");
}

__device__ __forceinline__ void phase_prep(const Params& p, LAS unsigned char* lds, const int tidx) {
    const int tid = tidx, lane = tid & 63, wave = tid >> 6;
    const int gw = blockIdx.x * NWAVES + wave, NGW = gridDim.x * NWAVES;
    LAS float* scr = (LAS float*)(lds + wave * 8704);
    unsigned char* ws = p.ws;
    constexpr int I_IN = (D / 64) * (INCP / 32), I_UQ = (256 / 64) * (768 / 32), I_UKV = (128 / 64) * (1024 / 32), I_OUT = (D / 64) * (D / 32), I_PQ = (D / 64) * (2048 / 32);
    constexpr int NITEMS = I_IN + I_UQ + I_UKV + I_OUT + I_PQ;
    if (blockIdx.x < 96) {
      LAS float* part = (LAS float*)(lds + 8 * 8704);
      LAS float* sil = part + 8 * 9 * 64;
      for (int i = tid; i < 9 * D; i += NTHREADS) { const int q = i >> 10, k = i & 1023; sil[i] = siluf(q < 8 ? p.c[q * D + k] : p.c_ctx[k]); }
      __syncthreads();
      for (int cgp = blockIdx.x; cgp < 96; cgp += gridDim.x) {
        const int col = cgp * 64 + lane;
        float acc[9];
#pragma unroll
        for (int q = 0; q < 9; ++q) acc[q] = 0.f;
#pragma unroll 8
        for (int kk = 0; kk < 128; ++kk) { const int k = wave * 128 + kk; const float w = p.w_ada[(size_t)k * NMOD + col];
#pragma unroll
            for (int q = 0; q < 9; ++q) acc[q] += sil[q * D + k] * w; }
        __syncthreads();
#pragma unroll
        for (int q = 0; q < 9; ++q) part[(wave * 9 + q) * 64 + lane] = acc[q];
        __syncthreads();
        float* mod = (float*)(ws + WS_MOD);
        for (int o = tid; o < 9 * 64; o += NTHREADS) { const int q = o >> 6, cl = o & 63; float s = p.b_ada[cgp * 64 + cl];
#pragma unroll
            for (int w8 = 0; w8 < 8; ++w8) s += part[(w8 * 9 + q) * 64 + cl];
            mod[q * NMOD + cgp * 64 + cl] = s; }
      } }
    for (int it = gw; it < NITEMS; it += NGW) {
        int r = it;
        if (r < I_IN) { transpose_item(p.w_in, D, INC, INCP, nullptr, (bf16_t*)(ws + WS_WIN), scr, r, lane); continue; } r -= I_IN;
        if (r < I_UQ) { transpose_item<true>(p.w_uq, 256, 768, 768, p.g_cq, (bf16_t*)(ws + WS_WUQ), scr, r, lane); continue; } r -= I_UQ;
        if (r < I_UKV) { transpose_item(p.w_ukv, 128, 1024, 1024, p.g_ckv, (bf16_t*)(ws + WS_WUKV), scr, r, lane); continue; } r -= I_UKV;
        if (r < I_OUT) { transpose_item(p.w_out, D, D, D, nullptr, (bf16_t*)(ws + WS_WOUT), scr, r, lane); continue; } r -= I_OUT;
        transpose_item(p.w_pq, D, 2048, 2048, nullptr, (bf16_t*)(ws + WS_WPQ), scr, r, lane);
    }
    const int gt = blockIdx.x * NTHREADS + tid, NGT = gridDim.x * NTHREADS;
    { bf16_t* wq = (bf16_t*)(ws + WS_WUQ);
      for (int i = gt; i < 4 * 64 * 256 / 8; i += NGT) { const int hd = i / (64 * 32), rem = i % (64 * 32); *(u32x4*)(wq + ((size_t)hd * 256 + 192) * 256 + (size_t)rem * 8) = (u32x4){0u, 0u, 0u, 0u}; } }
    { bf16_t* skb = (bf16_t*)(ws + WS_SKB);
      for (int i = gt; i < PH * 2 * NKEYS * 128 / 4; i += NGT) { const f32x4 v = ((const f32x4*)p.sub_keys)[i]; u32x2 o; o.x = cvt_pk_bf16(v[0], v[1]); o.y = cvt_pk_bf16(v[2], v[3]); ((u32x2*)skb)[i] = o; } }
    { float* rt = (float*)(ws + WS_ROPE);
      for (int i = gt; i < 64 * 16; i += NGT) { const int pos = i >> 4, j = i & 15; const float inv = powf(10000.f, -(float)j * (2.0f / 32.0f)); const float ang = (float)pos * inv;
          rt[2 * i] = cosf(ang); rt[2 * i + 1] = sinf(ang); } }
}

__device__ __forceinline__ void quant_experts(const Params& p, int vb, int nvb, const int tidx) {
    const int lane = tidx & 63, wave = tidx >> 6; unsigned char* ws = p.ws;
    unsigned* eu8 = (unsigned*)(ws + WS_EU8); unsigned* ev8 = (unsigned*)(ws + WS_EV8); float* su = (float*)(ws + WS_SU); float* sv = (float*)(ws + WS_SV);
    for (int r = vb * NWAVES + wave; r < 2 * NEXP; r += nvb * NWAVES) {
        if (r < NEXP) quant_row<false>(p.expert_u + (size_t)r * D, eu8, su + r, 0, lane, r);
        else { const int e = r - NEXP; quant_row<true>(p.expert_v + (size_t)e * D, ev8, sv + e, 0, lane, e); } }
}
__device__ __forceinline__ void norm_mod_row(const float* src, const float* g, const float* sh, const float* sc, bf16_t* dst, int lane) {
    f32x4 v[4]; float s = 0.f;
#pragma unroll
    for (int j = 0; j < 4; ++j) { v[j] = ((const f32x4*)src)[lane + 64 * j]; s += (v[j][0] * v[j][0] + v[j][1] * v[j][1]) + (v[j][2] * v[j][2] + v[j][3] * v[j][3]); }
    const float rstd = rsqrtf(wave_sum(s) * (1.f / D) + EPS);
#pragma unroll
    for (int j = 0; j < 4; ++j) { const int i4 = lane + 64 * j; const f32x4 gg = ((const f32x4*)g)[i4], s1 = ((const f32x4*)sc)[i4], h1 = ((const f32x4*)sh)[i4];
        const f32x4 o = v[j] * rstd * gg * (s1 + 1.f) + h1; u32x2 w; w.x = cvt_pk_bf16(o[0], o[1]); w.y = cvt_pk_bf16(o[2], o[3]); ((u32x2*)dst)[i4] = w; }
}
__device__ __forceinline__ void phase_hnorm(const Params& p, const int tidx) {
    const int lane = tidx & 63, wave = tidx >> 6;
    const int gw = blockIdx.x * NWAVES + wave, NGW = gridDim.x * NWAVES;
    const float* mod = (const float*)(p.ws + WS_MOD); bf16_t* hb = (bf16_t*)(p.ws + WS_HB);
    f32x4 na[4] = {}, nb[4] = {};
    auto srcof = [&](int row) { return row < NLAT ? p.x + (size_t)row * D : p.ctx + (size_t)(row - NLAT) * D; };
    auto fetch = [&](f32x4 (&d)[4], int row) { if (row < NTOK) { const float* s_ = srcof(row);
#pragma unroll
        for (int j = 0; j < 4; ++j) d[j] = ((const f32x4*)s_)[lane + 64 * j]; } };
    auto finish = [&](const f32x4 (&v)[4], int row) {
        const int mr = row < NLAT ? row / T : 8; const float* sh = mod + (size_t)mr * NMOD, * sc = sh + D; bf16_t* dst = hb + (size_t)row * D;
        float s = 0.f;
#pragma unroll
        for (int j = 0; j < 4; ++j) s += (v[j][0] * v[j][0] + v[j][1] * v[j][1]) + (v[j][2] * v[j][2] + v[j][3] * v[j][3]);
        const float rstd = rsqrtf(wave_sum_fast(s) * (1.f / D) + EPS);
#pragma unroll
        for (int j = 0; j < 4; ++j) { const int i4 = lane + 64 * j; const f32x4 gg = ((const f32x4*)p.g_norm1)[i4], s1 = ((const f32x4*)sc)[i4], h1 = ((const f32x4*)sh)[i4];
            const f32x4 o = v[j] * rstd * gg * (s1 + 1.f) + h1; u32x2 w; w.x = cvt_pk_bf16(o[0], o[1]); w.y = cvt_pk_bf16(o[2], o[3]); ((u32x2*)dst)[i4] = w; } };
    fetch(na, gw); fetch(nb, gw + NGW);
    for (int row = gw; row < NTOK; row += 2 * NGW) {
        f32x4 ca[4];
#pragma unroll
        for (int j = 0; j < 4; ++j) ca[j] = na[j];
        fetch(na, row + 2 * NGW);
        finish(ca, row);
        if (row + NGW < NTOK) {
#pragma unroll
            for (int j = 0; j < 4; ++j) ca[j] = nb[j];
            fetch(nb, row + 3 * NGW);
            finish(ca, row + NGW);
        }
    }
}

__device__ __forceinline__ int ml_row0(int b, int blk) { return blk == 0 ? NLAT + b * TC : b * T + (blk - 1) * MCH; }
__device__ __forceinline__ void conv_silu8(const bf16_t* cols, const float* convw, int row, int seg_lo, int seg_hi, int ch0, float (&o)[8]) {
    const u32x4 z = {0u, 0u, 0u, 0u};
    const u32x4 a = (row - 1 >= seg_lo) ? *(const u32x4*)(cols + (size_t)(row - 1) * INCP + C_MQ + ch0) : z;
    const u32x4 b = *(const u32x4*)(cols + (size_t)row * INCP + C_MQ + ch0);
    const u32x4 c = (row + 1 < seg_hi) ? *(const u32x4*)(cols + (size_t)(row + 1) * INCP + C_MQ + ch0) : z;
#pragma unroll
    for (int i = 0; i < 4; ++i) {
        const float w0a = convw[0 * 512 + ch0 + 2 * i], w1a = convw[1 * 512 + ch0 + 2 * i], w2a = convw[2 * 512 + ch0 + 2 * i];
        const float w0b = convw[0 * 512 + ch0 + 2 * i + 1], w1b = convw[1 * 512 + ch0 + 2 * i + 1], w2b = convw[2 * 512 + ch0 + 2 * i + 1];
        o[2 * i] = siluf(w0a * bf_lo(a[i]) + w1a * bf_lo(b[i]) + w2a * bf_lo(c[i]));
        o[2 * i + 1] = siluf(w0b * bf_hi(a[i]) + w1b * bf_hi(b[i]) + w2b * bf_hi(c[i]));
    }
}
__device__ __forceinline__ float scan_sum256(LAS float* sc, float v, int tid) {
    const int i = tid & 255; __syncthreads(); sc[tid] = v; __syncthreads();
#pragma unroll
    for (int off = 1; off < 256; off <<= 1) { float t = sc[tid]; if (i >= off) t += sc[tid - off]; __syncthreads(); sc[tid] = t; __syncthreads(); }
    return sc[tid];
}
__device__ __forceinline__ float scan_max256(LAS float* sc, float v, int tid) {
    const int i = tid & 255; __syncthreads(); sc[tid] = v; __syncthreads();
#pragma unroll
    for (int off = 1; off < 256; off <<= 1) { float t = sc[tid]; if (i >= off) t = fmaxf(t, sc[tid - off]); __syncthreads(); sc[tid] = t; __syncthreads(); }
    return sc[tid];
}

constexpr int VT_LD = 264;
__device__ __forceinline__ void ml_summary_unit(const Params& p, LAS unsigned char* lds, int unit, const int tidx) {
    const int tid = tidx, lane = tid & 63, wave = tid >> 6;
    const int blk = unit % 17, h = (unit / 17) % MH, b = unit / (17 * MH);
    const int row0 = ml_row0(b, blk), seg_lo = blk == 0 ? NLAT + b * TC : b * T, seg_hi = blk == 0 ? seg_lo + TC : seg_lo + T;
    const bf16_t* cols = (const bf16_t*)(p.ws + WS_COLS); const float* gates = (const float*)(p.ws + WS_GATES);
    LAS bf16_t* vT = (LAS bf16_t*)lds;
    LAS bf16_t* kfT = vT + 128 * VT_LD;
    LAS bf16_t* kbT = kfT + 64 * VT_LD;
    LAS float* sc = (LAS float*)(kbT + 64 * VT_LD);
    LAS float* wgt = sc + 512;
    LAS float* red = wgt + 512;
    __syncthreads();
    const int d = tid >> 8, i = tid & 255, tau = d ? 255 - i : i;
    const float graw_i = gates[(size_t)(row0 + tau) * 16 + d * 4 + h], graw_f = gates[(size_t)(row0 + tau) * 16 + 8 + d * 4 + h];
    const float ig = graw_i + p.b_igate[d * 4 + h], lf = logsigmoidf_(graw_f + p.b_fgate[d * 4 + h]);
    const float cum = scan_sum256(sc, lf, tid);
    const float F = sc[d * 256 + 255];
    const float a = (F - cum) + ig;
    const float mloc = scan_max256(sc, a, tid);
    const float mx = sc[d * 256 + 255];
    (void)mloc;
    wgt[d * 256 + tau] = __expf(a - mx);
    if (i == 0) { float* ms = (float*)(p.ws + WS_MSCAL) + ((((size_t)d * NB + b) * MH + h) * 17 + blk) * 2; ms[0] = F; ms[1] = mx; }
    __syncthreads();
    { const int t = tid & 255, hf = tid >> 8; const int row = row0 + t;
      const float wf = wgt[t], wb = wgt[256 + t];
#pragma unroll 2
      for (int c8 = 0; c8 < 8; ++c8) { const int ch = 64 * hf + 8 * c8; const u32x4 v = *(const u32x4*)(cols + (size_t)row * INCP + C_MV + h * MDV + ch);
#pragma unroll
          for (int q = 0; q < 4; ++q) { vT[(ch + 2 * q) * VT_LD + t] = (bf16_t)(v[q] & 0xffffu); vT[(ch + 2 * q + 1) * VT_LD + t] = (bf16_t)(v[q] >> 16); } }
#pragma unroll 1
      for (int c8 = 0; c8 < 4; ++c8) { const int ch = 32 * hf + 8 * c8; float kv[8]; conv_silu8(cols, p.conv_qk, row, seg_lo, seg_hi, 256 + h * MDK + ch, kv);
#pragma unroll
          for (int q = 0; q < 8; ++q) { kfT[(ch + q) * VT_LD + t] = f2bf(kv[q] * wf); kbT[(ch + q) * VT_LD + t] = f2bf(kv[q] * wb); } }
    }
    __syncthreads();
    { const int dvb = wave & 3, dkb = wave >> 2, r = lane & 31, hh = lane >> 5;
      f32x16 accf = {}, accb = {};
#pragma unroll 2
      for (int ks = 0; ks < 16; ++ks) { const int t0 = 16 * ks + 8 * hh;
          const bf16x8 av = *(const LAS bf16x8*)(vT + (dvb * 32 + r) * VT_LD + t0);
          const bf16x8 bf = *(const LAS bf16x8*)(kfT + (dkb * 32 + r) * VT_LD + t0);
          const bf16x8 bb = *(const LAS bf16x8*)(kbT + (dkb * 32 + r) * VT_LD + t0);
          accf = __builtin_amdgcn_mfma_f32_32x32x16_bf16(av, bf, accf, 0, 0, 0);
          accb = __builtin_amdgcn_mfma_f32_32x32x16_bf16(av, bb, accb, 0, 0, 0); }
      float* Uf = (float*)(p.ws + WS_U) + ((((size_t)0 * NB + b) * MH + h) * 17 + blk) * (MDV * MDK);
      float* Ub = (float*)(p.ws + WS_U) + ((((size_t)1 * NB + b) * MH + h) * 17 + blk) * (MDV * MDK);
#pragma unroll
      for (int q = 0; q < 16; ++q) { const int dv = dvb * 32 + crow(q, hh), dk = dkb * 32 + r; Uf[dv * MDK + dk] = accf[q]; Ub[dv * MDK + dk] = accb[q]; }
    }
    if (tid < 128) { const int dd = tid >> 6, dk = tid & 63; const LAS bf16_t* rowp = (dd ? kbT : kfT) + dk * VT_LD; float s = 0.f;
        for (int t = 0; t < 256; ++t) s += bf2f(rowp[t]);
        ((float*)(p.ws + WS_NL))[((((size_t)dd * NB + b) * MH + h) * 17 + blk) * MDK + dk] = s; }
    (void)red;
}

__device__ __forceinline__ int ml_blkof(int d, int j) { return d == 0 ? j : (j == 0 ? 0 : 17 - j); }
__device__ __forceinline__ void phase_ml_scan(const Params& p, const int tidx) {
    const int gt = blockIdx.x * NTHREADS + tidx, NGT = gridDim.x * NTHREADS;
    const float* ms = (const float*)(p.ws + WS_MSCAL); const float* U = (const float*)(p.ws + WS_U); const float* NL = (const float*)(p.ws + WS_NL);
    bf16_t* cst = (bf16_t*)(p.ws + WS_CST); float* nst = (float*)(p.ws + WS_NST); float* mst = (float*)(p.ws + WS_MST);
    constexpr int EPS_ = MDV * MDK + MDK;
    for (int e = gt; e < 64 * EPS_; e += NGT) {
        const int s = e / EPS_, el = e % EPS_;
        const int d = s / (NB * MH);
        float u[16];
#pragma unroll
        for (int j = 0; j < 16; ++j) { const int blk = ml_blkof(d, j); u[j] = (el < MDV * MDK) ? U[((size_t)s * 17 + blk) * (MDV * MDK) + el] : NL[((size_t)s * 17 + blk) * MDK + (el - MDV * MDK)]; }
        float m = 0.f, C = 0.f;
#pragma unroll
        for (int j = 0; j < 16; ++j) { const int blk = ml_blkof(d, j); const float F = ms[((size_t)s * 17 + blk) * 2], ml = ms[((size_t)s * 17 + blk) * 2 + 1];
            const float mn = fmaxf(F + m, ml); C = __expf(F + m - mn) * C + __expf(ml - mn) * u[j]; m = mn;
            if (el < MDV * MDK) cst[((size_t)s * 16 + j) * (MDV * MDK) + el] = f2bf(C); else nst[((size_t)s * 16 + j) * MDK + (el - MDV * MDK)] = C;
            if (el == 0) mst[(size_t)s * 16 + j] = m; }
    }
}

constexpr int QK_LD = 72;
__device__ __forceinline__ void ml_output_unit(const Params& p, LAS unsigned char* lds, int unit, const int tidx) {
    const int tid = tidx, lane = tid & 63, wave = tid >> 6;
    const int ib = unit % NBLK, h = (unit / NBLK) % MH, b = unit / (NBLK * MH);
    const int blk = ib + 1, row0 = ml_row0(b, blk), seg_lo = b * T, seg_hi = seg_lo + T;
    const bf16_t* cols = (const bf16_t*)(p.ws + WS_COLS); const float* gates = (const float*)(p.ws + WS_GATES);
    LAS bf16_t* vT = (LAS bf16_t*)lds;
    LAS bf16_t* qs = vT + 128 * VT_LD;
    LAS bf16_t* ks_ = qs + 256 * QK_LD;
    LAS float* sc = (LAS float*)(ks_ + 256 * QK_LD);
    LAS float* alpha = sc + 512;
    LAS float* beta = alpha + 512, *sint = beta + 512, *flr = sint + 512;
    LAS float* nv = flr + 512;
    __syncthreads();
    {
        const int d = tid >> 8, i = tid & 255, tau = d ? 255 - i : i;
        const float graw_i = gates[(size_t)(row0 + tau) * 16 + d * 4 + h], graw_f = gates[(size_t)(row0 + tau) * 16 + 8 + d * 4 + h];
        const float ig = graw_i + p.b_igate[d * 4 + h], lf = logsigmoidf_(graw_f + p.b_fgate[d * 4 + h]);
        const float cum = scan_sum256(sc, lf, tid);
        const float bt = ig - cum;
        const float pm = scan_max256(sc, bt, tid);
        const int sidx = d == 0 ? ib : 15 - ib;
        const int s = (d * NB + b) * MH + h;
        const float mprev = ((const float*)(p.ws + WS_MST))[(size_t)s * 16 + sidx];
        const float mt = fmaxf(cum + mprev, cum + pm);
        alpha[d * 256 + tau] = cum - mt; beta[d * 256 + tau] = bt; sint[d * 256 + tau] = __expf(cum + mprev - mt); flr[d * 256 + tau] = __expf(-mt);
        if (i < 64) nv[d * 64 + i] = ((const float*)(p.ws + WS_NST))[((size_t)s * 16 + sidx) * MDK + i];
    }
    {
        const int t = tid & 255, hf = tid >> 8; const int row = row0 + t;
#pragma unroll
        for (int c8 = 0; c8 < 8; ++c8) { const int ch = 64 * hf + 8 * c8; const u32x4 v = *(const u32x4*)(cols + (size_t)row * INCP + C_MV + h * MDV + ch);
#pragma unroll
            for (int q = 0; q < 4; ++q) { vT[(ch + 2 * q) * VT_LD + t] = (bf16_t)(v[q] & 0xffffu); vT[(ch + 2 * q + 1) * VT_LD + t] = (bf16_t)(v[q] >> 16); } }
#pragma unroll
        for (int c8 = 0; c8 < 4; ++c8) { const int ch = 32 * hf + 8 * c8; float kv[8], qv[8];
            conv_silu8(cols, p.conv_qk, row, seg_lo, seg_hi, 256 + h * MDK + ch, kv); conv_silu8(cols, p.conv_qk, row, seg_lo, seg_hi, h * MDK + ch, qv);
            u32x4 kw, qw;
#pragma unroll
            for (int q = 0; q < 4; ++q) { kw[q] = cvt_pk_bf16(kv[2 * q], kv[2 * q + 1]); qw[q] = cvt_pk_bf16(qv[2 * q] * 0.125f, qv[2 * q + 1] * 0.125f); }
            *(LAS u32x4*)(ks_ + t * QK_LD + ch) = kw; *(LAS u32x4*)(qs + t * QK_LD + ch) = qw; }
    }
    __syncthreads();
    const int c = lane & 31, hh = lane >> 5, tq = 32 * wave + c;
    bf16x8 qf[4];
#pragma unroll
    for (int ks = 0; ks < 4; ++ks) qf[ks] = *(const LAS bf16x8*)(qs + tq * QK_LD + 16 * ks + 8 * hh);
    f32x16 hsum[4];
#pragma unroll
    for (int dvb = 0; dvb < 4; ++dvb) hsum[dvb] = (f32x16){};
#pragma unroll 1
    for (int d = 0; d < 2; ++d) {
        const int sidx = d == 0 ? ib : 15 - ib; const int s = (d * NB + b) * MH + h;
        const bf16_t* Cst = (const bf16_t*)(p.ws + WS_CST) + ((size_t)s * 16 + sidx) * (MDV * MDK);
        const float al = alpha[d * 256 + tq], si = sint[d * 256 + tq], fl = flr[d * 256 + tq];
        f32x16 acc[4];
#pragma unroll
        for (int dvb = 0; dvb < 4; ++dvb) { f32x16 t = {};
#pragma unroll
            for (int ks = 0; ks < 4; ++ks) { const bf16x8 af = *(const bf16x8*)(Cst + (size_t)(dvb * 32 + c) * MDK + 16 * ks + 8 * hh); t = __builtin_amdgcn_mfma_f32_32x32x16_bf16(af, qf[ks], t, 0, 0, 0); }
            acc[dvb] = t * si; if (dvb & 1) asm volatile("" ::: "memory"); }
        float nq = 0.f;
#pragma unroll
        for (int j = 0; j < 32; ++j) nq += nv[d * 64 + 32 * hh + j] * bf2f(qs[tq * QK_LD + 32 * hh + j]);
        nq += __shfl_xor(nq, 32);
        float den = 0.f;
        const int sb_lo = d == 0 ? 0 : wave, sb_hi = d == 0 ? wave : 7;
#pragma unroll 1
        for (int sb = sb_lo; sb <= sb_hi; ++sb) {
            f32x16 st = {};
#pragma unroll
            for (int ks = 0; ks < 4; ++ks) { const bf16x8 af = *(const LAS bf16x8*)(ks_ + (32 * sb + c) * QK_LD + 16 * ks + 8 * hh); st = __builtin_amdgcn_mfma_f32_32x32x16_bf16(af, qf[ks], st, 0, 0, 0); }
#pragma unroll
            for (int q = 0; q < 16; ++q) { const int sg = 32 * sb + crow(q, hh); const float w = __expf(al + beta[d * 256 + sg]) * st[q];
                const bool ok = d == 0 ? (sg <= tq) : (sg >= tq); st[q] = ok ? w : 0.f; den += st[q]; }
            bf16x8 wf[2];
#pragma unroll
            for (int s2 = 0; s2 < 2; ++s2) { u32x4 w; w.x = cvt_pk_bf16(st[8 * s2 + 0], st[8 * s2 + 1]); w.y = cvt_pk_bf16(st[8 * s2 + 2], st[8 * s2 + 3]); w.z = cvt_pk_bf16(st[8 * s2 + 4], st[8 * s2 + 5]); w.w = cvt_pk_bf16(st[8 * s2 + 6], st[8 * s2 + 7]);
                wf[s2] = __builtin_bit_cast(bf16x8, w); }
#pragma unroll
            for (int dvb = 0; dvb < 4; ++dvb)
#pragma unroll
                for (int s2 = 0; s2 < 2; ++s2) { const LAS bf16_t* vp = vT + (dvb * 32 + c) * VT_LD + 32 * sb + 16 * s2 + 4 * hh;
                    const s16x4 lo = *(const LAS s16x4*)vp, hi = *(const LAS s16x4*)(vp + 8);
                    const bf16x8 af = {lo[0], lo[1], lo[2], lo[3], hi[0], hi[1], hi[2], hi[3]};
                    acc[dvb] = __builtin_amdgcn_mfma_f32_32x32x16_bf16(af, wf[s2], acc[dvb], 0, 0, 0); }
        }
        den += __shfl_xor(den, 32);
        const float dt = den + si * nq; const float inv = 1.f / fmaxf(fabsf(dt), fl);
#pragma unroll
        for (int dvb = 0; dvb < 4; ++dvb) hsum[dvb] += acc[dvb] * inv;
    }
    float ss = 0.f;
#pragma unroll
    for (int dvb = 0; dvb < 4; ++dvb)
#pragma unroll
        for (int q = 0; q < 16; ++q) ss += hsum[dvb][q] * hsum[dvb][q];
    ss += __shfl_xor(ss, 32);
    const float rstd = rsqrtf(ss * (1.f / MDV) + EPS);
    const int row = row0 + tq; bf16_t* mix = (bf16_t*)(p.ws + WS_MIX) + (size_t)row * D + 512 + h * MDV;
    const bf16_t* orow = cols + (size_t)row * INCP + C_MO + h * MDV;
#pragma unroll
    for (int dvb = 0; dvb < 4; ++dvb)
#pragma unroll
        for (int q4 = 0; q4 < 4; ++q4) { const int dv = dvb * 32 + 8 * q4 + 4 * hh; const u32x2 ow = *(const u32x2*)(orow + dv); const f32x4 gg = *(const f32x4*)(p.g_mlstm + h * MDV + dv);
            const float o0 = sigmoidf_(bf_lo(ow.x)) * hsum[dvb][4 * q4 + 0] * rstd * gg[0], o1 = sigmoidf_(bf_hi(ow.x)) * hsum[dvb][4 * q4 + 1] * rstd * gg[1];
            const float o2 = sigmoidf_(bf_lo(ow.y)) * hsum[dvb][4 * q4 + 2] * rstd * gg[2], o3 = sigmoidf_(bf_hi(ow.y)) * hsum[dvb][4 * q4 + 3] * rstd * gg[3];
            u32x2 w; w.x = cvt_pk_bf16(o0, o1); w.y = cvt_pk_bf16(o2, o3); *(u32x2*)(mix + dv) = w; }
}

__device__ __forceinline__ void phase_mla_fin(const Params& p, LAS unsigned char* lds, const int tidx) {
    const int lane = tidx & 63, wave = tidx >> 6;
    const int gw = blockIdx.x * NWAVES + wave, NGW = gridDim.x * NWAVES;
    LAS float* sq = (LAS float*)(lds + wave * 8192);
    const bf16_t* cols = (const bf16_t*)(p.ws + WS_COLS); const bf16_t* qraw = (const bf16_t*)(p.ws + WS_QRAW); const bf16_t* kvraw = (const bf16_t*)(p.ws + WS_KVRAW);
    const float* ssq = (const float*)(p.ws + WS_SSQ); const float* rt = (const float*)(p.ws + WS_ROPE);
    bf16_t* Q = (bf16_t*)(p.ws + WS_Q); bf16_t* Kb = (bf16_t*)(p.ws + WS_K); bf16_t* VT = (bf16_t*)(p.ws + WS_VT);
#pragma unroll 2
    for (int row = gw; row < NLAT; row += NGW) {
        const int b = row / T; const int t = row % T; const int prow = t >> 6, pcol = t & 63;
        const f32x4 sq4 = *(const f32x4*)(ssq + (size_t)row * 8);
        const float rq = rsqrtf(((sq4[0] + sq4[1]) + (sq4[2] + sq4[3])) * (1.f / 256.f) + EPS);
        {
            const bf16_t* qp = qraw + (size_t)row * 768 + 12 * lane;
            const u32x2 a0 = *(const u32x2*)qp, a1 = *(const u32x2*)(qp + 4), a2 = *(const u32x2*)(qp + 8);
            float v[12] = {bf_lo(a0.x), bf_hi(a0.x), bf_lo(a0.y), bf_hi(a0.y), bf_lo(a1.x), bf_hi(a1.x), bf_lo(a1.y), bf_hi(a1.y), bf_lo(a2.x), bf_hi(a2.x), bf_lo(a2.y), bf_hi(a2.y)};
            float s = 0.f;
#pragma unroll
            for (int q = 0; q < 12; ++q) { v[q] *= rq; s += v[q] * v[q]; }
            s = row_sum_f(s);
            const float rh = rsqrtf(s * (1.f / 192.f) + EPS);
            const int hd = lane >> 4, off = (lane & 15) * 12;
#pragma unroll
            for (int q = 0; q < 12; ++q) sq[12 * lane + q] = v[q] * rh * p.g_qn[off + q];
            asm volatile("s_waitcnt lgkmcnt(0)" ::: "memory");
            bf16_t* qo = Q + (((size_t)b * NH + hd) * T + t) * DQK + off;
            float o[12];
#pragma unroll
            for (int q = 0; q < 12; ++q) { const int dd = off + q; float val = sq[12 * lane + q];
                if (dd >= 128) { const int j = dd - 128, part = j >> 5, jj = j & 31, fi = jj & 15; const bool second = jj >= 16; const int pos = part ? pcol : prow;
                    const float cs = rt[(pos * 16 + fi) * 2], sn = rt[(pos * 16 + fi) * 2 + 1];
                    const float pt = sq[hd * 192 + 128 + part * 32 + (jj ^ 16)];
                    val = second ? (val * cs + pt * sn) : (val * cs - pt * sn); }
                o[q] = val; }
            u32x2 w0, w1, w2; w0.x = cvt_pk_bf16(o[0], o[1]); w0.y = cvt_pk_bf16(o[2], o[3]); w1.x = cvt_pk_bf16(o[4], o[5]); w1.y = cvt_pk_bf16(o[6], o[7]); w2.x = cvt_pk_bf16(o[8], o[9]); w2.y = cvt_pk_bf16(o[10], o[11]);
            *(u32x2*)qo = w0; *(u32x2*)(qo + 4) = w1; *(u32x2*)(qo + 8) = w2;
            asm volatile("s_waitcnt lgkmcnt(0)" ::: "memory");
        }
    }
}

constexpr int AK_LD = 200;
constexpr int AV_LD = 68;
constexpr int A_KBYTES = 64 * AK_LD * 2, A_VBYTES = 128 * AV_LD * 2;
constexpr int AQ_LD = 72;
__device__ __forceinline__ void attn_unit(const Params& p, LAS unsigned char* lds, int unit, const int tidx) {
    const int tid = tidx, lane = tid & 63, wave = tid >> 6;
    const int qb = unit % (T / 256), h = (unit / (T / 256)) % NH, b = unit / ((T / 256) * NH);
    const bf16_t* Q = (const bf16_t*)(p.ws + WS_Q) + (((size_t)b * NH + h) * T + qb * 256) * DQK;
    const bf16_t* Kg = (const bf16_t*)(p.ws + WS_K) + ((size_t)b * NH + h) * NKEY * DQK;
    const bf16_t* Vg = (const bf16_t*)(p.ws + WS_VT) + ((size_t)b * NH + h) * NKEY * DV;
    const int c = lane & 31, hh = lane >> 5, tq = 32 * wave + c;
    constexpr float CS = 0.07216878364870322f * 1.4426950408889634f;
    bf16x8 qf[8];
#pragma unroll
    for (int ks = 0; ks < 8; ++ks) qf[ks] = *(const bf16x8*)(Q + (size_t)tq * DQK + 16 * ks + 8 * hh);
    LAS bf16_t* Qr = (LAS bf16_t*)(lds + 2 * (A_KBYTES + A_VBYTES));
    __syncthreads();
#pragma unroll
    for (int ks = 8; ks < 12; ++ks) *(LAS bf16x8*)(Qr + tq * AQ_LD + 16 * (ks - 8) + 8 * hh) = *(const bf16x8*)(Q + (size_t)tq * DQK + 16 * ks + 8 * hh);
    f32x16 o[4];
#pragma unroll
    for (int dvb = 0; dvb < 4; ++dvb) o[dvb] = (f32x16){};
    float m = -INFINITY, l = 0.f;
    u32x4 kreg[3], vreg[2];
    const unsigned kofs = (unsigned)tid * 16u, vofs = (unsigned)(tid & 63) * (unsigned)(DV * 2) + (unsigned)(tid >> 6) * 16u;
    unsigned klo[3];
#pragma unroll
    for (int i = 0; i < 3; ++i) { const int ch = tid + 512 * i; klo[i] = (unsigned)((ch / 24) * (AK_LD * 2) + (ch % 24) * 16); }
    const unsigned vlo = (unsigned)(tid >> 6) * 8u * (unsigned)(AV_LD * 2) + (unsigned)(tid & 63) * 2u;
    auto load_k = [&](int kt) { const char* kb = (const char*)Kg + (size_t)kt * (64 * DQK * 2);
#pragma unroll
        for (int i = 0; i < 3; ++i) kreg[i] = *(const u32x4*)(kb + kofs + i * 8192); };
    auto load_v = [&](int kt) { const char* vb = (const char*)Vg + (size_t)kt * (64 * DV * 2);
#pragma unroll
        for (int i = 0; i < 2; ++i) vreg[i] = *(const u32x4*)(vb + vofs + i * 128); };
    auto store_k = [&](int buf) { LAS unsigned char* Ks = lds + buf * A_KBYTES;
#pragma unroll
        for (int i = 0; i < 3; ++i) *(LAS u32x4*)(Ks + klo[i]) = kreg[i]; };
    auto store_v = [&](int buf) { LAS unsigned char* Vs = lds + 2 * A_KBYTES + buf * A_VBYTES;
#pragma unroll
        for (int i = 0; i < 2; ++i) { LAS bf16_t* dp = (LAS bf16_t*)(Vs + vlo + i * (64 * AV_LD * 2));
            dp[0 * AV_LD] = (bf16_t)(vreg[i].x & 0xffffu); dp[1 * AV_LD] = (bf16_t)(vreg[i].x >> 16); dp[2 * AV_LD] = (bf16_t)(vreg[i].y & 0xffffu); dp[3 * AV_LD] = (bf16_t)(vreg[i].y >> 16);
            dp[4 * AV_LD] = (bf16_t)(vreg[i].z & 0xffffu); dp[5 * AV_LD] = (bf16_t)(vreg[i].z >> 16); dp[6 * AV_LD] = (bf16_t)(vreg[i].w & 0xffffu); dp[7 * AV_LD] = (bf16_t)(vreg[i].w >> 16); } };
    constexpr int NT = NKEY / 64;
    f32x16 p0 = {}, p1 = {}; bf16x8 pf[4] = {};
#define AT_QK(kbuf) do { const LAS bf16_t* Ks = (const LAS bf16_t*)(lds + (kbuf) * A_KBYTES); p0 = (f32x16){}; p1 = (f32x16){}; \
        _Pragma("unroll") for (int ks = 0; ks < 12; ++ks) { \
            const bf16x8 a0 = *(const LAS bf16x8*)(Ks + c * AK_LD + 16 * ks + 8 * hh), a1 = *(const LAS bf16x8*)(Ks + (32 + c) * AK_LD + 16 * ks + 8 * hh); \
            const bf16x8 qv = ks < 8 ? qf[ks < 8 ? ks : 0] : *(const LAS bf16x8*)(Qr + tq * AQ_LD + 16 * (ks - 8) + 8 * hh); \
            p0 = __builtin_amdgcn_mfma_f32_32x32x16_bf16(a0, qv, p0, 0, 0, 0); p1 = __builtin_amdgcn_mfma_f32_32x32x16_bf16(a1, qv, p1, 0, 0, 0); } } while (0)
#define AT_SM() do { float mx = p0[0]; \
        _Pragma("unroll") for (int q = 1; q < 16; ++q) mx = fmaxf(mx, p0[q]); \
        _Pragma("unroll") for (int q = 0; q < 16; ++q) mx = fmaxf(mx, p1[q]); \
        { auto r_ = __builtin_amdgcn_permlane32_swap(__float_as_uint(mx), __float_as_uint(mx), false, false); mx = fmaxf(__uint_as_float(r_[0]), __uint_as_float(r_[1])); } \
        const float mxs = mx * CS; \
        if (!__all(mxs <= m + 8.0f)) { const float mn = fmaxf(m, mxs), al = __builtin_amdgcn_exp2f(m - mn); m = mn; l *= al; \
            _Pragma("unroll") for (int dvb = 0; dvb < 4; ++dvb) o[dvb] *= al; } \
        float ps = 0.f; \
        _Pragma("unroll") for (int q = 0; q < 16; ++q) { p0[q] = __builtin_amdgcn_exp2f(fmaf(p0[q], CS, -m)); p1[q] = __builtin_amdgcn_exp2f(fmaf(p1[q], CS, -m)); ps += p0[q] + p1[q]; } \
        { auto r_ = __builtin_amdgcn_permlane32_swap(__float_as_uint(ps), __float_as_uint(ps), false, false); ps = __uint_as_float(r_[0]) + __uint_as_float(r_[1]); } \
        l += ps; \
        _Pragma("unroll") for (int s2 = 0; s2 < 2; ++s2) { u32x4 w; \
            w.x = cvt_pk_bf16(p0[8 * s2 + 0], p0[8 * s2 + 1]); w.y = cvt_pk_bf16(p0[8 * s2 + 2], p0[8 * s2 + 3]); w.z = cvt_pk_bf16(p0[8 * s2 + 4], p0[8 * s2 + 5]); w.w = cvt_pk_bf16(p0[8 * s2 + 6], p0[8 * s2 + 7]); pf[s2] = __builtin_bit_cast(bf16x8, w); \
            w.x = cvt_pk_bf16(p1[8 * s2 + 0], p1[8 * s2 + 1]); w.y = cvt_pk_bf16(p1[8 * s2 + 2], p1[8 * s2 + 3]); w.z = cvt_pk_bf16(p1[8 * s2 + 4], p1[8 * s2 + 5]); w.w = cvt_pk_bf16(p1[8 * s2 + 6], p1[8 * s2 + 7]); pf[2 + s2] = __builtin_bit_cast(bf16x8, w); } } while (0)
#define AT_PV(vbuf) do { const LAS bf16_t* Vs = (const LAS bf16_t*)(lds + 2 * A_KBYTES + (vbuf) * A_VBYTES); \
        _Pragma("unroll") for (int dvb = 0; dvb < 4; ++dvb) _Pragma("unroll") for (int s4 = 0; s4 < 4; ++s4) { const LAS bf16_t* vp = Vs + (dvb * 32 + c) * AV_LD + 16 * s4 + 4 * hh; \
            const s16x4 lo = *(const LAS s16x4*)vp, hi = *(const LAS s16x4*)(vp + 8); const bf16x8 af = {lo[0], lo[1], lo[2], lo[3], hi[0], hi[1], hi[2], hi[3]}; \
            o[dvb] = __builtin_amdgcn_mfma_f32_32x32x16_bf16(af, pf[s4], o[dvb], 0, 0, 0); } } while (0)
    __syncthreads();
    load_k(0); store_k(0);
    const bool grpA = __builtin_amdgcn_readfirstlane(wave) < 4;
    if (grpA) {
#pragma unroll 1
        for (int j = 0; j <= NT; ++j) {
            __syncthreads();
            if (j + 1 < NT) load_k(j + 1);
            if (j < NT) load_v(j);
            if (j > 0) AT_PV((j - 1) & 1);
            if (j < NT) { AT_QK(j & 1); AT_SM(); }
            if (j + 1 < NT) store_k((j + 1) & 1);
            if (j < NT) store_v(j & 1);
        }
    } else {
#pragma unroll 1
        for (int j = 0; j <= NT; ++j) {
            __syncthreads();
            if (j + 1 < NT) load_k(j + 1);
            if (j < NT) load_v(j);
            if (j > 0) { AT_SM(); AT_PV((j - 1) & 1); }
            if (j < NT) AT_QK(j & 1);
            if (j + 1 < NT) store_k((j + 1) & 1);
            if (j < NT) store_v(j & 1);
        }
    }
#undef AT_QK
#undef AT_SM
#undef AT_PV
    const float inv = 1.f / l;
    bf16_t* mix = (bf16_t*)(p.ws + WS_MIX) + (size_t)(b * T + qb * 256 + tq) * D + h * DV;
#pragma unroll
    for (int dvb = 0; dvb < 4; ++dvb)
#pragma unroll
        for (int q4 = 0; q4 < 4; ++q4) { const int dv = dvb * 32 + 8 * q4 + 4 * hh; u32x2 w; w.x = cvt_pk_bf16(o[dvb][4 * q4] * inv, o[dvb][4 * q4 + 1] * inv); w.y = cvt_pk_bf16(o[dvb][4 * q4 + 2] * inv, o[dvb][4 * q4 + 3] * inv); *(u32x2*)(mix + dv) = w; }
}

__device__ __forceinline__ void phase_h2(const Params& p, const int tidx) {
    const int lane = tidx & 63, wave = tidx >> 6;
    const int gw = blockIdx.x * NWAVES + wave, NGW = gridDim.x * NWAVES;
    const float* mod = (const float*)(p.ws + WS_MOD); bf16_t* h2 = (bf16_t*)(p.ws + WS_H2);
    unsigned* h2q = (unsigned*)(p.ws + WS_H2Q); float* hs = (float*)(p.ws + WS_HS);
    f32x4 na[4] = {}, nb[4] = {};
    auto fetch = [&](f32x4 (&d)[4], int row) { if (row < NLAT) { const float* s_ = p.out + (size_t)row * D;
#pragma unroll
        for (int j = 0; j < 4; ++j) d[j] = ((const f32x4*)s_)[lane + 64 * j]; } };
    auto finish = [&](f32x4 (&v)[4], int row) {
        const int mr = row / T; const float* sh = mod + (size_t)mr * NMOD + 3 * D, * sc = mod + (size_t)mr * NMOD + 4 * D;
        float s = 0.f;
#pragma unroll
        for (int j = 0; j < 4; ++j) s += (v[j][0] * v[j][0] + v[j][1] * v[j][1]) + (v[j][2] * v[j][2] + v[j][3] * v[j][3]);
        const float rstd = rsqrtf(wave_sum_fast(s) * (1.f / D) + EPS); float m = 0.f;
#pragma unroll
        for (int j = 0; j < 4; ++j) { const int i4 = lane + 64 * j; const f32x4 gg = ((const f32x4*)p.g_norm2)[i4], s1 = ((const f32x4*)sc)[i4], h1 = ((const f32x4*)sh)[i4];
            v[j] = v[j] * rstd * gg * (s1 + 1.f) + h1; u32x2 w; w.x = cvt_pk_bf16(v[j][0], v[j][1]); w.y = cvt_pk_bf16(v[j][2], v[j][3]); ((u32x2*)(h2 + (size_t)row * D))[i4] = w;
            m = fmaxf(m, fmaxf(fmaxf(fabsf(v[j][0]), fabsf(v[j][1])), fmaxf(fabsf(v[j][2]), fabsf(v[j][3])))); }
        m = fmaxf(wave_max_fast(m), 1e-30f); const float inv = 127.f / m;
#pragma unroll
        for (int j = 0; j < 4; ++j) h2q[(size_t)row * 256 + lane + 64 * j] = q8pack(v[j], inv, 0);
        if (lane == 0) hs[row] = m * (1.f / 127.f); };
    fetch(na, gw); fetch(nb, gw + NGW);
    for (int row = gw; row < NLAT; row += 2 * NGW) {
        f32x4 ca[4];
#pragma unroll
        for (int j = 0; j < 4; ++j) ca[j] = na[j];
        fetch(na, row + 2 * NGW);
        finish(ca, row);
        if (row + NGW < NLAT) {
#pragma unroll
            for (int j = 0; j < 4; ++j) ca[j] = nb[j];
            fetch(nb, row + 3 * NGW);
            finish(ca, row + NGW);
        }
    }
}

__device__ __forceinline__ unsigned ord_key(float v) { const unsigned u = __float_as_uint(v); return (u & 0x80000000u) ? ~u : (u | 0x80000000u); }
__device__ __forceinline__ float ord_val(unsigned k) { const unsigned u = (k & 0x80000000u) ? (k & 0x7fffffffu) : ~k; return __uint_as_float(u); }
__device__ __forceinline__ unsigned med3u(unsigned a, unsigned b, unsigned c) { const unsigned mx = a > b ? a : b, mn = a > b ? b : a; const unsigned t = mx < c ? mx : c; return mn > t ? mn : t; }
__device__ __forceinline__ void ins16(unsigned (&top)[16], unsigned x) {
    unsigned n[16];
    n[0] = top[0] > x ? top[0] : x;
#pragma unroll
    for (int i = 1; i < 16; ++i) n[i] = med3u(x, top[i - 1], top[i]);
#pragma unroll
    for (int i = 0; i < 16; ++i) top[i] = n[i];
}
__device__ __forceinline__ void peer_topk_unit(const Params& p, LAS unsigned char* lds, int unit, const int tidx) {
    const int lane = tidx & 63, h = tidx >> 6;
    const int c = lane & 31, hh = lane >> 5, tok = unit * 32 + c;
    const bf16_t* qp = (const bf16_t*)(p.ws + WS_QP) + (size_t)tok * 2048 + h * 256;
    const bf16_t* skb = (const bf16_t*)(p.ws + WS_SKB) + (size_t)h * 2 * NKEYS * 128;
    unsigned top[2][16];
    {
        unsigned cur[16], sav[16];
#pragma unroll
        for (int i = 0; i < 16; ++i) sav[i] = 0u;
        bf16x8 qf[8], afA[8], afB[8];
#define TK_LOADA(dst, pp_, kb_) do { _Pragma("unroll") for (int ks = 0; ks < 8; ++ks) dst[ks] = *(const bf16x8*)(skb + ((size_t)(pp_) * NKEYS + (kb_) * 32 + c) * 128 + 16 * ks + 8 * hh); } while (0)
#define TK_STAGE(af, kb_) do { f32x16 s; _Pragma("unroll") for (int q = 0; q < 16; ++q) s[q] = 64.f; \
        _Pragma("unroll") for (int ks = 0; ks < 8; ++ks) s = __builtin_amdgcn_mfma_f32_32x32x16_bf16(af[ks], qf[ks], s, 0, 0, 0); \
        _Pragma("unroll") for (int q = 0; q < 16; ++q) { const unsigned key = (__float_as_uint(fmaxf(s[q], 0.f)) & ~127u) | (unsigned)((kb_) * 32 + crow(q, hh)); ins16(cur, key); } } while (0)
#pragma unroll 1
        for (int pp = 0; pp < 2; ++pp) {
#pragma unroll
            for (int i = 0; i < 16; ++i) cur[i] = 0u;
#pragma unroll
            for (int ks = 0; ks < 8; ++ks) qf[ks] = *(const bf16x8*)(qp + pp * 128 + 16 * ks + 8 * hh);
            TK_LOADA(afA, pp, 0);
#pragma unroll 1
            for (int kb = 0; kb < 4; kb += 2) {
                TK_LOADA(afB, pp, kb + 1);
                TK_STAGE(afA, kb);
                if (kb + 2 < 4) TK_LOADA(afA, pp, kb + 2);
                TK_STAGE(afB, kb + 1);
            }
            unsigned oth[16];
#pragma unroll
            for (int i = 0; i < 16; ++i) { auto r_ = __builtin_amdgcn_permlane32_swap(cur[i], cur[i], false, false); oth[i] = hh ? r_[0] : r_[1]; }
#pragma unroll
            for (int i = 0; i < 16; ++i) ins16(cur, oth[i]);
            if (pp == 0) {
#pragma unroll
                for (int i = 0; i < 16; ++i) sav[i] = cur[i];
            }
        }
#undef TK_LOADA
#undef TK_STAGE
#pragma unroll
        for (int i = 0; i < 16; ++i) { top[0][i] = sav[i]; top[1][i] = cur[i]; }
    }
    float va[16], vb[16];
#pragma unroll
    for (int i = 0; i < 16; ++i) { va[i] = __uint_as_float(top[0][i] & ~127u) - 112.f; vb[i] = __uint_as_float(top[1][i] & ~127u); }
    unsigned best[16];
#pragma unroll
    for (int i = 0; i < 16; ++i) best[i] = 0u;
#pragma unroll
    for (int i = 0; i < 16; ++i)
#pragma unroll
        for (int j = 0; j < 16; ++j) if ((i + 1) * (j + 1) <= 16) { const unsigned key = (__float_as_uint(fmaxf(va[i] + vb[j], 0.f)) & ~255u) | (unsigned)(i * 16 + j); ins16(best, key); }
    float sv[16]; float mx = -INFINITY;
#pragma unroll
    for (int i = 0; i < 16; ++i) { sv[i] = __uint_as_float(best[i] & ~255u); mx = fmaxf(mx, sv[i]); }
    float sum = 0.f;
#pragma unroll
    for (int i = 0; i < 16; ++i) { sv[i] = __expf(sv[i] - mx); sum += sv[i]; }
    const float inv = 1.f / sum;
    int eid[16]; unsigned tsel[16]; const unsigned hmask = hh ? 0xffffffffu : 0u;
#pragma unroll
    for (int q = 0; q < 16; ++q) tsel[q] = ((top[1][q] & hmask) | (top[0][q] & ~hmask)) & 127u;
#pragma unroll
    for (int i = 0; i < 16; ++i) { const unsigned pi = best[i] & 255u; const unsigned sel = hh ? (pi & 15u) : (pi >> 4);
        unsigned mine_ = 0;
#pragma unroll
        for (int q = 0; q < 16; ++q) mine_ = (sel == (unsigned)q) ? tsel[q] : mine_;
        auto r_ = __builtin_amdgcn_permlane32_swap(mine_, mine_, false, false); const unsigned oth_ = hh ? r_[0] : r_[1];
        eid[i] = hh ? (int)(oth_ * NKEYS + mine_) : (int)(mine_ * NKEYS + oth_); }
    LAS unsigned long long* cnt = (LAS unsigned long long*)lds;
    __syncthreads();
    if (hh == 0) { unsigned long long mine = 0ull;
#pragma unroll
        for (int i = 0; i < 16; ++i) mine += 1ull << (8 * (eid[i] >> 11));
        cnt[c * 8 + h] = mine; }
    __syncthreads();
    {
        unsigned long long tot = 0ull, bhead = 0ull;
#pragma unroll
        for (int h2 = 0; h2 < 8; ++h2) { const unsigned long long w = cnt[c * 8 + h2]; tot += w; bhead += (h2 < h) ? w : 0ull; }
        unsigned long long incl = tot; incl += incl << 8; incl += incl << 16; incl += incl << 32;
        const unsigned long long start = incl << 8;
        unsigned long long base = start + bhead;
        LAS u32x2* lp_ = (LAS u32x2*)(lds + 4096); LAS float* ls_ = (LAS float*)(lds + 4096 + 32768);
        const float* su_t = (const float*)(p.ws + WS_SU); const float* sv_t = (const float*)(p.ws + WS_SV);
#pragma unroll
        for (int i = 0; i < 16; ++i) { const int sh = 8 * (eid[i] >> 11); const unsigned pos = (unsigned)(base >> sh) & 0xffu; base += 1ull << sh;
            if ((i >> 3) == hh) { lp_[c * 128 + pos] = (u32x2){(unsigned)eid[i], __float_as_uint(sv[i] * inv * sv_t[eid[i]])}; ls_[c * 128 + pos] = su_t[eid[i]]; } }
        __syncthreads();
        { const int tok0 = unit * 32; const int tid_ = tidx;
          u32x4* gp = (u32x4*)((u32x2*)(p.ws + WS_CE) + (size_t)tok0 * 128); u32x4* gs = (u32x4*)((float*)(p.ws + WS_SUE) + (size_t)tok0 * 128);
#pragma unroll
          for (int r = 0; r < 4; ++r) { const int i4 = tid_ + 512 * r; gp[i4] = *(const LAS u32x4*)((LAS unsigned*)lp_ + 4 * i4); }
#pragma unroll
          for (int r = 0; r < 2; ++r) { const int i4 = tid_ + 512 * r; gs[i4] = *(const LAS u32x4*)(ls_ + 4 * i4); } }
        if (h == 0 && hh == 0) { unsigned char* of = (unsigned char*)(p.ws + WS_OFFS) + (size_t)tok * 16; *(unsigned long long*)of = start; of[8] = 128; }
    }
}

__device__ __forceinline__ float ub0(unsigned w) { float f; asm("v_cvt_f32_ubyte0 %0, %1" : "=v"(f) : "v"(w)); return f; }
__device__ __forceinline__ float ub1(unsigned w) { float f; asm("v_cvt_f32_ubyte1 %0, %1" : "=v"(f) : "v"(w)); return f; }
__device__ __forceinline__ float ub2(unsigned w) { float f; asm("v_cvt_f32_ubyte2 %0, %1" : "=v"(f) : "v"(w)); return f; }
__device__ __forceinline__ float ub3(unsigned w) { float f; asm("v_cvt_f32_ubyte3 %0, %1" : "=v"(f) : "v"(w)); return f; }
__device__ __forceinline__ void fma_ub4(float& a0, float& a1, float& a2, float& a3, float c, unsigned w) {
    float t0, t1, t2, t3;
    asm("v_cvt_f32_ubyte0 %4, %9\n\tv_cvt_f32_ubyte1 %5, %9\n\tv_cvt_f32_ubyte2 %6, %9\n\tv_cvt_f32_ubyte3 %7, %9\n\t"
        "v_fmac_f32 %0, %8, %4\n\tv_fmac_f32 %1, %8, %5\n\tv_fmac_f32 %2, %8, %6\n\tv_fmac_f32 %3, %8, %7"
        : "+v"(a0), "+v"(a1), "+v"(a2), "+v"(a3), "=&v"(t0), "=&v"(t1), "=&v"(t2), "=&v"(t3) : "v"(c), "v"(w));
}
__device__ __forceinline__ void fma_ub4m(float& a0, float& a1, float& a2, float& a3, float c, unsigned w, unsigned k64, unsigned s01, unsigned s23) {
    unsigned h0, h1;
    asm("v_perm_b32 %4, %7, %6, %8\n\tv_perm_b32 %5, %7, %6, %9\n\t"
        "v_fma_mix_f32 %0, %4, %10, %0 op_sel:[0,0,0] op_sel_hi:[1,0,0]\n\tv_fma_mix_f32 %1, %4, %10, %1 op_sel:[1,0,0] op_sel_hi:[1,0,0]\n\t"
        "v_fma_mix_f32 %2, %5, %10, %2 op_sel:[0,0,0] op_sel_hi:[1,0,0]\n\tv_fma_mix_f32 %3, %5, %10, %3 op_sel:[1,0,0] op_sel_hi:[1,0,0]"
        : "+v"(a0), "+v"(a1), "+v"(a2), "+v"(a3), "=&v"(h0), "=&v"(h1) : "v"(w), "v"(k64), "v"(s01), "v"(s23), "v"(c));
}
__device__ __forceinline__ int idot16(const u32x4 a, const u32x4 b, int acc) {
    acc = __builtin_amdgcn_sdot4((int)a.x, (int)b.x, acc, false); acc = __builtin_amdgcn_sdot4((int)a.y, (int)b.y, acc, false);
    acc = __builtin_amdgcn_sdot4((int)a.z, (int)b.z, acc, false); acc = __builtin_amdgcn_sdot4((int)a.w, (int)b.w, acc, false); return acc;
}
__device__ __forceinline__ float gelu_erf(float v) {
    const float av = fabsf(v), t = __builtin_amdgcn_rcpf(fmaf(av, 0.2316418882f, 1.0f));
    float q = fmaf(t, 0.5307027145f, -0.7265760135f); q = fmaf(q, t, 0.7107068705f); q = fmaf(q, t, -0.142248368f); q = fmaf(q, t, 0.127414796f); q *= t;
    const float e = __builtin_amdgcn_exp2f(v * v * -0.72134752044f), m = v * (q * e);
    return v < 0.f ? m : v - m;
}
constexpr int UCH = 4;
template <typename T_> __device__ __forceinline__ T_ ldnt(const T_* p) { return *p; }
__device__ __forceinline__ void phase_peer_u(const Params& p, LAS unsigned char* lds, const int tidx) {
    const int lane = tidx & 63, wave = tidx >> 6;
    const int x = blockIdx.x & 7, nbx = ((int)gridDim.x - x + 7) >> 3, wl = ((int)blockIdx.x >> 3) * NWAVES + wave, wstride = nbx * NWAVES;
    const unsigned char* eu8 = (const unsigned char*)(p.ws + WS_EU8); const unsigned char* h2q = (const unsigned char*)(p.ws + WS_H2Q);
    const float* sue = (const float*)(p.ws + WS_SUE); const float* hs = (const float*)(p.ws + WS_HS);
    u32x2* ce = (u32x2*)(p.ws + WS_CE); const unsigned char* offs = (const unsigned char*)(p.ws + WS_OFFS);
    u32x2* cdst = p.dup ? (u32x2*)(p.ws + WS_CE + 48 * MiB) : ce;
    const int g4 = lane >> 4, l16 = lane & 15, gbase = lane & 48; const unsigned l16x16 = (unsigned)l16 * 16u;
    (void)lds;
    const int ntok_w = (NLAT - wl + wstride - 1) / wstride;
    int f_tok = 0, f_o0 = 0, f_n = 0, f_e0 = 0, f_e1 = 0; float f_g0 = 0.f, f_g1 = 0.f, f_hs = 0.f; u32x4 f_hq[4] = {};
    float f_s0 = 0.f, f_s1 = 0.f;
    int h_tok = 0, h_o0 = 0, h_n = 0, h_e0 = 0, h_e1 = 0; float h_g0 = 0.f, h_g1 = 0.f, h_hs = 0.f, h_s0 = 0.f, h_s1 = 0.f; u32x4 h_hq[4] = {};
    int p_o2 = 0;
    auto fetch_offs = [&](int b0) { const int ti = b0 + g4; const int t_ = wl + wstride * (ti < ntok_w ? ti : 0); p_o2 = *(const unsigned short*)(offs + (size_t)t_ * 16 + x); };
    auto fetch = [&](int b0) {
        const int ti = b0 + g4; const bool tv = ti < ntok_w; h_tok = wl + wstride * (tv ? ti : 0);
        h_o0 = p_o2 & 0xff; h_n = tv ? (p_o2 >> 8) - h_o0 : 0;
        { const unsigned i0 = (unsigned)h_tok * 128u + (unsigned)min(h_o0 + l16, 127), i1 = (unsigned)h_tok * 128u + (unsigned)min(h_o0 + 16 + l16, 127);
          const u32x2 p0_ = ce[i0], p1_ = ce[i1]; h_e0 = (int)p0_.x; h_e1 = (int)p1_.x; h_g0 = __uint_as_float(p0_.y); h_g1 = __uint_as_float(p1_.y); h_s0 = sue[i0]; h_s1 = sue[i1]; }
#pragma unroll
        for (int i = 0; i < 4; ++i) h_hq[i] = *(const u32x4*)(h2q + (size_t)h_tok * D + i * 256 + l16 * 16);
        h_hs = hs[h_tok];
    };
    auto rot = [&]() { f_tok = h_tok; f_o0 = h_o0; f_n = h_n; f_e0 = h_e0; f_e1 = h_e1; f_g0 = h_g0; f_g1 = h_g1; f_hs = h_hs; f_s0 = h_s0; f_s1 = h_s1;
#pragma unroll
        for (int i = 0; i < 4; ++i) f_hq[i] = h_hq[i]; };
    u32x4 ra[UCH][4], rb[UCH][4];
#define PU_LOAD(R, E0, E1, NN, GM, s0_) do { _Pragma("unroll") for (int k = 0; k < UCH; ++k) { const int s = (s0_) + k; int e = __shfl((s < 16) ? (E0) : (E1), gbase | (s & 15)); \
            e = (s < (NN)) ? e : __builtin_amdgcn_readlane(e, (GM));     \
            const unsigned ro = ((unsigned)e << 10) + l16x16;     \
            R[k][0] = *(const u32x4*)(eu8 + ro); R[k][1] = *(const u32x4*)(eu8 + ro + 256u); R[k][2] = *(const u32x4*)(eu8 + ro + 512u); R[k][3] = *(const u32x4*)(eu8 + ro + 768u); } } while (0)
#define PU_COMP(R, s0_) do { _Pragma("unroll") for (int k = 0; k < UCH; ++k) { const int s = (s0_) + k; \
            int d = idot16(R[k][3], hq[3], idot16(R[k][2], hq[2], idot16(R[k][1], hq[1], idot16(R[k][0], hq[0], 0)))); \
            d = row_sum_i(d); \
            const float df = (float)d; const bool mine_ = l16 == (s & 15); z0 = (mine_ && s < 16) ? df : z0; z1 = (mine_ && s >= 16) ? df : z1; } } while (0)
    auto gmof = [&](int nn) { const int a0 = __builtin_amdgcn_readlane(nn, 0), a1 = __builtin_amdgcn_readlane(nn, 16), a2 = __builtin_amdgcn_readlane(nn, 32), a3 = __builtin_amdgcn_readlane(nn, 48); const int mx = max(max(a0, a1), max(a2, a3)); return (a0 == mx) ? 0 : (a1 == mx) ? 16 : (a2 == mx) ? 32 : 48; };
    if (ntok_w > 0) { fetch_offs(0); fetch(0); rot(); fetch_offs(4); fetch(4); fetch_offs(8); const int gm0 = gmof(f_n); PU_LOAD(ra, f_e0, f_e1, f_n, gm0, 0); }
    for (int b0 = 0; b0 < ntok_w; b0 += 4) {
        const int tok = f_tok, o0 = f_o0, n = f_n, ev0 = f_e0, ev1 = f_e1; const float gv0 = f_g0, gv1 = f_g1, hsc = f_hs, us0 = f_s0, us1 = f_s1;
        u32x4 hq[4];
#pragma unroll
        for (int i = 0; i < 4; ++i) hq[i] = f_hq[i];
        const int j0 = o0 + l16, j1 = o0 + 16 + l16;
        const int n_0 = __builtin_amdgcn_readlane(n, 0), n_1 = __builtin_amdgcn_readlane(n, 16), n_2 = __builtin_amdgcn_readlane(n, 32), n_3 = __builtin_amdgcn_readlane(n, 48);
        const int nmax = max(max(n_0, n_1), max(n_2, n_3));
        const int gml = (n_0 == nmax) ? 0 : (n_1 == nmax) ? 16 : (n_2 == nmax) ? 32 : 48;
        const int nm = max(min(nmax, 32), 1);
        const bool more = b0 + 4 < ntok_w;
        if (more) { rot(); fetch(b0 + 8); fetch_offs(b0 + 12); }
        float z0 = 0.f, z1 = 0.f;
        for (int s0 = 0; s0 < nm; s0 += 2 * UCH) {
            const bool hasB = s0 + UCH < nm, hasA2 = s0 + 2 * UCH < nm;
            if (hasB) PU_LOAD(rb, ev0, ev1, n, gml, s0 + UCH);
            PU_COMP(ra, s0);
            if (hasA2) PU_LOAD(ra, ev0, ev1, n, gml, s0 + 2 * UCH); else if (more) { const int gmn = gmof(f_n); PU_LOAD(ra, f_e0, f_e1, f_n, gmn, 0); }
            if (hasB) PU_COMP(rb, s0 + UCH);
        }
        if (l16 < n) { const float z = z0 * us0 * hsc; ((float*)(cdst + (size_t)tok * 128 + j0))[1] = gv0 * gelu_erf(z); }
        if (16 + l16 < n) { const float z = z1 * us1 * hsc; ((float*)(cdst + (size_t)tok * 128 + j1))[1] = gv1 * gelu_erf(z); }
        for (int s = 32; s < nmax; ++s) { const bool ok = s < n; const int j = o0 + (ok ? s : 0);
            const u32x2 pj = ce[(size_t)tok * 128 + j]; const int e = (int)pj.x; const unsigned char* rp = eu8 + (size_t)e * D + l16 * 16;
            const u32x4 a0 = *(const u32x4*)rp, a1 = *(const u32x4*)(rp + 256), a2 = *(const u32x4*)(rp + 512), a3 = *(const u32x4*)(rp + 768);
            int d = idot16(a3, hq[3], idot16(a2, hq[2], idot16(a1, hq[1], idot16(a0, hq[0], 0))));
            d = row_sum_i(d);
            if (ok && l16 == 0) { const float z = (float)d * sue[(size_t)tok * 128 + j] * hsc; ((float*)(cdst + (size_t)tok * 128 + j))[1] = __uint_as_float(pj.y) * gelu_erf(z); } }
    }
#undef PU_LOAD
#undef PU_COMP
}
__device__ __forceinline__ void phase_peer_v(const Params& p, LAS unsigned char* lds, const int tidx) {
    const int lane = tidx & 63, wave = tidx >> 6;
    const int x = blockIdx.x & 7, nbx = ((int)gridDim.x - x + 7) >> 3, wl = ((int)blockIdx.x >> 3) * NWAVES + wave, wstride = nbx * NWAVES;
    const unsigned char* ev8 = (const unsigned char*)(p.ws + WS_EV8) + (size_t)x * (NEXP * 128) + (lane & 7) * 16;
    const u32x4* ce4 = (const u32x4*)(p.ws + WS_CE); const float* mod = (const float*)(p.ws + WS_MOD);
    LAS int* le = (LAS int*)(lds + wave * 2048);
    LAS unsigned char* lc8 = (LAS unsigned char*)(lds + wave * 2048 + 1024);
    const int rg = lane >> 3, cg = lane & 7; const bool b3 = lane & 8;
    const int colo = cg * 16 + ((lane & 32) ? 8 : 0) + ((lane & 16) ? 4 : 0) + (b3 ? 2 : 0);
    const int ntok_w = (NLAT - wl + wstride - 1) / wstride;
    const float pscale = p.dup ? 0.f : DBG_PSCALE;
    float n_c0 = 0.f, n_c1 = 0.f; int n_e0 = 0, n_e1 = 0;
    auto fetch = [&](int i) { if (i < ntok_w) { const u32x4 q_ = ce4[(size_t)(wl + wstride * i) * 64 + lane]; n_e0 = (int)q_.x; n_c0 = __uint_as_float(q_.y); n_e1 = (int)q_.z; n_c1 = __uint_as_float(q_.w); } };
    auto stage = [&](int buf, float& cscale) {
        const float cm = fmaxf(wave_max_fast(fmaxf(fabsf(n_c0), fabsf(n_c1))), 1e-30f); const float inv = 127.f / cm; cscale = cm * (1.f / 127.f);
        *(LAS u32x2*)(le + buf * 128 + 2 * lane) = (u32x2){(unsigned)n_e0, (unsigned)n_e1};
        lc8[buf * 128 + ((2 * lane) & 7) * 16 + (lane >> 2)] = (unsigned char)(__float2int_rn(n_c0 * inv) & 0xff);
        lc8[buf * 128 + ((2 * lane + 1) & 7) * 16 + (lane >> 2)] = (unsigned char)(__float2int_rn(n_c1 * inv) & 0xff);
        asm volatile("s_waitcnt lgkmcnt(0)" ::: "memory"); };
    u32x4 ra[16], rb[16]; float csa = 0.f, csb = 0.f; int gb_ = -1; f32x2 gq_ = {0.f, 0.f};
#define PV_LOAD(buf, R) do { _Pragma("unroll") for (int it = 0; it < 16; ++it) { const int e_ = le[(buf) * 128 + 8 * it + rg]; R[it] = *(const u32x4*)(ev8 + (size_t)e_ * 128); } } while (0)
#define PV_T4(r0, r1, r2, r3, cq_, A0, A1, A2, A3) do { \
        const unsigned t0 = __builtin_amdgcn_perm(r1, r0, 0x05010400u), t1 = __builtin_amdgcn_perm(r1, r0, 0x07030602u); \
        const unsigned u0 = __builtin_amdgcn_perm(r3, r2, 0x05010400u), u1 = __builtin_amdgcn_perm(r3, r2, 0x07030602u); \
        A0 = __builtin_amdgcn_sdot4((int)__builtin_amdgcn_perm(u0, t0, 0x05040100u), (int)(cq_), A0, false); \
        A1 = __builtin_amdgcn_sdot4((int)__builtin_amdgcn_perm(u0, t0, 0x07060302u), (int)(cq_), A1, false); \
        A2 = __builtin_amdgcn_sdot4((int)__builtin_amdgcn_perm(u1, t1, 0x05040100u), (int)(cq_), A2, false); \
        A3 = __builtin_amdgcn_sdot4((int)__builtin_amdgcn_perm(u1, t1, 0x07060302u), (int)(cq_), A3, false); } while (0)
#define PV_COMP(buf, R, i_, cs_) do { int acc[16]; \
        const int tok = wl + wstride * (i_); const int b = tok / T; float* op = p.out + (size_t)tok * D + x * 128 + colo; \
        if (b != gb_) { gb_ = b; gq_ = *(const f32x2*)(mod + (size_t)b * NMOD + 5 * D + x * 128 + colo) * pscale; }     \
        const f32x2 xv = *(const f32x2*)op; const f32x2 gg = gq_ * (cs_); \
        const u32x4 cq = *(const LAS u32x4*)(lc8 + (buf) * 128 + rg * 16); \
        _Pragma("unroll") for (int q = 0; q < 16; ++q) acc[q] = 0; \
        _Pragma("unroll") for (int a = 0; a < 4; ++a) { const unsigned cqa = cq[a]; \
            PV_T4(R[4 * a].x, R[4 * a + 1].x, R[4 * a + 2].x, R[4 * a + 3].x, cqa, acc[0], acc[1], acc[2], acc[3]); \
            PV_T4(R[4 * a].y, R[4 * a + 1].y, R[4 * a + 2].y, R[4 * a + 3].y, cqa, acc[4], acc[5], acc[6], acc[7]); \
            PV_T4(R[4 * a].z, R[4 * a + 1].z, R[4 * a + 2].z, R[4 * a + 3].z, cqa, acc[8], acc[9], acc[10], acc[11]); \
            PV_T4(R[4 * a].w, R[4 * a + 1].w, R[4 * a + 2].w, R[4 * a + 3].w, cqa, acc[12], acc[13], acc[14], acc[15]); } \
        int a8[8], a4[4], a2[2]; \
        _Pragma("unroll") for (int q = 0; q < 8; ++q) { auto r_ = __builtin_amdgcn_permlane32_swap((unsigned)acc[q], (unsigned)acc[8 + q], false, false); a8[q] = (int)r_[0] + (int)r_[1]; } \
        _Pragma("unroll") for (int q = 0; q < 4; ++q) { auto r_ = __builtin_amdgcn_permlane16_swap((unsigned)a8[q], (unsigned)a8[4 + q], false, false); a4[q] = (int)r_[0] + (int)r_[1]; } \
        _Pragma("unroll") for (int q = 0; q < 2; ++q) { const int snd = b3 ? a4[q] : a4[2 + q], kp = b3 ? a4[2 + q] : a4[q]; a2[q] = kp + dppi<0x128>(snd); } \
        f32x2 rr; rr[0] = xv[0] + gg[0] * (float)a2[0]; rr[1] = xv[1] + gg[1] * (float)a2[1]; *(f32x2*)op = rr; } while (0)
    if (ntok_w > 0) { fetch(0); stage(0, csa); fetch(1); PV_LOAD(0, ra); }
    for (int i = 0; i < ntok_w; i += 2) {
        if (i + 1 < ntok_w) { stage(1, csb); fetch(i + 2); PV_LOAD(1, rb); }
        PV_COMP(0, ra, i, csa);
        if (i + 2 < ntok_w) { stage(0, csa); fetch(i + 3); PV_LOAD(0, ra); }
        if (i + 1 < ntok_w) PV_COMP(1, rb, i + 1, csb);
    }
#undef PV_LOAD
#undef PV_T4
#undef PV_COMP
}

#ifndef DBG_CHECK
#define DBG_CHECK 0
#endif
#ifndef DBG_SEL
#define DBG_SEL 4
#endif
__device__ __forceinline__ int dbg_tok(int slot) { return slot * 128 + 37; }
__device__ __forceinline__ float block_sum(float v, LAS float* red, const int tidx) {
    v = wave_sum(v); __syncthreads(); if ((tidx & 63) == 0) red[tidx >> 6] = v; __syncthreads();
    float s = 0.f; for (int w = 0; w < 8; ++w) s += red[w]; return s;
}
__device__ __forceinline__ void dbg_peer_check(const Params& p, LAS unsigned char* lds, const int tidx) {
    const int tid = tidx, lane = tid & 63, wave = tid >> 6;
    LAS float* h2f = (LAS float*)lds;
    LAS float* q = h2f + 1024;
    LAS float* sp = q + 2048;
    LAS float* topv = sp + 256;
    LAS int* topi = (LAS int*)(topv + 32);
    LAS float* cv = (LAS float*)(topi + 32);
    LAS float* bestv = cv + 256;
    LAS int* eref = (LAS int*)(bestv + 16);
    LAS float* gref = (LAS float*)(eref + 128);
    LAS float* wref = gref + 128;
    LAS float* red = wref + 128;
    for (int slot = blockIdx.x; slot < 256; slot += gridDim.x) {
        const int tok = dbg_tok(slot);
        const bf16_t* h2 = (const bf16_t*)(p.ws + WS_H2) + (size_t)tok * D;
        __syncthreads();
        for (int i = tid; i < D; i += NTHREADS) h2f[i] = bf2f(h2[i]);
        __syncthreads();
        for (int n = tid; n < 2048; n += NTHREADS) { float s = 0.f; for (int k = 0; k < D; ++k) s += h2f[k] * p.w_pq[(size_t)k * 2048 + n]; q[n] = s; }
        __syncthreads();
        for (int h = 0; h < PH; ++h) {
            if (tid < 256) { const int pp = tid >> 7, k = tid & 127; float s = 0.f; const float* sk = p.sub_keys + ((size_t)(h * 2 + pp) * NKEYS + k) * 128;
                for (int d = 0; d < 128; ++d) s += q[h * 256 + pp * 128 + d] * sk[d]; sp[tid] = s; }
            __syncthreads();
            if (tid < 256) { const int pp = tid >> 7, k = tid & 127; const float v = sp[tid]; int r = 0;
                for (int k2 = 0; k2 < 128; ++k2) { const float v2 = sp[pp * 128 + k2]; r += (v2 > v || (v2 == v && k2 < k)) ? 1 : 0; }
                if (r < 16) { topv[pp * 16 + r] = v; topi[pp * 16 + r] = k; } }
            __syncthreads();
            if (tid < 256) cv[tid] = topv[tid >> 4] + topv[16 + (tid & 15)];
            __syncthreads();
            if (tid < 256) { const float v = cv[tid]; int r = 0;
                for (int t2 = 0; t2 < 256; ++t2) { const float v2 = cv[t2]; r += (v2 > v || (v2 == v && t2 < tid)) ? 1 : 0; }
                if (r < 16) { bestv[r] = v; eref[h * 16 + r] = topi[tid >> 4] * NKEYS + topi[16 + (tid & 15)]; } }
            __syncthreads();
            if (tid < 16) { float mx = bestv[0]; for (int i = 1; i < 16; ++i) mx = fmaxf(mx, bestv[i]); float sum = 0.f; for (int i = 0; i < 16; ++i) sum += expf(bestv[i] - mx);
                gref[h * 16 + tid] = expf(bestv[tid] - mx) / sum; }
            __syncthreads();
        }
        float terr = 0.f, tden = 0.f;
        { const bf16_t* eub = (const bf16_t*)(p.ws + WS_EU);
          for (int k = 0; k < 128; ++k) { const size_t e = (size_t)eref[k]; for (int d = tid; d < D; d += NTHREADS) { const float a = p.expert_u[e * D + d], bq = bf2f(eub[e * D + d]); terr += (a - bq) * (a - bq); tden += a * a; } } }
        terr = block_sum(terr, red, tidx); tden = block_sum(tden, red, tidx);
        for (int kk = 0; kk < 16; ++kk) { const int k = wave * 16 + kk; const float* ur = p.expert_u + (size_t)eref[k] * D; float s = 0.f;
            for (int d = lane; d < D; d += 64) s += ur[d] * h2f[d];
            s = wave_sum(s); if (lane == 0) wref[k] = gref[k] * 0.5f * s * (1.f + erff(s * 0.70710678118654752f)); }
        __syncthreads();
        const float* pf = (const float*)(p.ws + WS_DBGP) + (size_t)slot * D;
        float num = 0.f, den = 0.f;
        for (int d = tid; d < D; d += NTHREADS) { float o = 0.f; for (int k = 0; k < 128; ++k) o += wref[k] * p.expert_v[(size_t)eref[k] * D + d];
            const float f = pf[d]; num += (f - o) * (f - o); den += o * o; }
        num = block_sum(num, red, tidx); den = block_sum(den, red, tidx);
        const int* ef = (const int*)(p.ws + WS_EIDX) + (size_t)tok * 128; const float* gf = (const float*)(p.ws + WS_GW) + (size_t)tok * 128;
        float miss = 0.f, gerr = 0.f, gden = 0.f, werr = 0.f, wden = 0.f; const float* wf = (const float*)(p.ws + WS_DBGP + MiB) + (size_t)slot * 128;
        if (tid < 128) { const int e = ef[tid]; int found = -1; for (int k = 0; k < 128; ++k) if (eref[k] == e && (k >> 4) == (tid >> 4)) found = k;
            if (found < 0) miss = 1.f; else { const float dg = gf[tid] - gref[found]; gerr = dg * dg; gden = gref[found] * gref[found]; const float dw = wf[tid] - wref[found]; werr = dw * dw; wden = wref[found] * wref[found]; } }
        werr = block_sum(werr, red, tidx); wden = block_sum(wden, red, tidx);
        miss = block_sum(miss, red, tidx); gerr = block_sum(gerr, red, tidx); gden = block_sum(gden, red, tidx);
        if (tid == 0) { float* r = (float*)(p.ws + WS_DBGR) + slot * 8; r[0] = num; r[1] = den; r[2] = miss; r[3] = gerr; r[4] = gden; r[5] = werr; r[6] = wden; r[7] = terr / tden; }
    }
}
__device__ __forceinline__ void dbg_report(const Params& p, const int tidx) {
    const float* r = (const float*)(p.ws + WS_DBGR);
    float num = 0.f, den = 0.f, miss = 0.f, gerr = 0.f, gden = 0.f, werr = 0.f, wden = 0.f;
    for (int s = 0; s < 256; ++s) { num += r[s * 8]; den += r[s * 8 + 1]; miss += r[s * 8 + 2]; gerr += r[s * 8 + 3]; gden += r[s * 8 + 4]; werr += r[s * 8 + 5]; wden += r[s * 8 + 6]; }
    float val = 0.f;
    if (DBG_SEL == 1) val = num / den;
    if (DBG_SEL == 2) val = miss / (256.f * 128.f);
    if (DBG_SEL == 3) val = gerr / gden;
    if (DBG_SEL == 5) { float t = 0.f; for (int s = 0; s < 256; ++s) t += r[s * 8 + 7]; val = t / 256.f; }
    if (DBG_SEL == 4) val = werr / wden;
    const float sc = 1.f + sqrtf(fminf(val, 100.f));
    const int gt = blockIdx.x * NTHREADS + tidx, NGT = gridDim.x * NTHREADS;
    for (int i = gt; i < NLAT * D / 4; i += NGT) ((f32x4*)p.out)[i] = ((const f32x4*)p.x)[i] * sc;
}

#define XB_TMO      128
#define XB_XCNT(j)  (256  + 64 * (j))
#define XB_XSUB(j)  (1280 + 64 * (j))
#define XB_XGEN(j)  (2304 + 64 * (j))
#define XB_TOP      3328
#define XB_TOPGEN   3392
#define XCD_BAR_WORDS 3456
#define XB_SPIN_CAP (1u << 22)
__device__ __forceinline__ unsigned xb_ld(unsigned* p)              { return __hip_atomic_load(p, __ATOMIC_RELAXED, __HIP_MEMORY_SCOPE_AGENT); }
__device__ __forceinline__ unsigned xb_add(unsigned* p, unsigned v) { return __hip_atomic_fetch_add(p, v, __ATOMIC_RELAXED, __HIP_MEMORY_SCOPE_AGENT); }
__device__ __forceinline__ unsigned xb_xcc_id() { return (unsigned)__builtin_amdgcn_s_getreg((3 << 11) | 20) & 0xFu; }
#define XB_SPIN(cond, bar) do { unsigned _sp = 0; while (cond) { __builtin_amdgcn_s_sleep(1); \
    if ((++_sp & 255u) == 0u) { if (xb_ld(&(bar)[XB_TMO])) break; if (_sp > XB_SPIN_CAP) { atomicAdd(&(bar)[XB_TMO], 1u); break; } } } } while (0)
struct XcdBarrier { unsigned* bar; unsigned x; volatile LAS unsigned* st; };
__device__ __forceinline__ XcdBarrier xcd_barrier_post(unsigned* bar, volatile LAS unsigned* st) {
    XcdBarrier b; b.bar = bar; b.x = xb_xcc_id(); b.st = st;
    if (threadIdx.x == 0) (void)xb_add(&bar[XB_XCNT(b.x)], 1u);
    return b;
}
__device__ __forceinline__ void xcd_barrier_complete(unsigned* bar, unsigned x, unsigned& nloc, unsigned& nx) {
    const unsigned G = gridDim.x * gridDim.y * gridDim.z;
    unsigned sum, cnt, mine, sp = 0u;
    for (;;) {
        sum = 0u; cnt = 0u; mine = 0u;
#pragma unroll
        for (unsigned j = 0; j < 16; ++j) { const unsigned c = xb_ld(&bar[XB_XCNT(j)]); sum += c; cnt += (c > 0u) ? 1u : 0u; mine = (j == x) ? c : mine; }
        if (sum == G) break;
        __builtin_amdgcn_s_sleep(1);
        if ((++sp & 255u) == 0u) { if (xb_ld(&bar[XB_TMO])) break; if (sp > XB_SPIN_CAP) { atomicAdd(&bar[XB_TMO], 1u); break; } }
    }
    nloc = mine > 0u ? mine : 1u; nx = cnt > 0u ? cnt : 1u;
}
__device__ __forceinline__ void xcd_barrier(const XcdBarrier& b, const int tidx) {
    asm volatile("s_waitcnt vmcnt(0)" ::: "memory");
    __syncthreads();
    if (tidx == 0) {
        unsigned* bar = b.bar;
        __builtin_amdgcn_s_waitcnt(0);
        unsigned nloc = b.st[0], nx = b.st[1];
        if (nloc == 0u) { xcd_barrier_complete(bar, b.x, nloc, nx); b.st[0] = nloc; b.st[1] = nx; }
        const unsigned old = xb_add(&bar[XB_XSUB(b.x)], 1u);
        const unsigned gen = old / nloc;
        if (old + 1u == (gen + 1u) * nloc) {
            __builtin_amdgcn_fence(__ATOMIC_RELEASE, "agent");
            asm volatile("s_waitcnt vmcnt(0)" ::: "memory");
            const unsigned og = xb_add(&bar[XB_TOP], 1u);
            const unsigned tg = og / nx;
            if (og + 1u == (tg + 1u) * nx) xb_add(&bar[XB_TOPGEN], 1u);
            else XB_SPIN(xb_ld(&bar[XB_TOPGEN]) == tg, bar);
            __builtin_amdgcn_fence(__ATOMIC_ACQUIRE, "agent");
            xb_add(&bar[XB_XGEN(b.x)], 1u);
            asm volatile("s_waitcnt vmcnt(0)" ::: "memory");
        } else {
            XB_SPIN(xb_ld(&bar[XB_XGEN(b.x)]) == gen, bar);
            __builtin_amdgcn_fence(__ATOMIC_ACQUIRE, "agent");
            asm volatile("s_waitcnt vmcnt(0)" ::: "memory");
        }
    }
    __syncthreads();
}
constexpr int NPHASE = 12 + 2 * DBG_CHECK;
constexpr int LDS_BYTES = 160 * 1024;
typedef const __attribute__((address_space(4))) Params* KargPtr;
#if defined(__HIP_DEVICE_COMPILE__)
#define PLOAD() KargPtr kq_ = kp; asm volatile("" : "+s"(kq_)); const Params p = *kq_; unsigned char* ws = p.ws; (void)ws; const int tidx = (wave_s << 6) | lane_id_v()
#else
#define PLOAD() const Params p = p_unused; unsigned char* ws = p.ws; (void)ws; const int tidx = (wave_s << 6) | lane_id_v()
#endif
__global__ void __launch_bounds__(NTHREADS, 2) mega(Params p_unused) {
    extern __shared__ __attribute__((aligned(16))) unsigned char lds_raw[];
    LAS unsigned char* lds = (LAS unsigned char*)lds_raw;
    KargPtr kp = (KargPtr)__builtin_amdgcn_kernarg_segment_ptr();
    const int lo = kp->ph_lo, hi = kp->ph_hi;
    const int G = gridDim.x, bid = blockIdx.x;
    const int wave_s = __builtin_amdgcn_readfirstlane(threadIdx.x >> 6);
#if !MK_MULTI && !MK_CGSYNC
    volatile LAS unsigned* xst = (volatile LAS unsigned*)(lds + LDS_BYTES - 64);
    if (threadIdx.x < 2) xst[threadIdx.x] = 0u;
    __syncthreads();
    const XcdBarrier xbar = xcd_barrier_post((unsigned*)(kp->ws + WS_BAR), xst);
#endif
#ifndef PHMASK
#define PHMASK 0xFFFFF
#endif
#define IN(k) (((PHMASK >> (k)) & 1) && lo <= (k) && (k) < hi)
#define TIDX() ((wave_s << 6) | lane_id_v())
#if MK_MULTI
#define SEAM(k) do { } while (0)
#else
#if MK_CGSYNC
#define SEAM(k) do { if (IN(k) && IN((k) + 1)) cg::this_grid().sync(); } while (0)
#else
#define SEAM(k) do { if (IN(k) && IN((k) + 1)) xcd_barrier(xbar, (wave_s << 6) | lane_id_v()); } while (0)
#endif
#endif
    if (IN(0)) { PLOAD(); phase_prep(p, lds, tidx); }
    SEAM(0);
    if (IN(1)) { PLOAD(); phase_hnorm(p, tidx); }
    SEAM(1);
    if (IN(2)) { PLOAD(); pg8::Gemm g{(const bf16_t*)(ws + WS_HB), (const bf16_t*)(ws + WS_WIN), NTOK, INCP, D, D, D, 0}; pg8::StaticOrder S; S.init(NTOK, INCP, G, bid);
        pg8::EpiCols E{(bf16_t*)(ws + WS_COLS), (float*)(ws + WS_GATES), (float*)(ws + WS_SSQ)}; pg8::gemm_phase(lds, g, S, E, tidx);
        { const int nt = (NTOK / 256) * (INCP / 256), extra = nt % G;
          if (extra == 0 || extra >= G) quant_experts(p, bid, G, TIDX()); else if (bid >= extra) quant_experts(p, bid - extra, G - extra, TIDX()); } }
    SEAM(2);
    if (IN(3)) { PLOAD();
        { pg8::Gemm g{(const bf16_t*)(ws + WS_COLS) + C_CQ, (const bf16_t*)(ws + WS_WUQ), NLAT, 1024, 256, INCP, 256, 0}; pg8::StaticOrder S; S.init(NLAT, 1024, G, bid);
          const int t_ = TIDX(); pg8::EpiQ E{(const float*)(ws + WS_SSQ), p.g_qn, (const float*)(ws + WS_ROPE), (bf16_t*)(ws + WS_Q), lds + 128 * 1024, t_}; pg8::gemm_phase(lds, g, S, E, t_); }
        { pg8::Gemm g{(const bf16_t*)(ws + WS_COLS) + C_CKV, (const bf16_t*)(ws + WS_WUKV), NTOK, 1024, 128, INCP, 128, 0}; pg8::StaticOrder S; S.init(NTOK, 1024, G, bid);
          const int t_ = TIDX(); pg8::EpiKV E{(const bf16_t*)(ws + WS_COLS), (const float*)(ws + WS_SSQ), p.g_kn, (const float*)(ws + WS_ROPE), (bf16_t*)(ws + WS_K), (bf16_t*)(ws + WS_VT), lds + 128 * 1024, t_}; pg8::gemm_phase(lds, g, S, E, t_); }
        { const int t_ = TIDX(); for (int u = (bid + G / 2) % G; u < NB * MH * 17; u += G) ml_summary_unit(p, lds, u, t_); }
    }
    SEAM(3);
    if (IN(4)) { PLOAD(); phase_ml_scan(p, tidx); }
    SEAM(4);
    if (IN(5)) { PLOAD();
        if (!p.dup || DUP_SUB == 0) { const int t_ = TIDX(); for (int u = bid; u < NB * NH * (T / 256); u += G) attn_unit(p, lds, u, t_); }
        if (!p.dup || DUP_SUB == 1) { const int t_ = TIDX(); for (int u = bid; u < NB * MH * NBLK; u += G) ml_output_unit(p, lds, u, t_); }
    }
    SEAM(5);
    if (IN(6)) { PLOAD(); pg8::Gemm g{(const bf16_t*)(ws + WS_MIX), (const bf16_t*)(ws + WS_WOUT), NLAT, D, D, D, D, 0}; pg8::StaticOrder S; S.init(NLAT, D, G, bid);
        pg8::EpiResid E{p.x, p.out, (const float*)(ws + WS_MOD), 2 * D, (DBG_MODE == 1 || DBG_MODE == 5) ? 0.f : 1.f}; pg8::gemm_phase(lds, g, S, E, tidx); }
    SEAM(6);
#if DBG_MODE == 0 || DBG_MODE == 5
    if (IN(7)) { PLOAD(); phase_h2(p, tidx); }
    SEAM(7);
    if (IN(8)) { PLOAD(); pg8::Gemm g{(const bf16_t*)(ws + WS_H2), (const bf16_t*)(ws + WS_WPQ), NLAT, 2048, D, D, D, 0}; pg8::StaticOrder S; S.init(NLAT, 2048, G, bid);
        pg8::EpiBf16 E{(bf16_t*)(ws + WS_QP), 2048}; pg8::gemm_phase(lds, g, S, E, tidx); }
    SEAM(8);
    if (IN(9)) { PLOAD(); for (int u = bid; u < NLAT / 32; u += G) peer_topk_unit(p, lds, u, tidx); }
    SEAM(9);
    if (IN(10)) { PLOAD(); phase_peer_u(p, lds, tidx); }
    SEAM(10);
    if (IN(11)) { PLOAD(); phase_peer_v(p, lds, tidx); }
#endif
#if DBG_CHECK
    SEAM(11);
    if (IN(12)) { PLOAD(); dbg_peer_check(p, lds, tidx); }
    SEAM(12);
    if (IN(13)) { PLOAD(); dbg_report(p, tidx); }
#endif
#undef IN
#undef SEAM
}

extern "C" void kernel_launch(void* const* d_in, const int* in_sizes, int n_in, void* d_out, int out_size, void* d_ws, size_t ws_size, hipStream_t stream) {
    static int grid = 0;
    if (grid == 0) {
        if (n_in != 24 || out_size != NLAT * D || ws_size < WS_END) { fprintf(stderr, "kernel_launch: unexpected shapes (n_in %d out %d ws %zu, need %zu)\n", n_in, out_size, ws_size, (size_t)WS_END); grid = -1; return; }
        int dev = 0, cus = 0, per_cu = 0;
        hipGetDevice(&dev); hipDeviceGetAttribute(&cus, hipDeviceAttributeMultiprocessorCount, dev);
        hipFuncSetAttribute((const void*)mega, hipFuncAttributeMaxDynamicSharedMemorySize, LDS_BYTES);
        hipOccupancyMaxActiveBlocksPerMultiprocessor(&per_cu, (const void*)mega, NTHREADS, LDS_BYTES);
        (void)hipGetLastError();
        if (per_cu < 1) { fprintf(stderr, "kernel_launch: occupancy query says %d blocks per CU\n", per_cu); per_cu = 1; }
        grid = cus;
    }
    if (grid < 0) return;
    Params p{};
    const float** pp = (const float**)&p;
    for (int i = 0; i < 24; ++i) pp[i] = (const float*)d_in[i];
    p.out = (float*)d_out; p.ws = (unsigned char*)d_ws;
#if MK_MULTI
    for (int ph = 0; ph < NPHASE; ++ph) for (int rep = 0; rep <= ((DUP_MASK >> ph) & 1); ++rep) { p.ph_lo = ph; p.ph_hi = ph + 1; p.dup = rep; hipLaunchKernelGGL(mega, dim3(grid), dim3(NTHREADS), LDS_BYTES, stream, p); }
#else
    p.ph_lo = 0; p.ph_hi = NPHASE;
#if MK_CGSYNC
    void* args[] = {&p};
    hipError_t e = hipLaunchCooperativeKernel((void*)mega, dim3(grid), dim3(NTHREADS), args, LDS_BYTES, stream);
    if (e != hipSuccess) fprintf(stderr, "cooperative launch failed: %s (grid %d)\n", hipGetErrorString(e), grid);
#else
    (void)hipMemsetAsync((char*)d_ws + WS_BAR, 0, XCD_BAR_WORDS * 4, stream);
    hipLaunchKernelGGL(mega, dim3(grid), dim3(NTHREADS), LDS_BYTES, stream, p);
#endif
#endif
}
```

```cpp
#include <hip/hip_runtime.h>
#include <hip/hip_cooperative_groups.h>
#include <cstdio>
#include <cstdint>
namespace cg = cooperative_groups;

#ifndef MK_MULTI
#define MK_MULTI 0
#endif
#ifndef MK_CGSYNC
#define MK_CGSYNC 0
#endif
#ifndef DUP_MASK
#define DUP_MASK 0
#endif
#ifndef DUP_SUB
#define DUP_SUB 0
#endif
#define DBG_CHECK 0
#define DBG_SEL 4
#ifndef DBG_MODE
#define DBG_MODE 0
#endif
#ifndef DBG_PSCALE
#define DBG_PSCALE 1.0f
#endif

#define LAS __attribute__((address_space(3)))
typedef unsigned short bf16_t;
typedef short bf16x8 __attribute__((ext_vector_type(8)));
typedef short s16x4 __attribute__((ext_vector_type(4)));
typedef float f32x4 __attribute__((ext_vector_type(4)));
typedef float f32x2 __attribute__((ext_vector_type(2)));
typedef float f32x16 __attribute__((ext_vector_type(16)));
typedef unsigned u32x4 __attribute__((ext_vector_type(4)));
typedef unsigned u32x2 __attribute__((ext_vector_type(2)));
typedef __bf16 bf16v2 __attribute__((ext_vector_type(2)));

constexpr int NB = 8, T = 4096, TC = 256, D = 1024;
constexpr int NLAT = NB * T, NCTX = NB * TC, NTOK = NLAT + NCTX;
constexpr int NMOD = 6 * D;
constexpr int INC = 2000, INCP = 2048;
constexpr int C_CQ = 0, C_CKV = 256, C_KR = 384, C_MQ = 448, C_MK = 704, C_MV = 960, C_MO = 1472, C_G = 1984;
constexpr int NH = 4, DQK = 192, DNOPE = 128, DROPE = 64, DV = 128;
constexpr int NKEY = TC + T;
constexpr int MH = 4, MDK = 64, MDV = 128, MCH = 256, NBLK = T / MCH;
constexpr int PH = 8, NKEYS = 128, PDK = 256, PTOP = 16, NEXP = NKEYS * NKEYS;
constexpr float EPS = 1e-6f;
constexpr int NTHREADS = 512, NWAVES = 8;

constexpr size_t MiB = 1u << 20;
constexpr size_t WS_ZERO = 0;
constexpr size_t WS_MOD = 0;
constexpr size_t WS_SSQ = 18 * MiB + 512 * 1024;
constexpr size_t ZERO_BYTES = 1 * MiB;
constexpr size_t WS_BAR = 512 * 1024;
constexpr size_t WS_ROPE = 1 * MiB;
constexpr size_t WS_SKB = WS_ROPE + 64 * 1024;
constexpr size_t WS_MSCAL = WS_SKB + 512 * 1024;
constexpr size_t WS_MST = WS_MSCAL + 64 * 1024;
constexpr size_t WS_NST = WS_MST + 64 * 1024;
constexpr size_t WS_NL = WS_NST + 512 * 1024;
constexpr size_t WS_WIN = 4 * MiB;
constexpr size_t WS_WUQ = 8 * MiB;
constexpr size_t WS_WUKV = 9 * MiB;
constexpr size_t WS_WOUT = 10 * MiB;
constexpr size_t WS_WPQ = 12 * MiB;
constexpr size_t WS_GATES = 16 * MiB;
constexpr size_t WS_R1 = 20 * MiB;
constexpr size_t WS_HB = WS_R1, WS_Q = WS_R1, WS_CST = WS_R1 + 48 * MiB, WS_H2 = WS_R1;
constexpr size_t WS_COLS = 88 * MiB;
constexpr size_t WS_QP = WS_COLS;
constexpr size_t WS_R2 = 224 * MiB;
constexpr size_t WS_QRAW = WS_R2, WS_KVRAW = WS_R2 + 48 * MiB, WS_MIX = WS_R2;
constexpr size_t WS_EIDX = WS_R2 + 64 * MiB, WS_GW = WS_R2 + 80 * MiB;
constexpr size_t WS_CE = WS_EIDX;
constexpr size_t WS_SUE = WS_R2 + 96 * MiB;
constexpr size_t WS_U = 340 * MiB;
constexpr size_t WS_K = 376 * MiB;
constexpr size_t WS_VT = 428 * MiB;
constexpr size_t WS_EU = 376 * MiB;
constexpr size_t WS_EV = 408 * MiB;
constexpr size_t WS_EU8 = 464 * MiB;
constexpr size_t WS_EV8 = 480 * MiB;
constexpr size_t WS_H2Q = 408 * MiB;
constexpr size_t WS_SU = 3 * MiB;
constexpr size_t WS_SV = 3 * MiB + 64 * 1024;
constexpr size_t WS_HS = 3 * MiB + 128 * 1024;
constexpr size_t WS_OFFS = 3 * MiB + 256 * 1024;
constexpr size_t WS_END = 496 * MiB;
constexpr size_t WS_DBGP = 340 * MiB;
constexpr size_t WS_DBGR = 342 * MiB;

__device__ __forceinline__ unsigned cvt_pk_bf16(float lo, float hi) { unsigned r; asm volatile("v_cvt_pk_bf16_f32 %0, %1, %2" : "=v"(r) : "v"(lo), "v"(hi)); return r; }
__device__ __forceinline__ int lane_id_v() { int l; asm volatile("v_mbcnt_lo_u32_b32 %0, -1, 0\n\tv_mbcnt_hi_u32_b32 %0, -1, %0" : "=v"(l)); return l; }
__device__ __forceinline__ int pe_slice(int e) { return ((e >> 7) + e) & 7; }
__device__ __forceinline__ unsigned pe_local(unsigned e) { return ((e >> 7) << 4) | ((e & 127u) >> 3); }
__device__ __forceinline__ float bf_lo(unsigned w) { return __uint_as_float(w << 16); }
__device__ __forceinline__ float bf_hi(unsigned w) { return __uint_as_float(w & 0xffff0000u); }
__device__ __forceinline__ float bf2f(bf16_t v) { return __uint_as_float((unsigned)v << 16); }
__device__ __forceinline__ bf16_t f2bf(float f) { return (bf16_t)(cvt_pk_bf16(f, 0.f) & 0xffffu); }
__device__ __forceinline__ float wave_sum(float v) {
#pragma unroll
    for (int o = 1; o < 64; o <<= 1) v += __shfl_xor(v, o);
    return v;
}
__device__ __forceinline__ float siluf(float v) { return v / (1.f + __expf(-v)); }
__device__ __forceinline__ float sigmoidf_(float v) { return 1.f / (1.f + __expf(-v)); }
__device__ __forceinline__ float logsigmoidf_(float v) { return fminf(v, 0.f) - log1pf(__expf(-fabsf(v))); }
__device__ __forceinline__ int crow(int r, int hi) { return (r & 3) + 8 * (r >> 2) + 4 * hi; }

struct Params {
    const float *x, *c, *ctx, *c_ctx, *w_ada, *b_ada, *g_norm1, *w_in, *g_cq, *w_uq, *g_ckv, *w_ukv, *g_qn, *g_kn, *conv_qk, *b_igate, *b_fgate, *g_mlstm, *w_out, *g_norm2,
        *w_pq, *sub_keys, *expert_u, *expert_v;
    float* out; unsigned char* ws;
    int ph_lo, ph_hi, dup, pad_;
};

namespace pg8 {
constexpr int BM = 256, BK = 64, HALF = 128, HTB = HALF * BK * 2, STAGE_BYTES = 8 * HTB, NXCD = 8, WGM = 8;
__host__ __device__ __forceinline__ int lds_byte(int r, int c) { const int st = (r >> 4) * 2 + (c >> 5), rr = r & 15, cc = c & 31, ob = rr * 64 + cc * 2; return st * 1024 + (ob ^ (((ob >> 9) & 1) << 5)); }
__host__ __device__ __forceinline__ void stage_rc(int b, int& R, int& C) { const int st = b / 1024, sb = b % 1024, swz = sb ^ (((sb >> 9) & 1) << 5); R = (st >> 1) * 16 + swz / 64; C = (st & 1) * 32 + (swz % 64) / 2; }
__host__ __device__ __forceinline__ int perm32(int rho) { const int n = rho >> 4, i = rho & 15; return 8 * (i >> 2) + 4 * n + (i & 3); }
struct Unit { int pm, pn; };
struct Gemm { const bf16_t* A; const bf16_t* Bt; int M, N, K, lda, ldb, a_pn_off; };
struct StaticOrder {
    int nM, nN, nwg, G, c;
    __host__ __device__ void init(int M, int N, int G_, int c_) { nM = M / BM; nN = N / BM; nwg = nM * nN; G = G_; c = c_; }
    __host__ __device__ bool next(int i, Unit& u) const {
        const long L = (long)i * G + c; if (L >= nwg) return false;
        int wgid = (int)L; { const int q = nwg / NXCD, r = nwg % NXCD, xcd = wgid % NXCD, off = wgid / NXCD; wgid = (xcd < r ? xcd * (q + 1) : r * (q + 1) + (xcd - r) * q) + off; }
        const int nig = WGM * nN, gid = wgid / nig, fm = gid * WGM, gsz = (nM - fm) < WGM ? (nM - fm) : WGM;
        u.pm = fm + ((wgid % nig) % gsz); u.pn = (wgid % nig) / gsz; return true;
    }
};
template <class Epi, class Sched>
__device__ __forceinline__ void gemm_phase(LAS unsigned char* lds, const Gemm g, const Sched& S, const Epi& E, const int tidx) {
    const int tid = tidx, wid = __builtin_amdgcn_readfirstlane(tid >> 6), lane = tid & 63, wr = wid >> 2, wc = wid & 3, fr = lane & 15, fq = lane >> 4;
    const int K = g.K, nt = K / BK;
    unsigned voffA[2], voffB[2];
#pragma unroll
    for (int i = 0; i < 2; ++i) { int R, C; stage_rc(tid * 16 + i * 8192, R, C); const int Rb = Epi::PERM ? ((R & ~31) + perm32(R & 31)) : R;
        voffA[i] = (unsigned)(R * g.lda + C) * 2u; voffB[i] = (unsigned)(Rb * g.ldb + C) * 2u; }
    const size_t kstep = (size_t)(BK * 2);
    const size_t hstepA = (size_t)HALF * g.lda * 2, hstepB = (size_t)HALF * g.ldb * 2;
    const size_t tstepA = 2 * hstepA, tstepB = 2 * hstepB;
    const unsigned ldsw = (unsigned)wid * 1024u;
    const int aoff = lds_byte(wr * 64 + fr, fq * 8), boff = lds_byte(wc * 32 + fr, fq * 8);
#define PG8_SA(b, h) (((b) * 2 + (h)) * HTB)
#define PG8_SB(b, h) ((4 + (b) * 2 + (h)) * HTB)
#define PG8_STAGE(bufoff, gbase, voff) do { _Pragma("unroll") for (int _i = 0; _i < 2; ++_i) \
        __builtin_amdgcn_global_load_lds((const unsigned*)((const char*)(gbase) + (voff)[_i]), (LAS unsigned*)(lds + (bufoff) + ldsw + _i * 8192), 16, 0, 0); } while (0)
#define PG8_LDA(dst, b, h) do { _Pragma("unroll") for (int m = 0; m < 4; ++m) _Pragma("unroll") for (int k = 0; k < 2; ++k) dst[m][k] = *(const LAS bf16x8*)(lds + PG8_SA(b, h) + aoff + m * 2048 + k * 1024); } while (0)
#define PG8_LDB(dst, b, h) do { _Pragma("unroll") for (int n = 0; n < 2; ++n) _Pragma("unroll") for (int k = 0; k < 2; ++k) dst[n][k] = *(const LAS bf16x8*)(lds + PG8_SB(b, h) + boff + n * 2048 + k * 1024); } while (0)
#define PG8_MMA(ai, bj, At, Bt) do { __builtin_amdgcn_s_setprio(1); _Pragma("unroll") for (int m = 0; m < 4; ++m) _Pragma("unroll") for (int n = 0; n < 2; ++n) _Pragma("unroll") for (int k = 0; k < 2; ++k) \
        acc[ai][bj][m][n] = __builtin_amdgcn_mfma_f32_16x16x32_bf16(Bt[n][k], At[m][k], acc[ai][bj][m][n], 0, 0, 0); __builtin_amdgcn_s_setprio(0); } while (0)
#define PG8_WAIT_V(n) asm volatile("s_waitcnt vmcnt(" #n ")" ::: "memory")
#define PG8_WAIT_L(n) asm volatile("s_waitcnt lgkmcnt(" #n ")" ::: "memory")
#define PG8_BAR __builtin_amdgcn_s_barrier()
#define PG8_SCHED __builtin_amdgcn_sched_barrier(0)
    Unit cur, nxt; int ui = 0;
    if (!S.next(0, cur)) return;
    f32x4 acc[2][2][4][2];
#pragma unroll
    for (int a = 0; a < 2; ++a)
#pragma unroll
        for (int b = 0; b < 2; ++b)
#pragma unroll
            for (int m = 0; m < 4; ++m)
#pragma unroll
                for (int n = 0; n < 2; ++n) acc[a][b][m][n] = (f32x4){0.f, 0.f, 0.f, 0.f};
    bf16x8 At[4][2], B0[2][2], B1[2][2];
    const char* cA = (const char*)g.A + (size_t)cur.pm * tstepA + (size_t)cur.pn * g.a_pn_off * 2; const char* cB = (const char*)g.Bt + (size_t)cur.pn * tstepB;
    PG8_STAGE(PG8_SB(0, 0), cB, voffB); PG8_STAGE(PG8_SB(0, 1), cB + hstepB, voffB); PG8_STAGE(PG8_SA(0, 0), cA, voffA); PG8_STAGE(PG8_SA(0, 1), cA + hstepA, voffA);
    if (wr == 1) PG8_BAR;
    PG8_WAIT_V(2); PG8_BAR;
    PG8_STAGE(PG8_SB(1, 0), cB + kstep, voffB); PG8_STAGE(PG8_SA(1, 0), cA + kstep, voffA); PG8_STAGE(PG8_SB(1, 1), cB + hstepB + kstep, voffB);
    PG8_WAIT_V(6); PG8_BAR;
    for (;;) {
        const bool has_next = S.next(ui + 1, nxt);
        const char* nA = has_next ? (const char*)g.A + (size_t)nxt.pm * tstepA + (size_t)nxt.pn * g.a_pn_off * 2 : cA; const char* nB = has_next ? (const char*)g.Bt + (size_t)nxt.pn * tstepB : cB;
        for (int t = 0; t < nt; t += 2) {
            const bool last = (t == nt - 2);
            const char* a1 = cA + (size_t)(t + 1) * kstep;
            const char* a2 = last ? nA : cA + (size_t)(t + 2) * kstep; const char* b2 = last ? nB : cB + (size_t)(t + 2) * kstep;
            const char* a3 = a2 + kstep; const char* b3 = b2 + kstep;
            PG8_LDB(B0, 0, 0); PG8_LDB(B1, 0, 1); PG8_SCHED; PG8_LDA(At, 0, 0); PG8_STAGE(PG8_SA(1, 1), a1 + hstepA, voffA);
            PG8_WAIT_V(8); PG8_WAIT_L(0); PG8_BAR; PG8_MMA(0, 0, At, B0); PG8_MMA(0, 1, At, B1); PG8_BAR; PG8_SCHED;
            PG8_LDA(At, 0, 1); PG8_STAGE(PG8_SB(0, 0), b2, voffB); PG8_STAGE(PG8_SB(0, 1), b2 + hstepB, voffB); PG8_STAGE(PG8_SA(0, 0), a2, voffA);
            PG8_WAIT_V(8); PG8_WAIT_L(0); PG8_BAR; PG8_MMA(1, 0, At, B0); PG8_MMA(1, 1, At, B1); PG8_BAR; PG8_SCHED;
            PG8_LDB(B0, 1, 0); PG8_LDB(B1, 1, 1); PG8_SCHED; PG8_LDA(At, 1, 0); PG8_STAGE(PG8_SA(0, 1), a2 + hstepA, voffA);
            PG8_WAIT_V(8); PG8_WAIT_L(0); PG8_BAR; PG8_MMA(0, 0, At, B0); PG8_MMA(0, 1, At, B1); PG8_BAR; PG8_SCHED;
            PG8_LDA(At, 1, 1); PG8_STAGE(PG8_SB(1, 0), b3, voffB); PG8_STAGE(PG8_SB(1, 1), b3 + hstepB, voffB); PG8_STAGE(PG8_SA(1, 0), a3, voffA);
            PG8_WAIT_V(8); PG8_WAIT_L(0); PG8_BAR; PG8_MMA(1, 0, At, B0); PG8_MMA(1, 1, At, B1); PG8_BAR; PG8_SCHED;
        }
        if (wr == 0) PG8_BAR;
        E(acc, cur, wr, wc, fr, fq);
        if (!has_next) break;
#pragma unroll
        for (int a = 0; a < 2; ++a)
#pragma unroll
            for (int b = 0; b < 2; ++b)
#pragma unroll
                for (int m = 0; m < 4; ++m)
#pragma unroll
                    for (int n = 0; n < 2; ++n) acc[a][b][m][n] = (f32x4){0.f, 0.f, 0.f, 0.f};
        cur = nxt; cA = nA; cB = nB; ++ui;
        if (wr == 1) PG8_BAR;
    }
    PG8_WAIT_V(0);
    PG8_BAR;
#undef PG8_SA
#undef PG8_SB
#undef PG8_STAGE
#undef PG8_LDA
#undef PG8_LDB
#undef PG8_MMA
#undef PG8_WAIT_V
#undef PG8_WAIT_L
#undef PG8_BAR
#undef PG8_SCHED
}

struct EpiBf16 {
    static constexpr bool PERM = true;
    bf16_t* O; int ldc;
    __device__ __forceinline__ void operator()(const f32x4 (&acc)[2][2][4][2], const Unit& u, int wr, int wc, int fr, int fq) const {
        const int row0 = u.pm * BM + wr * 64 + fr, col0 = u.pn * BM + wc * 32 + 8 * fq;
#pragma unroll
        for (int ai = 0; ai < 2; ++ai)
#pragma unroll
            for (int m = 0; m < 4; ++m) { bf16_t* rowp = O + (size_t)(row0 + ai * HALF + m * 16) * ldc + col0;
#pragma unroll
                for (int bj = 0; bj < 2; ++bj) { const f32x4 v0 = acc[ai][bj][m][0], v1 = acc[ai][bj][m][1]; u32x4 w;
                    w.x = cvt_pk_bf16(v0[0], v0[1]); w.y = cvt_pk_bf16(v0[2], v0[3]); w.z = cvt_pk_bf16(v1[0], v1[1]); w.w = cvt_pk_bf16(v1[2], v1[3]);
                    *(u32x4*)(rowp + bj * HALF) = w; } }
    }
};
struct EpiCols {
    static constexpr bool PERM = true;
    bf16_t* O; float* gates; float* ssq;
    __device__ __forceinline__ void operator()(const f32x4 (&acc)[2][2][4][2], const Unit& u, int wr, int wc, int fr, int fq) const {
        const int row0 = u.pm * BM + wr * 64 + fr, col0 = u.pn * BM + wc * 32 + 8 * fq;
#pragma unroll
        for (int ai = 0; ai < 2; ++ai)
#pragma unroll
            for (int m = 0; m < 4; ++m) { const int row = row0 + ai * HALF + m * 16; bf16_t* rowp = O + (size_t)row * INCP + col0;
                float s0 = 0.f, s1 = 0.f;
#pragma unroll
                for (int bj = 0; bj < 2; ++bj) { const f32x4 v0 = acc[ai][bj][m][0], v1 = acc[ai][bj][m][1]; u32x4 w;
                    w.x = cvt_pk_bf16(v0[0], v0[1]); w.y = cvt_pk_bf16(v0[2], v0[3]); w.z = cvt_pk_bf16(v1[0], v1[1]); w.w = cvt_pk_bf16(v1[2], v1[3]);
                    *(u32x4*)(rowp + bj * HALF) = w;
                    const float s = (v0[0] * v0[0] + v0[1] * v0[1]) + (v0[2] * v0[2] + v0[3] * v0[3]) + (v1[0] * v1[0] + v1[1] * v1[1]) + (v1[2] * v1[2] + v1[3] * v1[3]);
                    if (bj == 0) s0 = s; else s1 = s; }
                if (u.pn == 0) { float s = s0 + s1; s += __shfl_xor(s, 16); s += __shfl_xor(s, 32); if (fq == 0) ssq[row * 8 + wc] = s; }
                if (u.pn == 1) { float s = s0; s += __shfl_xor(s, 16); s += __shfl_xor(s, 32); if (fq == 0) ssq[row * 8 + 4 + wc] = s; }
                if (u.pn == 7 && wc == 2 && fq < 2) { *(f32x4*)(gates + (size_t)row * 16 + 8 * fq) = acc[ai][1][m][0]; *(f32x4*)(gates + (size_t)row * 16 + 8 * fq + 4) = acc[ai][1][m][1]; }
            }
    }
};
struct EpiResid {
    static constexpr bool PERM = false;
    const float* base; float* out; const float* mod; int gate_off; float gscale;
    __device__ __forceinline__ void operator()(const f32x4 (&acc)[2][2][4][2], const Unit& u, int wr, int wc, int fr, int fq) const {
        const int row0 = u.pm * BM + wr * 64 + fr, col0 = u.pn * BM + wc * 32 + 4 * fq;
        const int b = (u.pm * BM) / T;
        f32x4 gv[2][2];
#pragma unroll
        for (int bj = 0; bj < 2; ++bj)
#pragma unroll
            for (int n = 0; n < 2; ++n) gv[bj][n] = *(const f32x4*)(mod + (size_t)b * NMOD + gate_off + col0 + bj * HALF + n * 16) * gscale;
#pragma unroll
        for (int ai = 0; ai < 2; ++ai)
#pragma unroll
            for (int m = 0; m < 4; ++m) { const size_t off = (size_t)(row0 + ai * HALF + m * 16) * D + col0;
#pragma unroll
                for (int bj = 0; bj < 2; ++bj)
#pragma unroll
                    for (int n = 0; n < 2; ++n) { const f32x4 bs = *(const f32x4*)(base + off + bj * HALF + n * 16); *(f32x4*)(out + off + bj * HALF + n * 16) = bs + gv[bj][n] * acc[ai][bj][m][n]; } }
    }
};
struct EpiKV {
    static constexpr bool PERM = true;
    const bf16_t* cols; const float* ssq; const float* g_kn; const float* rt; bf16_t* Kb; bf16_t* Vb; LAS unsigned char* xl; int tidx;
    __device__ __forceinline__ void operator()(const f32x4 (&acc)[2][2][4][2], const Unit& u, int wr_, int wc_, int fr_, int fq_) const {
        int fr = fr_, fq = fq_, tix = tidx, wr = wr_, wc = wc_; asm volatile("" : "+v"(fr), "+v"(fq), "+v"(tix), "+s"(wr), "+s"(wc));
        LAS float* P = (LAS float*)xl;
        LAS float* KR = P + 1024;
        LAS float* RK = KR + 256;
        LAS float* RKV = RK + 256;
        const int h = u.pn, rowbase = u.pm * BM;
        const bool lat = rowbase < NLAT; const int b = lat ? rowbase / T : (rowbase - NLAT) / TC; const int key0 = lat ? TC + rowbase % T : 0, t0 = lat ? rowbase % T : 0;
#pragma unroll
        for (int ai = 0; ai < 2; ++ai)
#pragma unroll
            for (int m = 0; m < 4; ++m) { const f32x4 v0 = acc[ai][0][m][0], v1 = acc[ai][0][m][1];
                float s = (v0[0] * v0[0] + v0[1] * v0[1]) + (v0[2] * v0[2] + v0[3] * v0[3]) + (v1[0] * v1[0] + v1[1] * v1[1]) + (v1[2] * v1[2] + v1[3] * v1[3]);
                s += __shfl_xor(s, 16); s += __shfl_xor(s, 32);
                if (fq == 0) P[(ai * HALF + wr * 64 + m * 16 + fr) * 4 + wc] = s; }
        const int rrow = tix >> 1, half = tix & 1;
        const bf16_t* krp = cols + (size_t)(rowbase + rrow) * INCP + C_KR + 32 * half;
        { float ss = 0.f;
#pragma unroll
          for (int c4 = 0; c4 < 4; ++c4) { const u32x4 kk = *(const u32x4*)(krp + 8 * c4);
#pragma unroll
              for (int q = 0; q < 4; ++q) { const float lo = bf_lo(kk[q]), hi = bf_hi(kk[q]); ss += lo * lo + hi * hi; } }
          ss += __shfl_xor(ss, 1); if (half == 0) KR[rrow] = ss; }
        asm volatile("s_waitcnt lgkmcnt(0)" ::: "memory"); __builtin_amdgcn_s_barrier(); asm volatile("" ::: "memory");
        if (tix < 256) { const f32x4 sk4 = *(const f32x4*)(ssq + (size_t)(rowbase + tix) * 8 + 4);
            const float rkv = rsqrtf(((sk4[0] + sk4[1]) + (sk4[2] + sk4[3])) * (1.f / 128.f) + EPS);
            const float sn = ((P[tix * 4] + P[tix * 4 + 1]) + (P[tix * 4 + 2] + P[tix * 4 + 3])) * rkv * rkv;
            RKV[tix] = rkv; RK[tix] = rsqrtf((sn + KR[tix]) * (1.f / 192.f) + EPS); }
        asm volatile("s_waitcnt lgkmcnt(0)" ::: "memory"); __builtin_amdgcn_s_barrier(); asm volatile("" ::: "memory");
        const int col0 = wc * 32 + 8 * fq;
        f32x4 g0 = *(const f32x4*)(g_kn + col0), g1 = *(const f32x4*)(g_kn + col0 + 4);
#pragma unroll
        for (int ai = 0; ai < 2; ++ai)
#pragma unroll
            for (int m = 0; m < 4; ++m) { const int r = ai * HALF + wr * 64 + m * 16 + fr; const float rkv = RKV[r], sk = rkv * RK[r];
                const size_t kvrow = ((size_t)b * NH + h) * NKEY + key0 + r;
                { const f32x4 v0 = acc[ai][0][m][0] * sk * g0, v1 = acc[ai][0][m][1] * sk * g1; u32x4 w;
                  w.x = cvt_pk_bf16(v0[0], v0[1]); w.y = cvt_pk_bf16(v0[2], v0[3]); w.z = cvt_pk_bf16(v1[0], v1[1]); w.w = cvt_pk_bf16(v1[2], v1[3]); *(u32x4*)(Kb + kvrow * DQK + col0) = w; }
                { const f32x4 v0 = acc[ai][1][m][0] * rkv, v1 = acc[ai][1][m][1] * rkv; u32x4 w;
                  w.x = cvt_pk_bf16(v0[0], v0[1]); w.y = cvt_pk_bf16(v0[2], v0[3]); w.z = cvt_pk_bf16(v1[0], v1[1]); w.w = cvt_pk_bf16(v1[2], v1[3]); *(u32x4*)(Vb + kvrow * DV + col0) = w; } }
        { const float rk = RK[rrow]; const int t = t0 + rrow; const int pos = half ? (t & 63) : (t >> 6);
          const float* gk = g_kn + 128 + 32 * half;
          bf16_t* kp = Kb + (((size_t)b * NH + h) * NKEY + key0 + rrow) * DQK + 128 + 32 * half;
#pragma unroll
          for (int hf = 0; hf < 2; ++hf) {
              const u32x4 ka = *(const u32x4*)(krp + 8 * hf), kb2 = *(const u32x4*)(krp + 16 + 8 * hf);
              float oa[8], ob[8];
#pragma unroll
              for (int q = 0; q < 8; ++q) { const int j = 8 * hf + q; float cs = 1.f, sn = 0.f; if (lat) { cs = rt[(pos * 16 + j) * 2]; sn = rt[(pos * 16 + j) * 2 + 1]; }
                  const float av = ((q & 1) ? bf_hi(ka[q >> 1]) : bf_lo(ka[q >> 1])) * rk * gk[j], cv = ((q & 1) ? bf_hi(kb2[q >> 1]) : bf_lo(kb2[q >> 1])) * rk * gk[16 + j];
                  oa[q] = av * cs - cv * sn; ob[q] = cv * cs + av * sn; }
              u32x4 w; w.x = cvt_pk_bf16(oa[0], oa[1]); w.y = cvt_pk_bf16(oa[2], oa[3]); w.z = cvt_pk_bf16(oa[4], oa[5]); w.w = cvt_pk_bf16(oa[6], oa[7]); *(u32x4*)(kp + 8 * hf) = w;
              w.x = cvt_pk_bf16(ob[0], ob[1]); w.y = cvt_pk_bf16(ob[2], ob[3]); w.z = cvt_pk_bf16(ob[4], ob[5]); w.w = cvt_pk_bf16(ob[6], ob[7]); *(u32x4*)(kp + 16 + 8 * hf) = w; } }
        asm volatile("s_waitcnt lgkmcnt(0)" ::: "memory"); __builtin_amdgcn_s_barrier(); asm volatile("" ::: "memory");
    }
};
struct EpiQ {
    static constexpr bool PERM = true;
    const float* ssq; const float* g_qn; const float* rt; bf16_t* Q; LAS unsigned char* xl; int tidx;
    __device__ __forceinline__ void operator()(const f32x4 (&acc)[2][2][4][2], const Unit& u, int wr_, int wc_, int fr_, int fq_) const {
        int fr = fr_, fq = fq_, tix = tidx, wr = wr_, wc = wc_; asm volatile("" : "+v"(fr), "+v"(fq), "+v"(tix), "+s"(wr), "+s"(wc));
        LAS float* P = (LAS float*)xl;
        LAS float* RS = P + 1024;
        const int h = u.pn, rowbase = u.pm * BM; const int b = rowbase / T, t0 = rowbase % T;
#pragma unroll
        for (int ai = 0; ai < 2; ++ai)
#pragma unroll
            for (int m = 0; m < 4; ++m) { float s = 0.f;
#pragma unroll
                for (int bj = 0; bj < 2; ++bj) { const f32x4 v0 = acc[ai][bj][m][0], v1 = acc[ai][bj][m][1];
                    s += (v0[0] * v0[0] + v0[1] * v0[1]) + (v0[2] * v0[2] + v0[3] * v0[3]) + (v1[0] * v1[0] + v1[1] * v1[1]) + (v1[2] * v1[2] + v1[3] * v1[3]); }
                s += __shfl_xor(s, 16); s += __shfl_xor(s, 32);
                if (fq == 0) P[(ai * HALF + wr * 64 + m * 16 + fr) * 4 + wc] = s; }
        asm volatile("s_waitcnt lgkmcnt(0)" ::: "memory"); __builtin_amdgcn_s_barrier(); asm volatile("" ::: "memory");
        if (tix < 256) { const f32x4 sq4 = *(const f32x4*)(ssq + (size_t)(rowbase + tix) * 8);
            const float rq = rsqrtf(((sq4[0] + sq4[1]) + (sq4[2] + sq4[3])) * (1.f / 256.f) + EPS);
            const float sn = ((P[tix * 4] + P[tix * 4 + 1]) + (P[tix * 4 + 2] + P[tix * 4 + 3])) * rq * rq;
            RS[tix] = rq * rsqrtf(sn * (1.f / 192.f) + EPS); }
        asm volatile("s_waitcnt lgkmcnt(0)" ::: "memory"); __builtin_amdgcn_s_barrier(); asm volatile("" ::: "memory");
        const int col0 = wc * 32 + 8 * fq;
        { const f32x4 g0 = *(const f32x4*)(g_qn + col0), g1 = *(const f32x4*)(g_qn + col0 + 4);
#pragma unroll
          for (int ai = 0; ai < 2; ++ai)
#pragma unroll
            for (int m = 0; m < 4; ++m) { const int r = ai * HALF + wr * 64 + m * 16 + fr; const float sc = RS[r];
                const f32x4 v0 = acc[ai][0][m][0] * sc * g0, v1 = acc[ai][0][m][1] * sc * g1; u32x4 w;
                w.x = cvt_pk_bf16(v0[0], v0[1]); w.y = cvt_pk_bf16(v0[2], v0[3]); w.z = cvt_pk_bf16(v1[0], v1[1]); w.w = cvt_pk_bf16(v1[2], v1[3]);
                *(u32x4*)(Q + (((size_t)b * NH + h) * T + t0 + r) * DQK + col0) = w; } }
        if (wc < 2) {
            const f32x4 g0 = *(const f32x4*)(g_qn + 128 + col0), g1 = *(const f32x4*)(g_qn + 128 + col0 + 4);
            const bool second = fq >= 2; const int fi0 = (8 * fq) & 15;
#pragma unroll
            for (int ai = 0; ai < 2; ++ai)
#pragma unroll
                for (int m = 0; m < 4; ++m) { const int r = ai * HALF + wr * 64 + m * 16 + fr; const float sc = RS[r];
                    const int t = t0 + r; const int pos = wc ? (t & 63) : (t >> 6);
                    const f32x4 v0 = acc[ai][1][m][0] * sc * g0, v1 = acc[ai][1][m][1] * sc * g1; float o[8];
#pragma unroll
                    for (int q = 0; q < 8; ++q) { const float own = q < 4 ? v0[q & 3] : v1[q & 3];
                        auto r_ = __builtin_amdgcn_permlane32_swap(__float_as_uint(own), __float_as_uint(own), false, false);
                        const float oth = second ? __uint_as_float(r_[0]) : __uint_as_float(r_[1]);
                        const f32x2 cs = *(const f32x2*)(rt + (pos * 16 + fi0 + q) * 2);
                        o[q] = second ? (own * cs[0] + oth * cs[1]) : (own * cs[0] - oth * cs[1]); }
                    u32x4 w; w.x = cvt_pk_bf16(o[0], o[1]); w.y = cvt_pk_bf16(o[2], o[3]); w.z = cvt_pk_bf16(o[4], o[5]); w.w = cvt_pk_bf16(o[6], o[7]);
                    *(u32x4*)(Q + (((size_t)b * NH + h) * T + t0 + r) * DQK + 128 + col0) = w; } }
        asm volatile("s_waitcnt lgkmcnt(0)" ::: "memory"); __builtin_amdgcn_s_barrier(); asm volatile("" ::: "memory");
    }
};
}

template <int CTRL> __device__ __forceinline__ int dppi(int v) { return __builtin_amdgcn_update_dpp(0, v, CTRL, 0xf, 0xf, true); }
template <int CTRL> __device__ __forceinline__ float dppf(float v) { return __int_as_float(__builtin_amdgcn_update_dpp(0, __float_as_int(v), CTRL, 0xf, 0xf, true)); }
__device__ __forceinline__ int row_sum_i(int d) { d += dppi<0xB1>(d); d += dppi<0x4E>(d); d += dppi<0x141>(d); d += dppi<0x140>(d); return d; }
__device__ __forceinline__ float row_sum_f(float d) { d += dppf<0xB1>(d); d += dppf<0x4E>(d); d += dppf<0x141>(d); d += dppf<0x140>(d); return d; }
__device__ __forceinline__ float wave_sum_fast(float v) {
    v = row_sum_f(v);
    { auto r = __builtin_amdgcn_permlane16_swap(__float_as_uint(v), __float_as_uint(v), false, false); v = __uint_as_float(r[0]) + __uint_as_float(r[1]); }
    { auto r = __builtin_amdgcn_permlane32_swap(__float_as_uint(v), __float_as_uint(v), false, false); v = __uint_as_float(r[0]) + __uint_as_float(r[1]); }
    return v;
}
__device__ __forceinline__ float wave_max_fast(float v) {
    v = fmaxf(v, dppf<0xB1>(v)); v = fmaxf(v, dppf<0x4E>(v)); v = fmaxf(v, dppf<0x141>(v)); v = fmaxf(v, dppf<0x140>(v));
    { auto r = __builtin_amdgcn_permlane16_swap(__float_as_uint(v), __float_as_uint(v), false, false); v = fmaxf(__uint_as_float(r[0]), __uint_as_float(r[1])); }
    { auto r = __builtin_amdgcn_permlane32_swap(__float_as_uint(v), __float_as_uint(v), false, false); v = fmaxf(__uint_as_float(r[0]), __uint_as_float(r[1])); }
    return v;
}
__device__ __forceinline__ float wave_max(float v) {
#pragma unroll
    for (int o = 1; o < 64; o <<= 1) v = fmaxf(v, __shfl_xor(v, o));
    return v;
}
__device__ __forceinline__ unsigned q8pack(f32x4 v, float inv, int bias) {
    int a = __float2int_rn(v[0] * inv), b = __float2int_rn(v[1] * inv), c = __float2int_rn(v[2] * inv), d = __float2int_rn(v[3] * inv);
    a = min(127, max(-127, a)) + bias; b = min(127, max(-127, b)) + bias; c = min(127, max(-127, c)) + bias; d = min(127, max(-127, d)) + bias;
    return (unsigned)(a & 0xff) | ((unsigned)(b & 0xff) << 8) | ((unsigned)(c & 0xff) << 16) | ((unsigned)(d & 0xff) << 24);
}
template <bool SLICED> __device__ __forceinline__ void quant_row(const float* src, unsigned* dst, float* scale, int bias, int lane, int row) {
    f32x4 v[4]; float m = 0.f;
#pragma unroll
    for (int j = 0; j < 4; ++j) { v[j] = ((const f32x4*)src)[lane + 64 * j]; m = fmaxf(m, fmaxf(fmaxf(fabsf(v[j][0]), fabsf(v[j][1])), fmaxf(fabsf(v[j][2]), fabsf(v[j][3])))); }
    m = fmaxf(wave_max(m), 1e-30f); const float inv = 127.f / m;
#pragma unroll
    for (int j = 0; j < 4; ++j) { if (SLICED) dst[(size_t)(2 * j + (lane >> 5)) * (NEXP * 32) + (size_t)row * 32 + (lane & 31)] = q8pack(v[j], inv, bias); else { const int d_ = lane + 64 * j; dst[((size_t)(pe_slice(row) * 32 + (d_ >> 3)) * 2048 + pe_local((unsigned)row)) * 8 + (d_ & 7)] = q8pack(v[j], inv, bias); } }
    if (lane == 0) *scale = m * (1.f / 127.f);
}
template <bool QPAD = false> __device__ __forceinline__ void transpose_item(const float* W, int K, int N, int Npad, const float* kscale, bf16_t* WT, LAS float* scr, int item, int lane) {
    const int nblk = Npad / 32, kb = item / nblk, nb = item % nblk, k0 = 64 * kb, n0 = 32 * nb;
    const int d0 = QPAD ? (nb / 6) * 256 + (nb % 6) * 32 : n0;
#pragma unroll 8
    for (int i = 0; i < 32; ++i) { const int kk = 2 * i + (lane >> 5); const int n = n0 + (lane & 31);
        float v = (n < N) ? W[(size_t)(k0 + kk) * N + n] : 0.f; if (kscale) v *= kscale[k0 + kk]; scr[kk * 33 + (lane & 31)] = v; }
    asm volatile("s_waitcnt lgkmcnt(0)" ::: "memory");
    const int c = lane & 7;
#pragma unroll
    for (int j = 0; j < 4; ++j) { const int n = (lane >> 3) + 8 * j; const LAS float* s = scr + (8 * c) * 33 + n;
        u32x4 o; o.x = cvt_pk_bf16(s[0 * 33], s[1 * 33]); o.y = cvt_pk_bf16(s[2 * 33], s[3 * 33]); o.z = cvt_pk_bf16(s[4 * 33], s[5 * 33]); o.w = cvt_pk_bf16(s[6 * 33], s[7 * 33]);
        *(u32x4*)(WT + (size_t)(d0 + n) * K + k0 + 8 * c) = o; }
    asm volatile("s_waitcnt lgkmcnt(0)" ::: "memory");
}

__device__ __forceinline__ void phase_prep(const Params& p, LAS unsigned char* lds, const int tidx) {
    const int tid = tidx, lane = tid & 63, wave = tid >> 6;
    const int gw = blockIdx.x * NWAVES + wave, NGW = gridDim.x * NWAVES;
    LAS float* scr = (LAS float*)(lds + wave * 8704);
    unsigned char* ws = p.ws;
    constexpr int I_IN = (D / 64) * (INCP / 32), I_UQ = (256 / 64) * (768 / 32), I_UKV = (128 / 64) * (1024 / 32), I_OUT = (D / 64) * (D / 32), I_PQ = (D / 64) * (2048 / 32);
    constexpr int NITEMS = I_IN + I_UQ + I_UKV + I_OUT + I_PQ;
    if (blockIdx.x < 96) {
      LAS float* part = (LAS float*)(lds + 8 * 8704);
      LAS float* sil = part + 8 * 9 * 64;
      for (int i = tid; i < 9 * D; i += NTHREADS) { const int q = i >> 10, k = i & 1023; sil[i] = siluf(q < 8 ? p.c[q * D + k] : p.c_ctx[k]); }
      __syncthreads();
      for (int cgp = blockIdx.x; cgp < 96; cgp += gridDim.x) {
        const int col = cgp * 64 + lane;
        float acc[9];
#pragma unroll
        for (int q = 0; q < 9; ++q) acc[q] = 0.f;
#pragma unroll 8
        for (int kk = 0; kk < 128; ++kk) { const int k = wave * 128 + kk; const float w = p.w_ada[(size_t)k * NMOD + col];
#pragma unroll
            for (int q = 0; q < 9; ++q) acc[q] += sil[q * D + k] * w; }
        __syncthreads();
#pragma unroll
        for (int q = 0; q < 9; ++q) part[(wave * 9 + q) * 64 + lane] = acc[q];
        __syncthreads();
        float* mod = (float*)(ws + WS_MOD);
        for (int o = tid; o < 9 * 64; o += NTHREADS) { const int q = o >> 6, cl = o & 63; float s = p.b_ada[cgp * 64 + cl];
#pragma unroll
            for (int w8 = 0; w8 < 8; ++w8) s += part[(w8 * 9 + q) * 64 + cl];
            mod[q * NMOD + cgp * 64 + cl] = s; }
      } }
    for (int it = gw; it < NITEMS; it += NGW) {
        int r = it;
        if (r < I_IN) { transpose_item(p.w_in, D, INC, INCP, nullptr, (bf16_t*)(ws + WS_WIN), scr, r, lane); continue; } r -= I_IN;
        if (r < I_UQ) { transpose_item<true>(p.w_uq, 256, 768, 768, p.g_cq, (bf16_t*)(ws + WS_WUQ), scr, r, lane); continue; } r -= I_UQ;
        if (r < I_UKV) { transpose_item(p.w_ukv, 128, 1024, 1024, p.g_ckv, (bf16_t*)(ws + WS_WUKV), scr, r, lane); continue; } r -= I_UKV;
        if (r < I_OUT) { transpose_item(p.w_out, D, D, D, nullptr, (bf16_t*)(ws + WS_WOUT), scr, r, lane); continue; } r -= I_OUT;
        transpose_item(p.w_pq, D, 2048, 2048, nullptr, (bf16_t*)(ws + WS_WPQ), scr, r, lane);
    }
    const int gt = blockIdx.x * NTHREADS + tid, NGT = gridDim.x * NTHREADS;
    { bf16_t* wq = (bf16_t*)(ws + WS_WUQ);
      for (int i = gt; i < 4 * 64 * 256 / 8; i += NGT) { const int hd = i / (64 * 32), rem = i % (64 * 32); *(u32x4*)(wq + ((size_t)hd * 256 + 192) * 256 + (size_t)rem * 8) = (u32x4){0u, 0u, 0u, 0u}; } }
    { bf16_t* skb = (bf16_t*)(ws + WS_SKB);
      for (int i = gt; i < PH * 2 * NKEYS * 128 / 4; i += NGT) { const f32x4 v = ((const f32x4*)p.sub_keys)[i]; u32x2 o; o.x = cvt_pk_bf16(v[0], v[1]); o.y = cvt_pk_bf16(v[2], v[3]); ((u32x2*)skb)[i] = o; } }
    { float* rt = (float*)(ws + WS_ROPE);
      for (int i = gt; i < 64 * 16; i += NGT) { const int pos = i >> 4, j = i & 15; const float inv = powf(10000.f, -(float)j * (2.0f / 32.0f)); const float ang = (float)pos * inv;
          rt[2 * i] = cosf(ang); rt[2 * i + 1] = sinf(ang); } }
}

__device__ __forceinline__ void quant_experts(const Params& p, int vb, int nvb, const int tidx) {
    const int lane = tidx & 63, wave = tidx >> 6; unsigned char* ws = p.ws;
    unsigned* eu8 = (unsigned*)(ws + WS_EU8); unsigned* ev8 = (unsigned*)(ws + WS_EV8); float* su = (float*)(ws + WS_SU); float* sv = (float*)(ws + WS_SV);
    for (int r = vb * NWAVES + wave; r < 2 * NEXP; r += nvb * NWAVES) {
        if (r < NEXP) quant_row<false>(p.expert_u + (size_t)r * D, eu8, su + r, 0, lane, r);
        else { const int e = r - NEXP; quant_row<true>(p.expert_v + (size_t)e * D, ev8, sv + e, 0, lane, e); } }
}
__device__ __forceinline__ void norm_mod_row(const float* src, const float* g, const float* sh, const float* sc, bf16_t* dst, int lane) {
    f32x4 v[4]; float s = 0.f;
#pragma unroll
    for (int j = 0; j < 4; ++j) { v[j] = ((const f32x4*)src)[lane + 64 * j]; s += (v[j][0] * v[j][0] + v[j][1] * v[j][1]) + (v[j][2] * v[j][2] + v[j][3] * v[j][3]); }
    const float rstd = rsqrtf(wave_sum(s) * (1.f / D) + EPS);
#pragma unroll
    for (int j = 0; j < 4; ++j) { const int i4 = lane + 64 * j; const f32x4 gg = ((const f32x4*)g)[i4], s1 = ((const f32x4*)sc)[i4], h1 = ((const f32x4*)sh)[i4];
        const f32x4 o = v[j] * rstd * gg * (s1 + 1.f) + h1; u32x2 w; w.x = cvt_pk_bf16(o[0], o[1]); w.y = cvt_pk_bf16(o[2], o[3]); ((u32x2*)dst)[i4] = w; }
}
__device__ __forceinline__ void phase_hnorm(const Params& p, const int tidx) {
    const int lane = tidx & 63, wave = tidx >> 6;
    const int gw = blockIdx.x * NWAVES + wave, NGW = gridDim.x * NWAVES;
    const float* mod = (const float*)(p.ws + WS_MOD); bf16_t* hb = (bf16_t*)(p.ws + WS_HB);
    f32x4 na[4] = {}, nb[4] = {};
    auto srcof = [&](int row) { return row < NLAT ? p.x + (size_t)row * D : p.ctx + (size_t)(row - NLAT) * D; };
    auto fetch = [&](f32x4 (&d)[4], int row) { if (row < NTOK) { const float* s_ = srcof(row);
#pragma unroll
        for (int j = 0; j < 4; ++j) d[j] = ((const f32x4*)s_)[lane + 64 * j]; } };
    auto finish = [&](const f32x4 (&v)[4], int row) {
        const int mr = row < NLAT ? row / T : 8; const float* sh = mod + (size_t)mr * NMOD, * sc = sh + D; bf16_t* dst = hb + (size_t)row * D;
        float s = 0.f;
#pragma unroll
        for (int j = 0; j < 4; ++j) s += (v[j][0] * v[j][0] + v[j][1] * v[j][1]) + (v[j][2] * v[j][2] + v[j][3] * v[j][3]);
        const float rstd = rsqrtf(wave_sum_fast(s) * (1.f / D) + EPS);
#pragma unroll
        for (int j = 0; j < 4; ++j) { const int i4 = lane + 64 * j; const f32x4 gg = ((const f32x4*)p.g_norm1)[i4], s1 = ((const f32x4*)sc)[i4], h1 = ((const f32x4*)sh)[i4];
            const f32x4 o = v[j] * rstd * gg * (s1 + 1.f) + h1; u32x2 w; w.x = cvt_pk_bf16(o[0], o[1]); w.y = cvt_pk_bf16(o[2], o[3]); ((u32x2*)dst)[i4] = w; } };
    fetch(na, gw); fetch(nb, gw + NGW);
    for (int row = gw; row < NTOK; row += 2 * NGW) {
        f32x4 ca[4];
#pragma unroll
        for (int j = 0; j < 4; ++j) ca[j] = na[j];
        fetch(na, row + 2 * NGW);
        finish(ca, row);
        if (row + NGW < NTOK) {
#pragma unroll
            for (int j = 0; j < 4; ++j) ca[j] = nb[j];
            fetch(nb, row + 3 * NGW);
            finish(ca, row + NGW);
        }
    }
}

__device__ __forceinline__ int ml_row0(int b, int blk) { return blk == 0 ? NLAT + b * TC : b * T + (blk - 1) * MCH; }
__device__ __forceinline__ void conv_silu8(const bf16_t* cols, const float* convw, int row, int seg_lo, int seg_hi, int ch0, float (&o)[8]) {
    const u32x4 z = {0u, 0u, 0u, 0u};
    const u32x4 a = (row - 1 >= seg_lo) ? *(const u32x4*)(cols + (size_t)(row - 1) * INCP + C_MQ + ch0) : z;
    const u32x4 b = *(const u32x4*)(cols + (size_t)row * INCP + C_MQ + ch0);
    const u32x4 c = (row + 1 < seg_hi) ? *(const u32x4*)(cols + (size_t)(row + 1) * INCP + C_MQ + ch0) : z;
#pragma unroll
    for (int i = 0; i < 4; ++i) {
        const float w0a = convw[0 * 512 + ch0 + 2 * i], w1a = convw[1 * 512 + ch0 + 2 * i], w2a = convw[2 * 512 + ch0 + 2 * i];
        const float w0b = convw[0 * 512 + ch0 + 2 * i + 1], w1b = convw[1 * 512 + ch0 + 2 * i + 1], w2b = convw[2 * 512 + ch0 + 2 * i + 1];
        o[2 * i] = siluf(w0a * bf_lo(a[i]) + w1a * bf_lo(b[i]) + w2a * bf_lo(c[i]));
        o[2 * i + 1] = siluf(w0b * bf_hi(a[i]) + w1b * bf_hi(b[i]) + w2b * bf_hi(c[i]));
    }
}
__device__ __forceinline__ float scan_sum256(LAS float* sc, float v, int tid) {
    const int i = tid & 255; __syncthreads(); sc[tid] = v; __syncthreads();
#pragma unroll
    for (int off = 1; off < 256; off <<= 1) { float t = sc[tid]; if (i >= off) t += sc[tid - off]; __syncthreads(); sc[tid] = t; __syncthreads(); }
    return sc[tid];
}
__device__ __forceinline__ float scan_max256(LAS float* sc, float v, int tid) {
    const int i = tid & 255; __syncthreads(); sc[tid] = v; __syncthreads();
#pragma unroll
    for (int off = 1; off < 256; off <<= 1) { float t = sc[tid]; if (i >= off) t = fmaxf(t, sc[tid - off]); __syncthreads(); sc[tid] = t; __syncthreads(); }
    return sc[tid];
}

constexpr int VT_LD = 264;
__device__ __forceinline__ void ml_summary_unit(const Params& p, LAS unsigned char* lds, int unit, const int tidx) {
    const int tid = tidx, lane = tid & 63, wave = tid >> 6;
    const int blk = unit % 17, h = (unit / 17) % MH, b = unit / (17 * MH);
    const int row0 = ml_row0(b, blk), seg_lo = blk == 0 ? NLAT + b * TC : b * T, seg_hi = blk == 0 ? seg_lo + TC : seg_lo + T;
    const bf16_t* cols = (const bf16_t*)(p.ws + WS_COLS); const float* gates = (const float*)(p.ws + WS_GATES);
    LAS bf16_t* vT = (LAS bf16_t*)lds;
    LAS bf16_t* kfT = vT + 128 * VT_LD;
    LAS bf16_t* kbT = kfT + 64 * VT_LD;
    LAS float* sc = (LAS float*)(kbT + 64 * VT_LD);
    LAS float* wgt = sc + 512;
    LAS float* red = wgt + 512;
    __syncthreads();
    const int d = tid >> 8, i = tid & 255, tau = d ? 255 - i : i;
    const float graw_i = gates[(size_t)(row0 + tau) * 16 + d * 4 + h], graw_f = gates[(size_t)(row0 + tau) * 16 + 8 + d * 4 + h];
    const float ig = graw_i + p.b_igate[d * 4 + h], lf = logsigmoidf_(graw_f + p.b_fgate[d * 4 + h]);
    const float cum = scan_sum256(sc, lf, tid);
    const float F = sc[d * 256 + 255];
    const float a = (F - cum) + ig;
    const float mloc = scan_max256(sc, a, tid);
    const float mx = sc[d * 256 + 255];
    (void)mloc;
    wgt[d * 256 + tau] = __expf(a - mx);
    if (i == 0) { float* ms = (float*)(p.ws + WS_MSCAL) + ((((size_t)d * NB + b) * MH + h) * 17 + blk) * 2; ms[0] = F; ms[1] = mx; }
    __syncthreads();
    { const int t = tid & 255, hf = tid >> 8; const int row = row0 + t;
      const float wf = wgt[t], wb = wgt[256 + t];
#pragma unroll 2
      for (int c8 = 0; c8 < 8; ++c8) { const int ch = 64 * hf + 8 * c8; const u32x4 v = *(const u32x4*)(cols + (size_t)row * INCP + C_MV + h * MDV + ch);
#pragma unroll
          for (int q = 0; q < 4; ++q) { vT[(ch + 2 * q) * VT_LD + t] = (bf16_t)(v[q] & 0xffffu); vT[(ch + 2 * q + 1) * VT_LD + t] = (bf16_t)(v[q] >> 16); } }
#pragma unroll 1
      for (int c8 = 0; c8 < 4; ++c8) { const int ch = 32 * hf + 8 * c8; float kv[8]; conv_silu8(cols, p.conv_qk, row, seg_lo, seg_hi, 256 + h * MDK + ch, kv);
#pragma unroll
          for (int q = 0; q < 8; ++q) { kfT[(ch + q) * VT_LD + t] = f2bf(kv[q] * wf); kbT[(ch + q) * VT_LD + t] = f2bf(kv[q] * wb); } }
    }
    __syncthreads();
    { const int dvb = wave & 3, dkb = wave >> 2, r = lane & 31, hh = lane >> 5;
      f32x16 accf = {}, accb = {};
#pragma unroll 2
      for (int ks = 0; ks < 16; ++ks) { const int t0 = 16 * ks + 8 * hh;
          const bf16x8 av = *(const LAS bf16x8*)(vT + (dvb * 32 + r) * VT_LD + t0);
          const bf16x8 bf = *(const LAS bf16x8*)(kfT + (dkb * 32 + r) * VT_LD + t0);
          const bf16x8 bb = *(const LAS bf16x8*)(kbT + (dkb * 32 + r) * VT_LD + t0);
          accf = __builtin_amdgcn_mfma_f32_32x32x16_bf16(av, bf, accf, 0, 0, 0);
          accb = __builtin_amdgcn_mfma_f32_32x32x16_bf16(av, bb, accb, 0, 0, 0); }
      float* Uf = (float*)(p.ws + WS_U) + ((((size_t)0 * NB + b) * MH + h) * 17 + blk) * (MDV * MDK);
      float* Ub = (float*)(p.ws + WS_U) + ((((size_t)1 * NB + b) * MH + h) * 17 + blk) * (MDV * MDK);
#pragma unroll
      for (int q = 0; q < 16; ++q) { const int dv = dvb * 32 + crow(q, hh), dk = dkb * 32 + r; Uf[dv * MDK + dk] = accf[q]; Ub[dv * MDK + dk] = accb[q]; }
    }
    if (tid < 128) { const int dd = tid >> 6, dk = tid & 63; const LAS bf16_t* rowp = (dd ? kbT : kfT) + dk * VT_LD; float s = 0.f;
        for (int t = 0; t < 256; ++t) s += bf2f(rowp[t]);
        ((float*)(p.ws + WS_NL))[((((size_t)dd * NB + b) * MH + h) * 17 + blk) * MDK + dk] = s; }
    (void)red;
}

__device__ __forceinline__ int ml_blkof(int d, int j) { return d == 0 ? j : (j == 0 ? 0 : 17 - j); }
__device__ __forceinline__ void phase_ml_scan(const Params& p, const int tidx) {
    const int gt = blockIdx.x * NTHREADS + tidx, NGT = gridDim.x * NTHREADS;
    const float* ms = (const float*)(p.ws + WS_MSCAL); const float* U = (const float*)(p.ws + WS_U); const float* NL = (const float*)(p.ws + WS_NL);
    bf16_t* cst = (bf16_t*)(p.ws + WS_CST); float* nst = (float*)(p.ws + WS_NST); float* mst = (float*)(p.ws + WS_MST);
    constexpr int EPS_ = MDV * MDK + MDK;
    for (int e = gt; e < 64 * EPS_; e += NGT) {
        const int s = e / EPS_, el = e % EPS_;
        const int d = s / (NB * MH);
        float u[16];
#pragma unroll
        for (int j = 0; j < 16; ++j) { const int blk = ml_blkof(d, j); u[j] = (el < MDV * MDK) ? U[((size_t)s * 17 + blk) * (MDV * MDK) + el] : NL[((size_t)s * 17 + blk) * MDK + (el - MDV * MDK)]; }
        float m = 0.f, C = 0.f;
#pragma unroll
        for (int j = 0; j < 16; ++j) { const int blk = ml_blkof(d, j); const float F = ms[((size_t)s * 17 + blk) * 2], ml = ms[((size_t)s * 17 + blk) * 2 + 1];
            const float mn = fmaxf(F + m, ml); C = __expf(F + m - mn) * C + __expf(ml - mn) * u[j]; m = mn;
            if (el < MDV * MDK) cst[((size_t)s * 16 + j) * (MDV * MDK) + el] = f2bf(C); else nst[((size_t)s * 16 + j) * MDK + (el - MDV * MDK)] = C;
            if (el == 0) mst[(size_t)s * 16 + j] = m; }
    }
}

constexpr int QK_LD = 72;
__device__ __forceinline__ void ml_output_unit(const Params& p, LAS unsigned char* lds, int unit, const int tidx) {
    const int tid = tidx, lane = tid & 63, wave = tid >> 6;
    const int ib = unit % NBLK, h = (unit / NBLK) % MH, b = unit / (NBLK * MH);
    const int blk = ib + 1, row0 = ml_row0(b, blk), seg_lo = b * T, seg_hi = seg_lo + T;
    const bf16_t* cols = (const bf16_t*)(p.ws + WS_COLS); const float* gates = (const float*)(p.ws + WS_GATES);
    LAS bf16_t* vT = (LAS bf16_t*)lds;
    LAS bf16_t* qs = vT + 128 * VT_LD;
    LAS bf16_t* ks_ = qs + 256 * QK_LD;
    LAS float* sc = (LAS float*)(ks_ + 256 * QK_LD);
    LAS float* alpha = sc + 512;
    LAS float* beta = alpha + 512, *sint = beta + 512, *flr = sint + 512;
    LAS float* nv = flr + 512;
    __syncthreads();
    {
        const int d = tid >> 8, i = tid & 255, tau = d ? 255 - i : i;
        const float graw_i = gates[(size_t)(row0 + tau) * 16 + d * 4 + h], graw_f = gates[(size_t)(row0 + tau) * 16 + 8 + d * 4 + h];
        const float ig = graw_i + p.b_igate[d * 4 + h], lf = logsigmoidf_(graw_f + p.b_fgate[d * 4 + h]);
        const float cum = scan_sum256(sc, lf, tid);
        const float bt = ig - cum;
        const float pm = scan_max256(sc, bt, tid);
        const int sidx = d == 0 ? ib : 15 - ib;
        const int s = (d * NB + b) * MH + h;
        const float mprev = ((const float*)(p.ws + WS_MST))[(size_t)s * 16 + sidx];
        const float mt = fmaxf(cum + mprev, cum + pm);
        alpha[d * 256 + tau] = cum - mt; beta[d * 256 + tau] = bt; sint[d * 256 + tau] = __expf(cum + mprev - mt); flr[d * 256 + tau] = __expf(-mt);
        if (i < 64) nv[d * 64 + i] = ((const float*)(p.ws + WS_NST))[((size_t)s * 16 + sidx) * MDK + i];
    }
    {
        const int t = tid & 255, hf = tid >> 8; const int row = row0 + t;
#pragma unroll
        for (int c8 = 0; c8 < 8; ++c8) { const int ch = 64 * hf + 8 * c8; const u32x4 v = *(const u32x4*)(cols + (size_t)row * INCP + C_MV + h * MDV + ch);
#pragma unroll
            for (int q = 0; q < 4; ++q) { vT[(ch + 2 * q) * VT_LD + t] = (bf16_t)(v[q] & 0xffffu); vT[(ch + 2 * q + 1) * VT_LD + t] = (bf16_t)(v[q] >> 16); } }
#pragma unroll
        for (int c8 = 0; c8 < 4; ++c8) { const int ch = 32 * hf + 8 * c8; float kv[8], qv[8];
            conv_silu8(cols, p.conv_qk, row, seg_lo, seg_hi, 256 + h * MDK + ch, kv); conv_silu8(cols, p.conv_qk, row, seg_lo, seg_hi, h * MDK + ch, qv);
            u32x4 kw, qw;
#pragma unroll
            for (int q = 0; q < 4; ++q) { kw[q] = cvt_pk_bf16(kv[2 * q], kv[2 * q + 1]); qw[q] = cvt_pk_bf16(qv[2 * q] * 0.125f, qv[2 * q + 1] * 0.125f); }
            *(LAS u32x4*)(ks_ + t * QK_LD + ch) = kw; *(LAS u32x4*)(qs + t * QK_LD + ch) = qw; }
    }
    __syncthreads();
    const int c = lane & 31, hh = lane >> 5, tq = 32 * wave + c;
    bf16x8 qf[4];
#pragma unroll
    for (int ks = 0; ks < 4; ++ks) qf[ks] = *(const LAS bf16x8*)(qs + tq * QK_LD + 16 * ks + 8 * hh);
    f32x16 hsum[4];
#pragma unroll
    for (int dvb = 0; dvb < 4; ++dvb) hsum[dvb] = (f32x16){};
#pragma unroll 1
    for (int d = 0; d < 2; ++d) {
        const int sidx = d == 0 ? ib : 15 - ib; const int s = (d * NB + b) * MH + h;
        const bf16_t* Cst = (const bf16_t*)(p.ws + WS_CST) + ((size_t)s * 16 + sidx) * (MDV * MDK);
        const float al = alpha[d * 256 + tq], si = sint[d * 256 + tq], fl = flr[d * 256 + tq];
        f32x16 acc[4];
#pragma unroll
        for (int dvb = 0; dvb < 4; ++dvb) { f32x16 t = {};
#pragma unroll
            for (int ks = 0; ks < 4; ++ks) { const bf16x8 af = *(const bf16x8*)(Cst + (size_t)(dvb * 32 + c) * MDK + 16 * ks + 8 * hh); t = __builtin_amdgcn_mfma_f32_32x32x16_bf16(af, qf[ks], t, 0, 0, 0); }
            acc[dvb] = t * si; if (dvb & 1) asm volatile("" ::: "memory"); }
        float nq = 0.f;
#pragma unroll
        for (int j = 0; j < 32; ++j) nq += nv[d * 64 + 32 * hh + j] * bf2f(qs[tq * QK_LD + 32 * hh + j]);
        nq += __shfl_xor(nq, 32);
        float den = 0.f;
        const int sb_lo = d == 0 ? 0 : wave, sb_hi = d == 0 ? wave : 7;
#pragma unroll 1
        for (int sb = sb_lo; sb <= sb_hi; ++sb) {
            f32x16 st = {};
#pragma unroll
            for (int ks = 0; ks < 4; ++ks) { const bf16x8 af = *(const LAS bf16x8*)(ks_ + (32 * sb + c) * QK_LD + 16 * ks + 8 * hh); st = __builtin_amdgcn_mfma_f32_32x32x16_bf16(af, qf[ks], st, 0, 0, 0); }
#pragma unroll
            for (int q = 0; q < 16; ++q) { const int sg = 32 * sb + crow(q, hh); const float w = __expf(al + beta[d * 256 + sg]) * st[q];
                const bool ok = d == 0 ? (sg <= tq) : (sg >= tq); st[q] = ok ? w : 0.f; den += st[q]; }
            bf16x8 wf[2];
#pragma unroll
            for (int s2 = 0; s2 < 2; ++s2) { u32x4 w; w.x = cvt_pk_bf16(st[8 * s2 + 0], st[8 * s2 + 1]); w.y = cvt_pk_bf16(st[8 * s2 + 2], st[8 * s2 + 3]); w.z = cvt_pk_bf16(st[8 * s2 + 4], st[8 * s2 + 5]); w.w = cvt_pk_bf16(st[8 * s2 + 6], st[8 * s2 + 7]);
                wf[s2] = __builtin_bit_cast(bf16x8, w); }
#pragma unroll
            for (int dvb = 0; dvb < 4; ++dvb)
#pragma unroll
                for (int s2 = 0; s2 < 2; ++s2) { const LAS bf16_t* vp = vT + (dvb * 32 + c) * VT_LD + 32 * sb + 16 * s2 + 4 * hh;
                    const s16x4 lo = *(const LAS s16x4*)vp, hi = *(const LAS s16x4*)(vp + 8);
                    const bf16x8 af = {lo[0], lo[1], lo[2], lo[3], hi[0], hi[1], hi[2], hi[3]};
                    acc[dvb] = __builtin_amdgcn_mfma_f32_32x32x16_bf16(af, wf[s2], acc[dvb], 0, 0, 0); }
        }
        den += __shfl_xor(den, 32);
        const float dt = den + si * nq; const float inv = 1.f / fmaxf(fabsf(dt), fl);
#pragma unroll
        for (int dvb = 0; dvb < 4; ++dvb) hsum[dvb] += acc[dvb] * inv;
    }
    float ss = 0.f;
#pragma unroll
    for (int dvb = 0; dvb < 4; ++dvb)
#pragma unroll
        for (int q = 0; q < 16; ++q) ss += hsum[dvb][q] * hsum[dvb][q];
    ss += __shfl_xor(ss, 32);
    const float rstd = rsqrtf(ss * (1.f / MDV) + EPS);
    const int row = row0 + tq; bf16_t* mix = (bf16_t*)(p.ws + WS_MIX) + (size_t)row * D + 512 + h * MDV;
    const bf16_t* orow = cols + (size_t)row * INCP + C_MO + h * MDV;
#pragma unroll
    for (int dvb = 0; dvb < 4; ++dvb)
#pragma unroll
        for (int q4 = 0; q4 < 4; ++q4) { const int dv = dvb * 32 + 8 * q4 + 4 * hh; const u32x2 ow = *(const u32x2*)(orow + dv); const f32x4 gg = *(const f32x4*)(p.g_mlstm + h * MDV + dv);
            const float o0 = sigmoidf_(bf_lo(ow.x)) * hsum[dvb][4 * q4 + 0] * rstd * gg[0], o1 = sigmoidf_(bf_hi(ow.x)) * hsum[dvb][4 * q4 + 1] * rstd * gg[1];
            const float o2 = sigmoidf_(bf_lo(ow.y)) * hsum[dvb][4 * q4 + 2] * rstd * gg[2], o3 = sigmoidf_(bf_hi(ow.y)) * hsum[dvb][4 * q4 + 3] * rstd * gg[3];
            u32x2 w; w.x = cvt_pk_bf16(o0, o1); w.y = cvt_pk_bf16(o2, o3); *(u32x2*)(mix + dv) = w; }
}

__device__ __forceinline__ void phase_mla_fin(const Params& p, LAS unsigned char* lds, const int tidx) {
    const int lane = tidx & 63, wave = tidx >> 6;
    const int gw = blockIdx.x * NWAVES + wave, NGW = gridDim.x * NWAVES;
    LAS float* sq = (LAS float*)(lds + wave * 8192);
    const bf16_t* cols = (const bf16_t*)(p.ws + WS_COLS); const bf16_t* qraw = (const bf16_t*)(p.ws + WS_QRAW); const bf16_t* kvraw = (const bf16_t*)(p.ws + WS_KVRAW);
    const float* ssq = (const float*)(p.ws + WS_SSQ); const float* rt = (const float*)(p.ws + WS_ROPE);
    bf16_t* Q = (bf16_t*)(p.ws + WS_Q); bf16_t* Kb = (bf16_t*)(p.ws + WS_K); bf16_t* VT = (bf16_t*)(p.ws + WS_VT);
#pragma unroll 2
    for (int row = gw; row < NLAT; row += NGW) {
        const int b = row / T; const int t = row % T; const int prow = t >> 6, pcol = t & 63;
        const f32x4 sq4 = *(const f32x4*)(ssq + (size_t)row * 8);
        const float rq = rsqrtf(((sq4[0] + sq4[1]) + (sq4[2] + sq4[3])) * (1.f / 256.f) + EPS);
        {
            const bf16_t* qp = qraw + (size_t)row * 768 + 12 * lane;
            const u32x2 a0 = *(const u32x2*)qp, a1 = *(const u32x2*)(qp + 4), a2 = *(const u32x2*)(qp + 8);
            float v[12] = {bf_lo(a0.x), bf_hi(a0.x), bf_lo(a0.y), bf_hi(a0.y), bf_lo(a1.x), bf_hi(a1.x), bf_lo(a1.y), bf_hi(a1.y), bf_lo(a2.x), bf_hi(a2.x), bf_lo(a2.y), bf_hi(a2.y)};
            float s = 0.f;
#pragma unroll
            for (int q = 0; q < 12; ++q) { v[q] *= rq; s += v[q] * v[q]; }
            s = row_sum_f(s);
            const float rh = rsqrtf(s * (1.f / 192.f) + EPS);
            const int hd = lane >> 4, off = (lane & 15) * 12;
#pragma unroll
            for (int q = 0; q < 12; ++q) sq[12 * lane + q] = v[q] * rh * p.g_qn[off + q];
            asm volatile("s_waitcnt lgkmcnt(0)" ::: "memory");
            bf16_t* qo = Q + (((size_t)b * NH + hd) * T + t) * DQK + off;
            float o[12];
#pragma unroll
            for (int q = 0; q < 12; ++q) { const int dd = off + q; float val = sq[12 * lane + q];
                if (dd >= 128) { const int j = dd - 128, part = j >> 5, jj = j & 31, fi = jj & 15; const bool second = jj >= 16; const int pos = part ? pcol : prow;
                    const float cs = rt[(pos * 16 + fi) * 2], sn = rt[(pos * 16 + fi) * 2 + 1];
                    const float pt = sq[hd * 192 + 128 + part * 32 + (jj ^ 16)];
                    val = second ? (val * cs + pt * sn) : (val * cs - pt * sn); }
                o[q] = val; }
            u32x2 w0, w1, w2; w0.x = cvt_pk_bf16(o[0], o[1]); w0.y = cvt_pk_bf16(o[2], o[3]); w1.x = cvt_pk_bf16(o[4], o[5]); w1.y = cvt_pk_bf16(o[6], o[7]); w2.x = cvt_pk_bf16(o[8], o[9]); w2.y = cvt_pk_bf16(o[10], o[11]);
            *(u32x2*)qo = w0; *(u32x2*)(qo + 4) = w1; *(u32x2*)(qo + 8) = w2;
            asm volatile("s_waitcnt lgkmcnt(0)" ::: "memory");
        }
    }
}

constexpr int AK_LD = 200;
constexpr int AV_LD = 68;
constexpr int A_KBYTES = 64 * AK_LD * 2, A_VBYTES = 128 * AV_LD * 2;
constexpr int AQ_LD = 72;
__device__ __forceinline__ void attn_unit(const Params& p, LAS unsigned char* lds, int unit, const int tidx) {
    const int tid = tidx, lane = tid & 63, wave = tid >> 6;
    const int qb = unit % (T / 256), h = (unit / (T / 256)) % NH, b = unit / ((T / 256) * NH);
    const bf16_t* Q = (const bf16_t*)(p.ws + WS_Q) + (((size_t)b * NH + h) * T + qb * 256) * DQK;
    const bf16_t* Kg = (const bf16_t*)(p.ws + WS_K) + ((size_t)b * NH + h) * NKEY * DQK;
    const bf16_t* Vg = (const bf16_t*)(p.ws + WS_VT) + ((size_t)b * NH + h) * NKEY * DV;
    const int c = lane & 31, hh = lane >> 5, tq = 32 * wave + c;
    constexpr float CS = 0.07216878364870322f * 1.4426950408889634f;
    bf16x8 qf[8];
#pragma unroll
    for (int ks = 0; ks < 8; ++ks) qf[ks] = *(const bf16x8*)(Q + (size_t)tq * DQK + 16 * ks + 8 * hh);
    LAS bf16_t* Qr = (LAS bf16_t*)(lds + 2 * (A_KBYTES + A_VBYTES));
    __syncthreads();
#pragma unroll
    for (int ks = 8; ks < 12; ++ks) *(LAS bf16x8*)(Qr + tq * AQ_LD + 16 * (ks - 8) + 8 * hh) = *(const bf16x8*)(Q + (size_t)tq * DQK + 16 * ks + 8 * hh);
    f32x16 o[4];
#pragma unroll
    for (int dvb = 0; dvb < 4; ++dvb) o[dvb] = (f32x16){};
    float m = -INFINITY, l = 0.f;
    u32x4 kreg[3], vreg[2];
    const unsigned kofs = (unsigned)tid * 16u, vofs = (unsigned)(tid & 63) * (unsigned)(DV * 2) + (unsigned)(tid >> 6) * 16u;
    unsigned klo[3];
#pragma unroll
    for (int i = 0; i < 3; ++i) { const int ch = tid + 512 * i; klo[i] = (unsigned)((ch / 24) * (AK_LD * 2) + (ch % 24) * 16); }
    const unsigned vlo = (unsigned)(tid >> 6) * 8u * (unsigned)(AV_LD * 2) + (unsigned)(tid & 63) * 2u;
    auto load_k = [&](int kt) { const char* kb = (const char*)Kg + (size_t)kt * (64 * DQK * 2);
#pragma unroll
        for (int i = 0; i < 3; ++i) kreg[i] = *(const u32x4*)(kb + kofs + i * 8192); };
    auto load_v = [&](int kt) { const char* vb = (const char*)Vg + (size_t)kt * (64 * DV * 2);
#pragma unroll
        for (int i = 0; i < 2; ++i) vreg[i] = *(const u32x4*)(vb + vofs + i * 128); };
    auto store_k = [&](int buf) { LAS unsigned char* Ks = lds + buf * A_KBYTES;
#pragma unroll
        for (int i = 0; i < 3; ++i) *(LAS u32x4*)(Ks + klo[i]) = kreg[i]; };
    auto store_v = [&](int buf) { LAS unsigned char* Vs = lds + 2 * A_KBYTES + buf * A_VBYTES;
#pragma unroll
        for (int i = 0; i < 2; ++i) { LAS bf16_t* dp = (LAS bf16_t*)(Vs + vlo + i * (64 * AV_LD * 2));
            dp[0 * AV_LD] = (bf16_t)(vreg[i].x & 0xffffu); dp[1 * AV_LD] = (bf16_t)(vreg[i].x >> 16); dp[2 * AV_LD] = (bf16_t)(vreg[i].y & 0xffffu); dp[3 * AV_LD] = (bf16_t)(vreg[i].y >> 16);
            dp[4 * AV_LD] = (bf16_t)(vreg[i].z & 0xffffu); dp[5 * AV_LD] = (bf16_t)(vreg[i].z >> 16); dp[6 * AV_LD] = (bf16_t)(vreg[i].w & 0xffffu); dp[7 * AV_LD] = (bf16_t)(vreg[i].w >> 16); } };
    constexpr int NT = NKEY / 64;
    f32x16 p0 = {}, p1 = {}; bf16x8 pf[4] = {};
#define AT_QK(kbuf) do { const LAS bf16_t* Ks = (const LAS bf16_t*)(lds + (kbuf) * A_KBYTES); p0 = (f32x16){}; p1 = (f32x16){}; \
        _Pragma("unroll") for (int ks = 0; ks < 12; ++ks) { \
            const bf16x8 a0 = *(const LAS bf16x8*)(Ks + c * AK_LD + 16 * ks + 8 * hh), a1 = *(const LAS bf16x8*)(Ks + (32 + c) * AK_LD + 16 * ks + 8 * hh); \
            const bf16x8 qv = ks < 8 ? qf[ks < 8 ? ks : 0] : *(const LAS bf16x8*)(Qr + tq * AQ_LD + 16 * (ks - 8) + 8 * hh); \
            p0 = __builtin_amdgcn_mfma_f32_32x32x16_bf16(a0, qv, p0, 0, 0, 0); p1 = __builtin_amdgcn_mfma_f32_32x32x16_bf16(a1, qv, p1, 0, 0, 0); } } while (0)
#define AT_SM() do { float mx = p0[0]; \
        _Pragma("unroll") for (int q = 1; q < 16; ++q) mx = fmaxf(mx, p0[q]); \
        _Pragma("unroll") for (int q = 0; q < 16; ++q) mx = fmaxf(mx, p1[q]); \
        { auto r_ = __builtin_amdgcn_permlane32_swap(__float_as_uint(mx), __float_as_uint(mx), false, false); mx = fmaxf(__uint_as_float(r_[0]), __uint_as_float(r_[1])); } \
        const float mxs = mx * CS; \
        if (!__all(mxs <= m + 8.0f)) { const float mn = fmaxf(m, mxs), al = __builtin_amdgcn_exp2f(m - mn); m = mn; l *= al; \
            _Pragma("unroll") for (int dvb = 0; dvb < 4; ++dvb) o[dvb] *= al; } \
        float ps = 0.f; \
        _Pragma("unroll") for (int q = 0; q < 16; ++q) { p0[q] = __builtin_amdgcn_exp2f(fmaf(p0[q], CS, -m)); p1[q] = __builtin_amdgcn_exp2f(fmaf(p1[q], CS, -m)); ps += p0[q] + p1[q]; } \
        { auto r_ = __builtin_amdgcn_permlane32_swap(__float_as_uint(ps), __float_as_uint(ps), false, false); ps = __uint_as_float(r_[0]) + __uint_as_float(r_[1]); } \
        l += ps; \
        _Pragma("unroll") for (int s2 = 0; s2 < 2; ++s2) { u32x4 w; \
            w.x = cvt_pk_bf16(p0[8 * s2 + 0], p0[8 * s2 + 1]); w.y = cvt_pk_bf16(p0[8 * s2 + 2], p0[8 * s2 + 3]); w.z = cvt_pk_bf16(p0[8 * s2 + 4], p0[8 * s2 + 5]); w.w = cvt_pk_bf16(p0[8 * s2 + 6], p0[8 * s2 + 7]); pf[s2] = __builtin_bit_cast(bf16x8, w); \
            w.x = cvt_pk_bf16(p1[8 * s2 + 0], p1[8 * s2 + 1]); w.y = cvt_pk_bf16(p1[8 * s2 + 2], p1[8 * s2 + 3]); w.z = cvt_pk_bf16(p1[8 * s2 + 4], p1[8 * s2 + 5]); w.w = cvt_pk_bf16(p1[8 * s2 + 6], p1[8 * s2 + 7]); pf[2 + s2] = __builtin_bit_cast(bf16x8, w); } } while (0)
#define AT_PV(vbuf) do { const LAS bf16_t* Vs = (const LAS bf16_t*)(lds + 2 * A_KBYTES + (vbuf) * A_VBYTES); \
        _Pragma("unroll") for (int dvb = 0; dvb < 4; ++dvb) _Pragma("unroll") for (int s4 = 0; s4 < 4; ++s4) { const LAS bf16_t* vp = Vs + (dvb * 32 + c) * AV_LD + 16 * s4 + 4 * hh; \
            const s16x4 lo = *(const LAS s16x4*)vp, hi = *(const LAS s16x4*)(vp + 8); const bf16x8 af = {lo[0], lo[1], lo[2], lo[3], hi[0], hi[1], hi[2], hi[3]}; \
            o[dvb] = __builtin_amdgcn_mfma_f32_32x32x16_bf16(af, pf[s4], o[dvb], 0, 0, 0); } } while (0)
    __syncthreads();
    load_k(0); store_k(0);
    const bool grpA = __builtin_amdgcn_readfirstlane(wave) < 4;
    if (grpA) {
#pragma unroll 1
        for (int j = 0; j <= NT; ++j) {
            __syncthreads();
            if (j + 1 < NT) load_k(j + 1);
            if (j < NT) load_v(j);
            if (j > 0) AT_PV((j - 1) & 1);
            if (j < NT) { AT_QK(j & 1); AT_SM(); }
            if (j + 1 < NT) store_k((j + 1) & 1);
            if (j < NT) store_v(j & 1);
        }
    } else {
#pragma unroll 1
        for (int j = 0; j <= NT; ++j) {
            __syncthreads();
            if (j + 1 < NT) load_k(j + 1);
            if (j < NT) load_v(j);
            if (j > 0) { AT_SM(); AT_PV((j - 1) & 1); }
            if (j < NT) AT_QK(j & 1);
            if (j + 1 < NT) store_k((j + 1) & 1);
            if (j < NT) store_v(j & 1);
        }
    }
#undef AT_QK
#undef AT_SM
#undef AT_PV
    const float inv = 1.f / l;
    bf16_t* mix = (bf16_t*)(p.ws + WS_MIX) + (size_t)(b * T + qb * 256 + tq) * D + h * DV;
#pragma unroll
    for (int dvb = 0; dvb < 4; ++dvb)
#pragma unroll
        for (int q4 = 0; q4 < 4; ++q4) { const int dv = dvb * 32 + 8 * q4 + 4 * hh; u32x2 w; w.x = cvt_pk_bf16(o[dvb][4 * q4] * inv, o[dvb][4 * q4 + 1] * inv); w.y = cvt_pk_bf16(o[dvb][4 * q4 + 2] * inv, o[dvb][4 * q4 + 3] * inv); *(u32x2*)(mix + dv) = w; }
}

__device__ __forceinline__ void phase_h2(const Params& p, const int tidx) {
    const int lane = tidx & 63, wave = tidx >> 6;
    const int gw = blockIdx.x * NWAVES + wave, NGW = gridDim.x * NWAVES;
    const float* mod = (const float*)(p.ws + WS_MOD); bf16_t* h2 = (bf16_t*)(p.ws + WS_H2);
    unsigned* h2q = (unsigned*)(p.ws + WS_H2Q); float* hs = (float*)(p.ws + WS_HS);
    f32x4 na[4] = {}, nb[4] = {};
    auto fetch = [&](f32x4 (&d)[4], int row) { if (row < NLAT) { const float* s_ = p.out + (size_t)row * D;
#pragma unroll
        for (int j = 0; j < 4; ++j) d[j] = ((const f32x4*)s_)[lane + 64 * j]; } };
    auto finish = [&](f32x4 (&v)[4], int row) {
        const int mr = row / T; const float* sh = mod + (size_t)mr * NMOD + 3 * D, * sc = mod + (size_t)mr * NMOD + 4 * D;
        float s = 0.f;
#pragma unroll
        for (int j = 0; j < 4; ++j) s += (v[j][0] * v[j][0] + v[j][1] * v[j][1]) + (v[j][2] * v[j][2] + v[j][3] * v[j][3]);
        const float rstd = rsqrtf(wave_sum_fast(s) * (1.f / D) + EPS); float m = 0.f;
#pragma unroll
        for (int j = 0; j < 4; ++j) { const int i4 = lane + 64 * j; const f32x4 gg = ((const f32x4*)p.g_norm2)[i4], s1 = ((const f32x4*)sc)[i4], h1 = ((const f32x4*)sh)[i4];
            v[j] = v[j] * rstd * gg * (s1 + 1.f) + h1; u32x2 w; w.x = cvt_pk_bf16(v[j][0], v[j][1]); w.y = cvt_pk_bf16(v[j][2], v[j][3]); ((u32x2*)(h2 + (size_t)row * D))[i4] = w;
            m = fmaxf(m, fmaxf(fmaxf(fabsf(v[j][0]), fabsf(v[j][1])), fmaxf(fabsf(v[j][2]), fabsf(v[j][3])))); }
        m = fmaxf(wave_max_fast(m), 1e-30f); const float inv = 127.f / m;
#pragma unroll
        for (int j = 0; j < 4; ++j) { const int d_ = lane + 64 * j; h2q[((size_t)(d_ >> 3) * NLAT + row) * 8 + (d_ & 7)] = q8pack(v[j], inv, 0); }
        if (lane == 0) hs[row] = m * (1.f / 127.f); };
    fetch(na, gw); fetch(nb, gw + NGW);
    for (int row = gw; row < NLAT; row += 2 * NGW) {
        f32x4 ca[4];
#pragma unroll
        for (int j = 0; j < 4; ++j) ca[j] = na[j];
        fetch(na, row + 2 * NGW);
        finish(ca, row);
        if (row + NGW < NLAT) {
#pragma unroll
            for (int j = 0; j < 4; ++j) ca[j] = nb[j];
            fetch(nb, row + 3 * NGW);
            finish(ca, row + NGW);
        }
    }
}

__device__ __forceinline__ unsigned ord_key(float v) { const unsigned u = __float_as_uint(v); return (u & 0x80000000u) ? ~u : (u | 0x80000000u); }
__device__ __forceinline__ float ord_val(unsigned k) { const unsigned u = (k & 0x80000000u) ? (k & 0x7fffffffu) : ~k; return __uint_as_float(u); }
__device__ __forceinline__ unsigned med3u(unsigned a, unsigned b, unsigned c) { const unsigned mx = a > b ? a : b, mn = a > b ? b : a; const unsigned t = mx < c ? mx : c; return mn > t ? mn : t; }
__device__ __forceinline__ void ins16(unsigned (&top)[16], unsigned x) {
    unsigned n[16];
    n[0] = top[0] > x ? top[0] : x;
#pragma unroll
    for (int i = 1; i < 16; ++i) n[i] = med3u(x, top[i - 1], top[i]);
#pragma unroll
    for (int i = 0; i < 16; ++i) top[i] = n[i];
}
__device__ __forceinline__ void peer_topk_unit(const Params& p, LAS unsigned char* lds, int unit, const int tidx) {
    const int lane = tidx & 63, h = tidx >> 6;
    const int c = lane & 31, hh = lane >> 5, tok = unit * 32 + c;
    const bf16_t* qp = (const bf16_t*)(p.ws + WS_QP) + (size_t)tok * 2048 + h * 256;
    const bf16_t* skb = (const bf16_t*)(p.ws + WS_SKB) + (size_t)h * 2 * NKEYS * 128;
    unsigned top[2][16];
    {
        unsigned cur[16], sav[16];
#pragma unroll
        for (int i = 0; i < 16; ++i) sav[i] = 0u;
        bf16x8 qf[8], afA[8], afB[8];
#define TK_LOADA(dst, pp_, kb_) do { _Pragma("unroll") for (int ks = 0; ks < 8; ++ks) dst[ks] = *(const bf16x8*)(skb + ((size_t)(pp_) * NKEYS + (kb_) * 32 + c) * 128 + 16 * ks + 8 * hh); } while (0)
#define TK_STAGE(af, kb_) do { f32x16 s; _Pragma("unroll") for (int q = 0; q < 16; ++q) s[q] = 64.f; \
        _Pragma("unroll") for (int ks = 0; ks < 8; ++ks) s = __builtin_amdgcn_mfma_f32_32x32x16_bf16(af[ks], qf[ks], s, 0, 0, 0); \
        _Pragma("unroll") for (int q = 0; q < 16; ++q) { const unsigned key = (__float_as_uint(fmaxf(s[q], 0.f)) & ~127u) | (unsigned)((kb_) * 32 + crow(q, hh)); ins16(cur, key); } } while (0)
#pragma unroll 1
        for (int pp = 0; pp < 2; ++pp) {
#pragma unroll
            for (int i = 0; i < 16; ++i) cur[i] = 0u;
#pragma unroll
            for (int ks = 0; ks < 8; ++ks) qf[ks] = *(const bf16x8*)(qp + pp * 128 + 16 * ks + 8 * hh);
            TK_LOADA(afA, pp, 0);
#pragma unroll 1
            for (int kb = 0; kb < 4; kb += 2) {
                TK_LOADA(afB, pp, kb + 1);
                TK_STAGE(afA, kb);
                if (kb + 2 < 4) TK_LOADA(afA, pp, kb + 2);
                TK_STAGE(afB, kb + 1);
            }
            unsigned oth[16];
#pragma unroll
            for (int i = 0; i < 16; ++i) { auto r_ = __builtin_amdgcn_permlane32_swap(cur[i], cur[i], false, false); oth[i] = hh ? r_[0] : r_[1]; }
#pragma unroll
            for (int i = 0; i < 16; ++i) ins16(cur, oth[i]);
            if (pp == 0) {
#pragma unroll
                for (int i = 0; i < 16; ++i) sav[i] = cur[i];
            }
        }
#undef TK_LOADA
#undef TK_STAGE
#pragma unroll
        for (int i = 0; i < 16; ++i) { top[0][i] = sav[i]; top[1][i] = cur[i]; }
    }
    float va[16], vb[16];
#pragma unroll
    for (int i = 0; i < 16; ++i) { va[i] = __uint_as_float(top[0][i] & ~127u) - 112.f; vb[i] = __uint_as_float(top[1][i] & ~127u); }
    unsigned best[16];
#pragma unroll
    for (int i = 0; i < 16; ++i) best[i] = 0u;
#pragma unroll
    for (int i = 0; i < 16; ++i)
#pragma unroll
        for (int j = 0; j < 16; ++j) if ((i + 1) * (j + 1) <= 16) { const unsigned key = (__float_as_uint(fmaxf(va[i] + vb[j], 0.f)) & ~255u) | (unsigned)(i * 16 + j); ins16(best, key); }
    float sv[16]; float mx = -INFINITY;
#pragma unroll
    for (int i = 0; i < 16; ++i) { sv[i] = __uint_as_float(best[i] & ~255u); mx = fmaxf(mx, sv[i]); }
    float sum = 0.f;
#pragma unroll
    for (int i = 0; i < 16; ++i) { sv[i] = __expf(sv[i] - mx); sum += sv[i]; }
    const float inv = 1.f / sum;
    int eid[16]; unsigned tsel[16]; const unsigned hmask = hh ? 0xffffffffu : 0u;
#pragma unroll
    for (int q = 0; q < 16; ++q) tsel[q] = ((top[1][q] & hmask) | (top[0][q] & ~hmask)) & 127u;
#pragma unroll
    for (int i = 0; i < 16; ++i) { const unsigned pi = best[i] & 255u; const unsigned sel = hh ? (pi & 15u) : (pi >> 4);
        unsigned mine_ = 0;
#pragma unroll
        for (int q = 0; q < 16; ++q) mine_ = (sel == (unsigned)q) ? tsel[q] : mine_;
        auto r_ = __builtin_amdgcn_permlane32_swap(mine_, mine_, false, false); const unsigned oth_ = hh ? r_[0] : r_[1];
        eid[i] = hh ? (int)(oth_ * NKEYS + mine_) : (int)(mine_ * NKEYS + oth_); }
    LAS unsigned long long* cnt = (LAS unsigned long long*)lds;
    __syncthreads();
    if (hh == 0) { unsigned long long mine = 0ull;
#pragma unroll
        for (int i = 0; i < 16; ++i) mine += 1ull << (8 * pe_slice(eid[i]));
        cnt[c * 8 + h] = mine; }
    __syncthreads();
    {
        unsigned long long tot = 0ull, bhead = 0ull;
#pragma unroll
        for (int h2 = 0; h2 < 8; ++h2) { const unsigned long long w = cnt[c * 8 + h2]; tot += w; bhead += (h2 < h) ? w : 0ull; }
        unsigned long long incl = tot; incl += incl << 8; incl += incl << 16; incl += incl << 32;
        const unsigned long long start = incl << 8;
        unsigned long long base = start + bhead;
        LAS u32x2* lp_ = (LAS u32x2*)(lds + 4096); LAS float* ls_ = (LAS float*)(lds + 4096 + 32768);
        const float* su_t = (const float*)(p.ws + WS_SU); const float* sv_t = (const float*)(p.ws + WS_SV);
#pragma unroll
        for (int i = 0; i < 16; ++i) { const int sh = 8 * pe_slice(eid[i]); const unsigned pos = (unsigned)(base >> sh) & 0xffu; base += 1ull << sh;
            if ((i >> 3) == hh) { lp_[c * 128 + pos] = (u32x2){(unsigned)eid[i], __float_as_uint(sv[i] * inv * sv_t[eid[i]])}; ls_[c * 128 + pos] = su_t[eid[i]]; } }
        __syncthreads();
        { const int tok0 = unit * 32; const int tid_ = tidx;
          u32x4* gp = (u32x4*)((u32x2*)(p.ws + WS_CE) + (size_t)tok0 * 128); u32x4* gs = (u32x4*)((float*)(p.ws + WS_SUE) + (size_t)tok0 * 128);
#pragma unroll
          for (int r = 0; r < 4; ++r) { const int i4 = tid_ + 512 * r; gp[i4] = *(const LAS u32x4*)((LAS unsigned*)lp_ + 4 * i4); }
#pragma unroll
          for (int r = 0; r < 2; ++r) { const int i4 = tid_ + 512 * r; gs[i4] = *(const LAS u32x4*)(ls_ + 4 * i4); } }
        if (h == 0 && hh == 0) { unsigned char* of = (unsigned char*)(p.ws + WS_OFFS) + (size_t)tok * 16; *(unsigned long long*)of = start; of[8] = 128; }
    }
}

__device__ __forceinline__ float ub0(unsigned w) { float f; asm("v_cvt_f32_ubyte0 %0, %1" : "=v"(f) : "v"(w)); return f; }
__device__ __forceinline__ float ub1(unsigned w) { float f; asm("v_cvt_f32_ubyte1 %0, %1" : "=v"(f) : "v"(w)); return f; }
__device__ __forceinline__ float ub2(unsigned w) { float f; asm("v_cvt_f32_ubyte2 %0, %1" : "=v"(f) : "v"(w)); return f; }
__device__ __forceinline__ float ub3(unsigned w) { float f; asm("v_cvt_f32_ubyte3 %0, %1" : "=v"(f) : "v"(w)); return f; }
__device__ __forceinline__ void fma_ub4(float& a0, float& a1, float& a2, float& a3, float c, unsigned w) {
    float t0, t1, t2, t3;
    asm("v_cvt_f32_ubyte0 %4, %9\n\tv_cvt_f32_ubyte1 %5, %9\n\tv_cvt_f32_ubyte2 %6, %9\n\tv_cvt_f32_ubyte3 %7, %9\n\t"
        "v_fmac_f32 %0, %8, %4\n\tv_fmac_f32 %1, %8, %5\n\tv_fmac_f32 %2, %8, %6\n\tv_fmac_f32 %3, %8, %7"
        : "+v"(a0), "+v"(a1), "+v"(a2), "+v"(a3), "=&v"(t0), "=&v"(t1), "=&v"(t2), "=&v"(t3) : "v"(c), "v"(w));
}
__device__ __forceinline__ void fma_ub4m(float& a0, float& a1, float& a2, float& a3, float c, unsigned w, unsigned k64, unsigned s01, unsigned s23) {
    unsigned h0, h1;
    asm("v_perm_b32 %4, %7, %6, %8\n\tv_perm_b32 %5, %7, %6, %9\n\t"
        "v_fma_mix_f32 %0, %4, %10, %0 op_sel:[0,0,0] op_sel_hi:[1,0,0]\n\tv_fma_mix_f32 %1, %4, %10, %1 op_sel:[1,0,0] op_sel_hi:[1,0,0]\n\t"
        "v_fma_mix_f32 %2, %5, %10, %2 op_sel:[0,0,0] op_sel_hi:[1,0,0]\n\tv_fma_mix_f32 %3, %5, %10, %3 op_sel:[1,0,0] op_sel_hi:[1,0,0]"
        : "+v"(a0), "+v"(a1), "+v"(a2), "+v"(a3), "=&v"(h0), "=&v"(h1) : "v"(w), "v"(k64), "v"(s01), "v"(s23), "v"(c));
}
__device__ __forceinline__ int idot16(const u32x4 a, const u32x4 b, int acc) {
    acc = __builtin_amdgcn_sdot4((int)a.x, (int)b.x, acc, false); acc = __builtin_amdgcn_sdot4((int)a.y, (int)b.y, acc, false);
    acc = __builtin_amdgcn_sdot4((int)a.z, (int)b.z, acc, false); acc = __builtin_amdgcn_sdot4((int)a.w, (int)b.w, acc, false); return acc;
}
__device__ __forceinline__ float gelu_erf(float v) {
    const float av = fabsf(v), t = __builtin_amdgcn_rcpf(fmaf(av, 0.2316418882f, 1.0f));
    float q = fmaf(t, 0.5307027145f, -0.7265760135f); q = fmaf(q, t, 0.7107068705f); q = fmaf(q, t, -0.142248368f); q = fmaf(q, t, 0.127414796f); q *= t;
    const float e = __builtin_amdgcn_exp2f(v * v * -0.72134752044f), m = v * (q * e);
    return v < 0.f ? m : v - m;
}
#ifndef UKMAIN
#define UKMAIN 32
#endif
__device__ __forceinline__ void phase_peer_u(const Params& p, LAS unsigned char* lds, const int tidx) {
    const int lane = tidx & 63, wave = tidx >> 6, l32 = lane & 31, hf = lane >> 5, par = lane & 1;
    const int x = blockIdx.x & 7, nbx = ((int)gridDim.x - x + 7) >> 3, bl = (int)blockIdx.x >> 3;
    const int tpb = (NLAT + nbx - 1) / nbx, t0 = bl * tpb, t1 = min(NLAT, t0 + tpb);
    const int nsweep = (max(t1 - t0, 0) + NTHREADS - 1) / NTHREADS, nit = nsweep * 32;
    const unsigned char* tabg = (const unsigned char*)(p.ws + WS_EU8) + (size_t)x * (32 * 65536);
    const unsigned char* h2q = (const unsigned char*)(p.ws + WS_H2Q);
    const float* sue = (const float*)(p.ws + WS_SUE); const float* hs = (const float*)(p.ws + WS_HS);
    const u32x2* ce = (const u32x2*)(p.ws + WS_CE); const unsigned char* offs = (const unsigned char*)(p.ws + WS_OFFS);
    u32x2* cdst = p.dup ? (u32x2*)(p.ws + WS_CE + 48 * MiB) : (u32x2*)(p.ws + WS_CE);
    if (nit == 0) return;
    const unsigned wreg = (unsigned)wave * 8192u;
    auto stage = [&](int buf, int cs) { const unsigned char* g = tabg + (size_t)cs * 65536 + wreg + lane * 16;
#pragma unroll
        for (int i = 0; i < 8; ++i) __builtin_amdgcn_global_load_lds((const unsigned*)(g + i * 1024), (LAS unsigned*)(lds + buf * 65536 + wreg + i * 1024), 16, 0, 0); };
    int acc[32]; unsigned ids[16]; int o0 = 0, n = 0, tk = t0, tokb = t0, nch = 0; float hsv = 0.f;
    u32x4 hA = {}, hB = {}, nA = {}, nB = {};
#pragma unroll
    for (int k = 0; k < 32; ++k) acc[k] = 0;
#pragma unroll
    for (int k = 0; k < 16; ++k) ids[k] = 0;
    stage(0, 0);
    for (int it = 0; it <= nit; ++it) {
        asm volatile("s_waitcnt vmcnt(0)" ::: "memory"); __syncthreads();
        const int cs = it & 31;
        if (cs == 0) {
            LAS unsigned* st = (LAS unsigned*)(lds + ((it + 1) & 1) * 65536 + wreg);
            if (it > 0) {
#pragma unroll
                for (int j = 0; j < 8; ++j) *(LAS f32x4*)(st + lane * 32 + 4 * j) = (f32x4){(float)acc[4 * j], (float)acc[4 * j + 1], (float)acc[4 * j + 2], (float)acc[4 * j + 3]};
                asm volatile("s_waitcnt lgkmcnt(0)" ::: "memory");
                { u32x2 pr_[32]; float su_[32];
#pragma unroll
                  for (int i = 0; i < 32; ++i) {
                    const int oa = __builtin_amdgcn_readlane(o0, 2 * i), ob = __builtin_amdgcn_readlane(o0, 2 * i + 1);
                    const int ti = 2 * i + hf, oi = hf ? ob : oa, tki = min(tokb + ti, t1 - 1);
                    const size_t idx = (size_t)tki * 128 + min(oi + l32, 127); pr_[i] = ce[idx]; su_[i] = sue[idx]; }
#pragma unroll
                  for (int i = 0; i < 32; ++i) {
                    const int oa = __builtin_amdgcn_readlane(o0, 2 * i), ob = __builtin_amdgcn_readlane(o0, 2 * i + 1), na_ = __builtin_amdgcn_readlane(n, 2 * i), nb_ = __builtin_amdgcn_readlane(n, 2 * i + 1);
                    const float ha = __uint_as_float((unsigned)__builtin_amdgcn_readlane((int)__float_as_uint(hsv), 2 * i)), hb = __uint_as_float((unsigned)__builtin_amdgcn_readlane((int)__float_as_uint(hsv), 2 * i + 1));
                    const int ti = 2 * i + hf, oi = hf ? ob : oa, ni = min(hf ? nb_ : na_, UKMAIN), tki = min(tokb + ti, t1 - 1);
                    const float z = __uint_as_float(st[ti * 32 + l32]) * su_[i] * (hf ? hb : ha); const float c_ = __uint_as_float(pr_[i].y) * gelu_erf(z);
                    if (l32 < ni) ((float*)(cdst + (size_t)tki * 128 + oi + l32))[1] = c_; } }
                { unsigned long long hvm = __ballot(n > UKMAIN);
                  while (hvm) { const int i = (int)__builtin_ctzll(hvm); hvm &= hvm - 1ull;
                    const int ni = __builtin_amdgcn_readlane(n, i), oi = __builtin_amdgcn_readlane(o0, i), tki = tokb + i;
                    const float hsi = __uint_as_float((unsigned)__builtin_amdgcn_readlane((int)__float_as_uint(hsv), i));
                    const u32x4 h_ = *(const u32x4*)(h2q + ((size_t)(lane >> 1) * NLAT + tki) * 32 + par * 16);
                    for (int j0 = UKMAIN; j0 < ni; j0 += 8) {
                        u32x2 pr_[8]; float su_[8]; u32x4 a_[8];
#pragma unroll
                        for (int q = 0; q < 8; ++q) { const size_t idx = (size_t)tki * 128 + oi + min(j0 + q, ni - 1); pr_[q] = ce[idx]; su_[q] = sue[idx]; }
#pragma unroll
                        for (int q = 0; q < 8; ++q) a_[q] = *(const u32x4*)(tabg + ((size_t)(lane >> 1) * 2048 + pe_local(pr_[q].x)) * 32 + par * 16);
                        float mine = 0.f, myg = 0.f, mys = 0.f;
#pragma unroll
                        for (int q = 0; q < 8; ++q) { const float d = wave_sum((float)idot16(a_[q], h_, 0));
                            const bool me = lane == q; mine = me ? d : mine; myg = me ? __uint_as_float(pr_[q].y) : myg; mys = me ? su_[q] : mys; }
                        if (lane < 8 && j0 + lane < ni) { const float z = mine * mys * hsi; ((float*)(cdst + (size_t)tki * 128 + oi + j0 + lane))[1] = myg * gelu_erf(z); } } } }
                asm volatile("s_waitcnt lgkmcnt(0)" ::: "memory");
            }
            if (it == nit) break;
            tokb = t0 + (it >> 5) * NTHREADS + wave * 64;
            { const int tok = tokb + lane; const bool tv = tok < t1; tk = tv ? tok : t1 - 1;
              const unsigned o2 = *(const unsigned short*)(offs + (size_t)tk * 16 + x); o0 = (int)(o2 & 0xffu); n = tv ? (int)(o2 >> 8) - o0 : 0; hsv = hs[tk]; }
            { unsigned ev_[32];
#pragma unroll
              for (int i = 0; i < 32; ++i) {
                const int oa = __builtin_amdgcn_readlane(o0, 2 * i), ob = __builtin_amdgcn_readlane(o0, 2 * i + 1);
                const int ti = 2 * i + hf, oi = hf ? ob : oa, tki = min(tokb + ti, t1 - 1);
                ev_[i] = ce[(size_t)tki * 128 + min(oi + l32, 127)].x; }
#pragma unroll
              for (int i = 0; i < 32; ++i) {
                const int na_ = __builtin_amdgcn_readlane(n, 2 * i), nb_ = __builtin_amdgcn_readlane(n, 2 * i + 1);
                const int ti = 2 * i + hf, ni = min(hf ? nb_ : na_, UKMAIN);
                st[ti * 32 + l32] = (l32 < ni) ? (pe_local(ev_[i]) << 5) : 0u; } }
            asm volatile("s_waitcnt lgkmcnt(0)" ::: "memory");
            { const unsigned po = (unsigned)par * 16u * 0x10001u;
#pragma unroll
              for (int j = 0; j < 8; ++j) { const u32x4 q = *(const LAS u32x4*)(st + lane * 32 + 4 * j); ids[2 * j] = (q.x | (q.y << 16)) + po; ids[2 * j + 1] = (q.z | (q.w << 16)) + po; } }
            asm volatile("s_waitcnt lgkmcnt(0)" ::: "memory");
            { const int nm = min(n, UKMAIN); const int mx = __builtin_amdgcn_readfirstlane((int)wave_max_fast((float)nm)); nch = (mx + 3) >> 2; }
#pragma unroll
            for (int k = 0; k < 32; ++k) acc[k] = 0;
            { const unsigned char* hp = h2q + (size_t)tk * 32; nA = *(const u32x4*)(hp + par * 16); nB = *(const u32x4*)(hp + (par ^ 1) * 16); }
        }
        if (it + 1 < nit) stage((it + 1) & 1, (cs + 1) & 31);
        hA = nA; hB = nB;
        if (cs < 31) { const unsigned char* hp = h2q + ((size_t)(cs + 1) * NLAT + tk) * 32; nA = *(const u32x4*)(hp + par * 16); nB = *(const u32x4*)(hp + (par ^ 1) * 16); }
        const unsigned lA = (unsigned)(size_t)lds + (unsigned)((it & 1) * 65536), lB = lA + 16u - 32u * (unsigned)par;
        u32x4 ra[4][2], rb[4][2];
#define PU_OF(k) ((((k) & 1) ? (ids[(k) >> 1] >> 16) : (ids[(k) >> 1] & 0xffffu)))
#define PU_LD(R, c) do { _Pragma("unroll") for (int q_ = 0; q_ < 4; ++q_) { const unsigned of_ = PU_OF(4 * (c) + q_); const unsigned a0_ = lA + of_, a1_ = lB + of_; \
            asm volatile("ds_read_b128 %0, %1" : "=v"(R[q_][0]) : "v"(a0_)); asm volatile("ds_read_b128 %0, %1" : "=v"(R[q_][1]) : "v"(a1_)); } } while (0)
#define PU_WAIT(n) asm volatile("s_waitcnt lgkmcnt(" #n ")" ::: "memory")
#define PU_CP(R, c) do { _Pragma("unroll") for (int q_ = 0; q_ < 4; ++q_) acc[4 * (c) + q_] = idot16(R[q_][1], hB, idot16(R[q_][0], hA, acc[4 * (c) + q_])); } while (0)
#define PU_BODY(N) do { PU_LD(ra, 0); \
            _Pragma("unroll") for (int c = 0; c < (N); c += 2) { \
                if (c + 1 < (N)) { PU_LD(rb, c + 1); PU_WAIT(8); } else PU_WAIT(0); \
                __builtin_amdgcn_sched_barrier(0); PU_CP(ra, c); __builtin_amdgcn_sched_barrier(0); \
                if (c + 1 < (N)) { if (c + 2 < (N)) { PU_LD(ra, c + 2); PU_WAIT(8); } else PU_WAIT(0); \
                    __builtin_amdgcn_sched_barrier(0); PU_CP(rb, c + 1); __builtin_amdgcn_sched_barrier(0); } } } while (0)
        switch (nch) { case 1: PU_BODY(1); break; case 2: PU_BODY(2); break; case 3: PU_BODY(3); break; case 4: PU_BODY(4); break;
                       case 5: PU_BODY(5); break; case 6: PU_BODY(6); break; case 7: PU_BODY(7); break; case 8: PU_BODY(8); break; default: break; }
#undef PU_BODY
#undef PU_OF
#undef PU_LD
#undef PU_WAIT
#undef PU_CP
    }
}
__device__ __forceinline__ void phase_peer_v(const Params& p, LAS unsigned char* lds, const int tidx) {
    const int lane = tidx & 63, wave = tidx >> 6;
    const int x = blockIdx.x & 7, nbx = ((int)gridDim.x - x + 7) >> 3, wl = ((int)blockIdx.x >> 3) * NWAVES + wave, wstride = nbx * NWAVES;
    const unsigned char* ev8 = (const unsigned char*)(p.ws + WS_EV8) + (size_t)x * (NEXP * 128) + (lane & 7) * 16;
    const u32x4* ce4 = (const u32x4*)(p.ws + WS_CE); const float* mod = (const float*)(p.ws + WS_MOD);
    LAS int* le = (LAS int*)(lds + wave * 2048);
    LAS unsigned char* lc8 = (LAS unsigned char*)(lds + wave * 2048 + 1024);
    const int rg = lane >> 3, cg = lane & 7; const bool b3 = lane & 8;
    const int colo = cg * 16 + ((lane & 32) ? 8 : 0) + ((lane & 16) ? 4 : 0) + (b3 ? 2 : 0);
    const int ntok_w = (NLAT - wl + wstride - 1) / wstride;
    const float pscale = p.dup ? 0.f : DBG_PSCALE;
    float n_c0 = 0.f, n_c1 = 0.f; int n_e0 = 0, n_e1 = 0;
    auto fetch = [&](int i) { if (i < ntok_w) { const u32x4 q_ = ce4[(size_t)(wl + wstride * i) * 64 + lane]; n_e0 = (int)q_.x; n_c0 = __uint_as_float(q_.y); n_e1 = (int)q_.z; n_c1 = __uint_as_float(q_.w); } };
    auto stage = [&](int buf, float& cscale) {
        const float cm = fmaxf(wave_max_fast(fmaxf(fabsf(n_c0), fabsf(n_c1))), 1e-30f); const float inv = 127.f / cm; cscale = cm * (1.f / 127.f);
        *(LAS u32x2*)(le + buf * 128 + 2 * lane) = (u32x2){(unsigned)n_e0, (unsigned)n_e1};
        lc8[buf * 128 + ((2 * lane) & 7) * 16 + (lane >> 2)] = (unsigned char)(__float2int_rn(n_c0 * inv) & 0xff);
        lc8[buf * 128 + ((2 * lane + 1) & 7) * 16 + (lane >> 2)] = (unsigned char)(__float2int_rn(n_c1 * inv) & 0xff);
        asm volatile("s_waitcnt lgkmcnt(0)" ::: "memory"); };
    u32x4 ra[16], rb[16]; float csa = 0.f, csb = 0.f; int gb_ = -1; f32x2 gq_ = {0.f, 0.f};
#define PV_LOAD(buf, R) do { _Pragma("unroll") for (int it = 0; it < 16; ++it) { const int e_ = le[(buf) * 128 + 8 * it + rg]; R[it] = *(const u32x4*)(ev8 + (size_t)e_ * 128); } } while (0)
#define PV_T4(r0, r1, r2, r3, cq_, A0, A1, A2, A3) do { \
        const unsigned t0 = __builtin_amdgcn_perm(r1, r0, 0x05010400u), t1 = __builtin_amdgcn_perm(r1, r0, 0x07030602u); \
        const unsigned u0 = __builtin_amdgcn_perm(r3, r2, 0x05010400u), u1 = __builtin_amdgcn_perm(r3, r2, 0x07030602u); \
        A0 = __builtin_amdgcn_sdot4((int)__builtin_amdgcn_perm(u0, t0, 0x05040100u), (int)(cq_), A0, false); \
        A1 = __builtin_amdgcn_sdot4((int)__builtin_amdgcn_perm(u0, t0, 0x07060302u), (int)(cq_), A1, false); \
        A2 = __builtin_amdgcn_sdot4((int)__builtin_amdgcn_perm(u1, t1, 0x05040100u), (int)(cq_), A2, false); \
        A3 = __builtin_amdgcn_sdot4((int)__builtin_amdgcn_perm(u1, t1, 0x07060302u), (int)(cq_), A3, false); } while (0)
#define PV_COMP(buf, R, i_, cs_) do { int acc[16]; \
        const int tok = wl + wstride * (i_); const int b = tok / T; float* op = p.out + (size_t)tok * D + x * 128 + colo; \
        if (b != gb_) { gb_ = b; gq_ = *(const f32x2*)(mod + (size_t)b * NMOD + 5 * D + x * 128 + colo) * pscale; }     \
        const f32x2 xv = *(const f32x2*)op; const f32x2 gg = gq_ * (cs_); \
        const u32x4 cq = *(const LAS u32x4*)(lc8 + (buf) * 128 + rg * 16); \
        _Pragma("unroll") for (int q = 0; q < 16; ++q) acc[q] = 0; \
        _Pragma("unroll") for (int a = 0; a < 4; ++a) { const unsigned cqa = cq[a]; \
            PV_T4(R[4 * a].x, R[4 * a + 1].x, R[4 * a + 2].x, R[4 * a + 3].x, cqa, acc[0], acc[1], acc[2], acc[3]); \
            PV_T4(R[4 * a].y, R[4 * a + 1].y, R[4 * a + 2].y, R[4 * a + 3].y, cqa, acc[4], acc[5], acc[6], acc[7]); \
            PV_T4(R[4 * a].z, R[4 * a + 1].z, R[4 * a + 2].z, R[4 * a + 3].z, cqa, acc[8], acc[9], acc[10], acc[11]); \
            PV_T4(R[4 * a].w, R[4 * a + 1].w, R[4 * a + 2].w, R[4 * a + 3].w, cqa, acc[12], acc[13], acc[14], acc[15]); } \
        int a8[8], a4[4], a2[2]; \
        _Pragma("unroll") for (int q = 0; q < 8; ++q) { auto r_ = __builtin_amdgcn_permlane32_swap((unsigned)acc[q], (unsigned)acc[8 + q], false, false); a8[q] = (int)r_[0] + (int)r_[1]; } \
        _Pragma("unroll") for (int q = 0; q < 4; ++q) { auto r_ = __builtin_amdgcn_permlane16_swap((unsigned)a8[q], (unsigned)a8[4 + q], false, false); a4[q] = (int)r_[0] + (int)r_[1]; } \
        _Pragma("unroll") for (int q = 0; q < 2; ++q) { const int snd = b3 ? a4[q] : a4[2 + q], kp = b3 ? a4[2 + q] : a4[q]; a2[q] = kp + dppi<0x128>(snd); } \
        f32x2 rr; rr[0] = xv[0] + gg[0] * (float)a2[0]; rr[1] = xv[1] + gg[1] * (float)a2[1]; *(f32x2*)op = rr; } while (0)
    if (ntok_w > 0) { fetch(0); stage(0, csa); fetch(1); PV_LOAD(0, ra); }
    for (int i = 0; i < ntok_w; i += 2) {
        if (i + 1 < ntok_w) { stage(1, csb); fetch(i + 2); PV_LOAD(1, rb); }
        PV_COMP(0, ra, i, csa);
        if (i + 2 < ntok_w) { stage(0, csa); fetch(i + 3); PV_LOAD(0, ra); }
        if (i + 1 < ntok_w) PV_COMP(1, rb, i + 1, csb);
    }
#undef PV_LOAD
#undef PV_T4
#undef PV_COMP
}

#ifndef DBG_CHECK
#define DBG_CHECK 0
#endif
#ifndef DBG_SEL
#define DBG_SEL 4
#endif
__device__ __forceinline__ int dbg_tok(int slot) { return slot * 128 + 37; }
__device__ __forceinline__ float block_sum(float v, LAS float* red, const int tidx) {
    v = wave_sum(v); __syncthreads(); if ((tidx & 63) == 0) red[tidx >> 6] = v; __syncthreads();
    float s = 0.f; for (int w = 0; w < 8; ++w) s += red[w]; return s;
}
__device__ __forceinline__ void dbg_peer_check(const Params& p, LAS unsigned char* lds, const int tidx) {
    const int tid = tidx, lane = tid & 63, wave = tid >> 6;
    LAS float* h2f = (LAS float*)lds;
    LAS float* q = h2f + 1024;
    LAS float* sp = q + 2048;
    LAS float* topv = sp + 256;
    LAS int* topi = (LAS int*)(topv + 32);
    LAS float* cv = (LAS float*)(topi + 32);
    LAS float* bestv = cv + 256;
    LAS int* eref = (LAS int*)(bestv + 16);
    LAS float* gref = (LAS float*)(eref + 128);
    LAS float* wref = gref + 128;
    LAS float* red = wref + 128;
    for (int slot = blockIdx.x; slot < 256; slot += gridDim.x) {
        const int tok = dbg_tok(slot);
        const bf16_t* h2 = (const bf16_t*)(p.ws + WS_H2) + (size_t)tok * D;
        __syncthreads();
        for (int i = tid; i < D; i += NTHREADS) h2f[i] = bf2f(h2[i]);
        __syncthreads();
        for (int n = tid; n < 2048; n += NTHREADS) { float s = 0.f; for (int k = 0; k < D; ++k) s += h2f[k] * p.w_pq[(size_t)k * 2048 + n]; q[n] = s; }
        __syncthreads();
        for (int h = 0; h < PH; ++h) {
            if (tid < 256) { const int pp = tid >> 7, k = tid & 127; float s = 0.f; const float* sk = p.sub_keys + ((size_t)(h * 2 + pp) * NKEYS + k) * 128;
                for (int d = 0; d < 128; ++d) s += q[h * 256 + pp * 128 + d] * sk[d]; sp[tid] = s; }
            __syncthreads();
            if (tid < 256) { const int pp = tid >> 7, k = tid & 127; const float v = sp[tid]; int r = 0;
                for (int k2 = 0; k2 < 128; ++k2) { const float v2 = sp[pp * 128 + k2]; r += (v2 > v || (v2 == v && k2 < k)) ? 1 : 0; }
                if (r < 16) { topv[pp * 16 + r] = v; topi[pp * 16 + r] = k; } }
            __syncthreads();
            if (tid < 256) cv[tid] = topv[tid >> 4] + topv[16 + (tid & 15)];
            __syncthreads();
            if (tid < 256) { const float v = cv[tid]; int r = 0;
                for (int t2 = 0; t2 < 256; ++t2) { const float v2 = cv[t2]; r += (v2 > v || (v2 == v && t2 < tid)) ? 1 : 0; }
                if (r < 16) { bestv[r] = v; eref[h * 16 + r] = topi[tid >> 4] * NKEYS + topi[16 + (tid & 15)]; } }
            __syncthreads();
            if (tid < 16) { float mx = bestv[0]; for (int i = 1; i < 16; ++i) mx = fmaxf(mx, bestv[i]); float sum = 0.f; for (int i = 0; i < 16; ++i) sum += expf(bestv[i] - mx);
                gref[h * 16 + tid] = expf(bestv[tid] - mx) / sum; }
            __syncthreads();
        }
        float terr = 0.f, tden = 0.f;
        { const bf16_t* eub = (const bf16_t*)(p.ws + WS_EU);
          for (int k = 0; k < 128; ++k) { const size_t e = (size_t)eref[k]; for (int d = tid; d < D; d += NTHREADS) { const float a = p.expert_u[e * D + d], bq = bf2f(eub[e * D + d]); terr += (a - bq) * (a - bq); tden += a * a; } } }
        terr = block_sum(terr, red, tidx); tden = block_sum(tden, red, tidx);
        for (int kk = 0; kk < 16; ++kk) { const int k = wave * 16 + kk; const float* ur = p.expert_u + (size_t)eref[k] * D; float s = 0.f;
            for (int d = lane; d < D; d += 64) s += ur[d] * h2f[d];
            s = wave_sum(s); if (lane == 0) wref[k] = gref[k] * 0.5f * s * (1.f + erff(s * 0.70710678118654752f)); }
        __syncthreads();
        const float* pf = (const float*)(p.ws + WS_DBGP) + (size_t)slot * D;
        float num = 0.f, den = 0.f;
        for (int d = tid; d < D; d += NTHREADS) { float o = 0.f; for (int k = 0; k < 128; ++k) o += wref[k] * p.expert_v[(size_t)eref[k] * D + d];
            const float f = pf[d]; num += (f - o) * (f - o); den += o * o; }
        num = block_sum(num, red, tidx); den = block_sum(den, red, tidx);
        const int* ef = (const int*)(p.ws + WS_EIDX) + (size_t)tok * 128; const float* gf = (const float*)(p.ws + WS_GW) + (size_t)tok * 128;
        float miss = 0.f, gerr = 0.f, gden = 0.f, werr = 0.f, wden = 0.f; const float* wf = (const float*)(p.ws + WS_DBGP + MiB) + (size_t)slot * 128;
        if (tid < 128) { const int e = ef[tid]; int found = -1; for (int k = 0; k < 128; ++k) if (eref[k] == e && (k >> 4) == (tid >> 4)) found = k;
            if (found < 0) miss = 1.f; else { const float dg = gf[tid] - gref[found]; gerr = dg * dg; gden = gref[found] * gref[found]; const float dw = wf[tid] - wref[found]; werr = dw * dw; wden = wref[found] * wref[found]; } }
        werr = block_sum(werr, red, tidx); wden = block_sum(wden, red, tidx);
        miss = block_sum(miss, red, tidx); gerr = block_sum(gerr, red, tidx); gden = block_sum(gden, red, tidx);
        if (tid == 0) { float* r = (float*)(p.ws + WS_DBGR) + slot * 8; r[0] = num; r[1] = den; r[2] = miss; r[3] = gerr; r[4] = gden; r[5] = werr; r[6] = wden; r[7] = terr / tden; }
    }
}
__device__ __forceinline__ void dbg_report(const Params& p, const int tidx) {
    const float* r = (const float*)(p.ws + WS_DBGR);
    float num = 0.f, den = 0.f, miss = 0.f, gerr = 0.f, gden = 0.f, werr = 0.f, wden = 0.f;
    for (int s = 0; s < 256; ++s) { num += r[s * 8]; den += r[s * 8 + 1]; miss += r[s * 8 + 2]; gerr += r[s * 8 + 3]; gden += r[s * 8 + 4]; werr += r[s * 8 + 5]; wden += r[s * 8 + 6]; }
    float val = 0.f;
    if (DBG_SEL == 1) val = num / den;
    if (DBG_SEL == 2) val = miss / (256.f * 128.f);
    if (DBG_SEL == 3) val = gerr / gden;
    if (DBG_SEL == 5) { float t = 0.f; for (int s = 0; s < 256; ++s) t += r[s * 8 + 7]; val = t / 256.f; }
    if (DBG_SEL == 4) val = werr / wden;
    const float sc = 1.f + sqrtf(fminf(val, 100.f));
    const int gt = blockIdx.x * NTHREADS + tidx, NGT = gridDim.x * NTHREADS;
    for (int i = gt; i < NLAT * D / 4; i += NGT) ((f32x4*)p.out)[i] = ((const f32x4*)p.x)[i] * sc;
}

#define XB_TMO      128
#define XB_XCNT(j)  (256  + 64 * (j))
#define XB_XSUB(j)  (1280 + 64 * (j))
#define XB_XGEN(j)  (2304 + 64 * (j))
#define XB_TOP      3328
#define XB_TOPGEN   3392
#define XCD_BAR_WORDS 3456
#define XB_SPIN_CAP (1u << 22)
__device__ __forceinline__ unsigned xb_ld(unsigned* p)              { return __hip_atomic_load(p, __ATOMIC_RELAXED, __HIP_MEMORY_SCOPE_AGENT); }
__device__ __forceinline__ unsigned xb_add(unsigned* p, unsigned v) { return __hip_atomic_fetch_add(p, v, __ATOMIC_RELAXED, __HIP_MEMORY_SCOPE_AGENT); }
__device__ __forceinline__ unsigned xb_xcc_id() { return (unsigned)__builtin_amdgcn_s_getreg((3 << 11) | 20) & 0xFu; }
#define XB_SPIN(cond, bar) do { unsigned _sp = 0; while (cond) { __builtin_amdgcn_s_sleep(1); \
    if ((++_sp & 255u) == 0u) { if (xb_ld(&(bar)[XB_TMO])) break; if (_sp > XB_SPIN_CAP) { atomicAdd(&(bar)[XB_TMO], 1u); break; } } } } while (0)
struct XcdBarrier { unsigned* bar; unsigned x; volatile LAS unsigned* st; };
__device__ __forceinline__ XcdBarrier xcd_barrier_post(unsigned* bar, volatile LAS unsigned* st) {
    XcdBarrier b; b.bar = bar; b.x = xb_xcc_id(); b.st = st;
    if (threadIdx.x == 0) (void)xb_add(&bar[XB_XCNT(b.x)], 1u);
    return b;
}
__device__ __forceinline__ void xcd_barrier_complete(unsigned* bar, unsigned x, unsigned& nloc, unsigned& nx) {
    const unsigned G = gridDim.x * gridDim.y * gridDim.z;
    unsigned sum, cnt, mine, sp = 0u;
    for (;;) {
        sum = 0u; cnt = 0u; mine = 0u;
#pragma unroll
        for (unsigned j = 0; j < 16; ++j) { const unsigned c = xb_ld(&bar[XB_XCNT(j)]); sum += c; cnt += (c > 0u) ? 1u : 0u; mine = (j == x) ? c : mine; }
        if (sum == G) break;
        __builtin_amdgcn_s_sleep(1);
        if ((++sp & 255u) == 0u) { if (xb_ld(&bar[XB_TMO])) break; if (sp > XB_SPIN_CAP) { atomicAdd(&bar[XB_TMO], 1u); break; } }
    }
    nloc = mine > 0u ? mine : 1u; nx = cnt > 0u ? cnt : 1u;
}
__device__ __forceinline__ void xcd_barrier(const XcdBarrier& b, const int tidx) {
    asm volatile("s_waitcnt vmcnt(0)" ::: "memory");
    __syncthreads();
    if (tidx == 0) {
        unsigned* bar = b.bar;
        __builtin_amdgcn_s_waitcnt(0);
        unsigned nloc = b.st[0], nx = b.st[1];
        if (nloc == 0u) { xcd_barrier_complete(bar, b.x, nloc, nx); b.st[0] = nloc; b.st[1] = nx; }
        const unsigned old = xb_add(&bar[XB_XSUB(b.x)], 1u);
        const unsigned gen = old / nloc;
        if (old + 1u == (gen + 1u) * nloc) {
            __builtin_amdgcn_fence(__ATOMIC_RELEASE, "agent");
            asm volatile("s_waitcnt vmcnt(0)" ::: "memory");
            const unsigned og = xb_add(&bar[XB_TOP], 1u);
            const unsigned tg = og / nx;
            if (og + 1u == (tg + 1u) * nx) xb_add(&bar[XB_TOPGEN], 1u);
            else XB_SPIN(xb_ld(&bar[XB_TOPGEN]) == tg, bar);
            __builtin_amdgcn_fence(__ATOMIC_ACQUIRE, "agent");
            xb_add(&bar[XB_XGEN(b.x)], 1u);
            asm volatile("s_waitcnt vmcnt(0)" ::: "memory");
        } else {
            XB_SPIN(xb_ld(&bar[XB_XGEN(b.x)]) == gen, bar);
            __builtin_amdgcn_fence(__ATOMIC_ACQUIRE, "agent");
            asm volatile("s_waitcnt vmcnt(0)" ::: "memory");
        }
    }
    __syncthreads();
}
constexpr int NPHASE = 12 + 2 * DBG_CHECK;
constexpr int LDS_BYTES = 160 * 1024;
typedef const __attribute__((address_space(4))) Params* KargPtr;
#if defined(__HIP_DEVICE_COMPILE__)
#define PLOAD() KargPtr kq_ = kp; asm volatile("" : "+s"(kq_)); const Params p = *kq_; unsigned char* ws = p.ws; (void)ws; const int tidx = (wave_s << 6) | lane_id_v()
#else
#define PLOAD() const Params p = p_unused; unsigned char* ws = p.ws; (void)ws; const int tidx = (wave_s << 6) | lane_id_v()
#endif
__global__ void __launch_bounds__(NTHREADS, 2) mega(Params p_unused) {
    extern __shared__ __attribute__((aligned(16))) unsigned char lds_raw[];
    LAS unsigned char* lds = (LAS unsigned char*)lds_raw;
    KargPtr kp = (KargPtr)__builtin_amdgcn_kernarg_segment_ptr();
    const int lo = kp->ph_lo, hi = kp->ph_hi;
    const int G = gridDim.x, bid = blockIdx.x;
    const int wave_s = __builtin_amdgcn_readfirstlane(threadIdx.x >> 6);
#if !MK_MULTI && !MK_CGSYNC
    volatile LAS unsigned* xst = (volatile LAS unsigned*)(lds + LDS_BYTES - 64);
    if (threadIdx.x < 2) xst[threadIdx.x] = 0u;
    __syncthreads();
    const XcdBarrier xbar = xcd_barrier_post((unsigned*)(kp->ws + WS_BAR), xst);
#endif
#ifndef PHMASK
#define PHMASK 0xFFFFF
#endif
#define IN(k) (((PHMASK >> (k)) & 1) && lo <= (k) && (k) < hi)
#define TIDX() ((wave_s << 6) | lane_id_v())
#if MK_MULTI
#define SEAM(k) do { } while (0)
#else
#if MK_CGSYNC
#define SEAM(k) do { if (IN(k) && IN((k) + 1)) cg::this_grid().sync(); } while (0)
#else
#define SEAM(k) do { if (IN(k) && IN((k) + 1)) xcd_barrier(xbar, (wave_s << 6) | lane_id_v()); } while (0)
#endif
#endif
    if (IN(0)) { PLOAD(); phase_prep(p, lds, tidx); }
    SEAM(0);
    if (IN(1)) { PLOAD(); phase_hnorm(p, tidx); }
    SEAM(1);
    if (IN(2)) { PLOAD(); pg8::Gemm g{(const bf16_t*)(ws + WS_HB), (const bf16_t*)(ws + WS_WIN), NTOK, INCP, D, D, D, 0}; pg8::StaticOrder S; S.init(NTOK, INCP, G, bid);
        pg8::EpiCols E{(bf16_t*)(ws + WS_COLS), (float*)(ws + WS_GATES), (float*)(ws + WS_SSQ)}; pg8::gemm_phase(lds, g, S, E, tidx);
        { const int nt = (NTOK / 256) * (INCP / 256), extra = nt % G;
          if (extra == 0 || extra >= G) quant_experts(p, bid, G, TIDX()); else if (bid >= extra) quant_experts(p, bid - extra, G - extra, TIDX()); } }
    SEAM(2);
    if (IN(3)) { PLOAD();
        { pg8::Gemm g{(const bf16_t*)(ws + WS_COLS) + C_CQ, (const bf16_t*)(ws + WS_WUQ), NLAT, 1024, 256, INCP, 256, 0}; pg8::StaticOrder S; S.init(NLAT, 1024, G, bid);
          const int t_ = TIDX(); pg8::EpiQ E{(const float*)(ws + WS_SSQ), p.g_qn, (const float*)(ws + WS_ROPE), (bf16_t*)(ws + WS_Q), lds + 128 * 1024, t_}; pg8::gemm_phase(lds, g, S, E, t_); }
        { pg8::Gemm g{(const bf16_t*)(ws + WS_COLS) + C_CKV, (const bf16_t*)(ws + WS_WUKV), NTOK, 1024, 128, INCP, 128, 0}; pg8::StaticOrder S; S.init(NTOK, 1024, G, bid);
          const int t_ = TIDX(); pg8::EpiKV E{(const bf16_t*)(ws + WS_COLS), (const float*)(ws + WS_SSQ), p.g_kn, (const float*)(ws + WS_ROPE), (bf16_t*)(ws + WS_K), (bf16_t*)(ws + WS_VT), lds + 128 * 1024, t_}; pg8::gemm_phase(lds, g, S, E, t_); }
        { const int t_ = TIDX(); for (int u = (bid + G / 2) % G; u < NB * MH * 17; u += G) ml_summary_unit(p, lds, u, t_); }
    }
    SEAM(3);
    if (IN(4)) { PLOAD(); phase_ml_scan(p, tidx); }
    SEAM(4);
    if (IN(5)) { PLOAD();
        if (!p.dup || DUP_SUB == 0) { const int t_ = TIDX(); for (int u = bid; u < NB * NH * (T / 256); u += G) attn_unit(p, lds, u, t_); }
        if (!p.dup || DUP_SUB == 1) { const int t_ = TIDX(); for (int u = bid; u < NB * MH * NBLK; u += G) ml_output_unit(p, lds, u, t_); }
    }
    SEAM(5);
    if (IN(6)) { PLOAD(); pg8::Gemm g{(const bf16_t*)(ws + WS_MIX), (const bf16_t*)(ws + WS_WOUT), NLAT, D, D, D, D, 0}; pg8::StaticOrder S; S.init(NLAT, D, G, bid);
        pg8::EpiResid E{p.x, p.out, (const float*)(ws + WS_MOD), 2 * D, (DBG_MODE == 1 || DBG_MODE == 5) ? 0.f : 1.f}; pg8::gemm_phase(lds, g, S, E, tidx); }
    SEAM(6);
#if DBG_MODE == 0 || DBG_MODE == 5
    if (IN(7)) { PLOAD(); phase_h2(p, tidx); }
    SEAM(7);
    if (IN(8)) { PLOAD(); pg8::Gemm g{(const bf16_t*)(ws + WS_H2), (const bf16_t*)(ws + WS_WPQ), NLAT, 2048, D, D, D, 0}; pg8::StaticOrder S; S.init(NLAT, 2048, G, bid);
        pg8::EpiBf16 E{(bf16_t*)(ws + WS_QP), 2048}; pg8::gemm_phase(lds, g, S, E, tidx); }
    SEAM(8);
    if (IN(9)) { PLOAD(); for (int u = bid; u < NLAT / 32; u += G) peer_topk_unit(p, lds, u, tidx); }
    SEAM(9);
    if (IN(10)) { PLOAD(); phase_peer_u(p, lds, tidx); }
    SEAM(10);
    if (IN(11)) { PLOAD(); phase_peer_v(p, lds, tidx); }
#endif
#if DBG_CHECK
    SEAM(11);
    if (IN(12)) { PLOAD(); dbg_peer_check(p, lds, tidx); }
    SEAM(12);
    if (IN(13)) { PLOAD(); dbg_report(p, tidx); }
#endif
#undef IN
#undef SEAM
}

extern "C" void kernel_launch(void* const* d_in, const int* in_sizes, int n_in, void* d_out, int out_size, void* d_ws, size_t ws_size, hipStream_t stream) {
    static int grid = 0;
    if (grid == 0) {
        if (n_in != 24 || out_size != NLAT * D || ws_size < WS_END) { fprintf(stderr, "kernel_launch: unexpected shapes (n_in %d out %d ws %zu, need %zu)\n", n_in, out_size, ws_size, (size_t)WS_END); grid = -1; return; }
        int dev = 0, cus = 0, per_cu = 0;
        hipGetDevice(&dev); hipDeviceGetAttribute(&cus, hipDeviceAttributeMultiprocessorCount, dev);
        hipFuncSetAttribute((const void*)mega, hipFuncAttributeMaxDynamicSharedMemorySize, LDS_BYTES);
        hipOccupancyMaxActiveBlocksPerMultiprocessor(&per_cu, (const void*)mega, NTHREADS, LDS_BYTES);
        (void)hipGetLastError();
        if (per_cu < 1) { fprintf(stderr, "kernel_launch: occupancy query says %d blocks per CU\n", per_cu); per_cu = 1; }
        grid = cus;
    }
    if (grid < 0) return;
    Params p{};
    const float** pp = (const float**)&p;
    for (int i = 0; i < 24; ++i) pp[i] = (const float*)d_in[i];
    p.out = (float*)d_out; p.ws = (unsigned char*)d_ws;
#if MK_MULTI
    for (int ph = 0; ph < NPHASE; ++ph) for (int rep = 0; rep <= ((DUP_MASK >> ph) & 1); ++rep) { p.ph_lo = ph; p.ph_hi = ph + 1; p.dup = rep; hipLaunchKernelGGL(mega, dim3(grid), dim3(NTHREADS), LDS_BYTES, stream, p); }
#else
    p.ph_lo = 0; p.ph_hi = NPHASE;
#if MK_CGSYNC
    void* args[] = {&p};
    hipError_t e = hipLaunchCooperativeKernel((void*)mega, dim3(grid), dim3(NTHREADS), args, LDS_BYTES, stream);
    if (e != hipSuccess) fprintf(stderr, "cooperative launch failed: %s (grid %d)\n", hipGetErrorString(e), grid);
#else
    (void)hipMemsetAsync((char*)d_ws + WS_BAR, 0, XCD_BAR_WORDS * 4, stream);
    hipLaunchKernelGGL(mega, dim3(grid), dim3(NTHREADS), LDS_BYTES, stream, p);
#endif
#endif
}
```

```cpp
#include <hip/hip_runtime.h>
#include <hip/hip_cooperative_groups.h>
#include <cstdio>
#include <cstdint>
namespace cg = cooperative_groups;

#ifndef MK_MULTI
#define MK_MULTI 0
#endif
#ifndef MK_CGSYNC
#define MK_CGSYNC 0
#endif
#ifndef DUP_MASK
#define DUP_MASK 0
#endif
#ifndef DUP_SUB
#define DUP_SUB 0
#endif
#define DBG_CHECK 0
#define DBG_SEL 4
#ifndef DBG_MODE
#define DBG_MODE 0
#endif
#ifndef DBG_PSCALE
#define DBG_PSCALE 1.0f
#endif

#define LAS __attribute__((address_space(3)))
typedef unsigned short bf16_t;
typedef short bf16x8 __attribute__((ext_vector_type(8)));
typedef short s16x4 __attribute__((ext_vector_type(4)));
typedef float f32x4 __attribute__((ext_vector_type(4)));
typedef float f32x2 __attribute__((ext_vector_type(2)));
typedef float f32x16 __attribute__((ext_vector_type(16)));
typedef unsigned u32x4 __attribute__((ext_vector_type(4)));
typedef unsigned u32x2 __attribute__((ext_vector_type(2)));
typedef __bf16 bf16v2 __attribute__((ext_vector_type(2)));

constexpr int NB = 8, T = 4096, TC = 256, D = 1024;
constexpr int NLAT = NB * T, NCTX = NB * TC, NTOK = NLAT + NCTX;
constexpr int NMOD = 6 * D;
constexpr int INC = 2000, INCP = 2048;
constexpr int C_CQ = 0, C_CKV = 256, C_KR = 384, C_MQ = 448, C_MK = 704, C_MV = 960, C_MO = 1472, C_G = 1984;
constexpr int NH = 4, DQK = 192, DNOPE = 128, DROPE = 64, DV = 128;
constexpr int NKEY = TC + T;
constexpr int MH = 4, MDK = 64, MDV = 128, MCH = 256, NBLK = T / MCH;
constexpr int PH = 8, NKEYS = 128, PDK = 256, PTOP = 16, NEXP = NKEYS * NKEYS;
constexpr float EPS = 1e-6f;
constexpr int NTHREADS = 512, NWAVES = 8;

constexpr size_t MiB = 1u << 20;
constexpr size_t WS_ZERO = 0;
constexpr size_t WS_MOD = 0;
constexpr size_t WS_SSQ = 18 * MiB + 512 * 1024;
constexpr size_t ZERO_BYTES = 1 * MiB;
constexpr size_t WS_BAR = 512 * 1024;
constexpr size_t WS_ROPE = 1 * MiB;
constexpr size_t WS_SKB = WS_ROPE + 64 * 1024;
constexpr size_t WS_MSCAL = WS_SKB + 512 * 1024;
constexpr size_t WS_MST = WS_MSCAL + 64 * 1024;
constexpr size_t WS_NST = WS_MST + 64 * 1024;
constexpr size_t WS_NL = WS_NST + 512 * 1024;
constexpr size_t WS_WIN = 4 * MiB;
constexpr size_t WS_WUQ = 8 * MiB;
constexpr size_t WS_WUKV = 9 * MiB;
constexpr size_t WS_WOUT = 10 * MiB;
constexpr size_t WS_WPQ = 12 * MiB;
constexpr size_t WS_GATES = 16 * MiB;
constexpr size_t WS_R1 = 20 * MiB;
constexpr size_t WS_HB = WS_R1, WS_Q = WS_R1, WS_CST = WS_R1 + 48 * MiB, WS_H2 = WS_R1;
constexpr size_t WS_COLS = 88 * MiB;
constexpr size_t WS_QP = WS_COLS;
constexpr size_t WS_R2 = 224 * MiB;
constexpr size_t WS_QRAW = WS_R2, WS_KVRAW = WS_R2 + 48 * MiB, WS_MIX = WS_R2;
constexpr size_t WS_EIDX = WS_R2 + 64 * MiB, WS_GW = WS_R2 + 80 * MiB;
constexpr size_t WS_CE = WS_EIDX;
constexpr size_t WS_SUE = WS_R2 + 96 * MiB;
constexpr size_t WS_U = 340 * MiB;
constexpr size_t WS_K = 376 * MiB;
constexpr size_t WS_VT = 428 * MiB;
constexpr size_t WS_EU = 376 * MiB;
constexpr size_t WS_EV = 408 * MiB;
constexpr size_t WS_EU8 = 464 * MiB;
constexpr size_t WS_EV8 = 480 * MiB;
constexpr size_t WS_H2Q = 408 * MiB;
constexpr size_t WS_SU = 3 * MiB;
constexpr size_t WS_SV = 3 * MiB + 64 * 1024;
constexpr size_t WS_HS = 3 * MiB + 128 * 1024;
constexpr size_t WS_OFFS = 3 * MiB + 256 * 1024;
constexpr size_t WS_END = 496 * MiB;
constexpr size_t WS_DBGP = 340 * MiB;
constexpr size_t WS_DBGR = 342 * MiB;

__device__ __forceinline__ unsigned cvt_pk_bf16(float lo, float hi) { unsigned r; asm volatile("v_cvt_pk_bf16_f32 %0, %1, %2" : "=v"(r) : "v"(lo), "v"(hi)); return r; }
__device__ __forceinline__ int lane_id_v() { int l; asm volatile("v_mbcnt_lo_u32_b32 %0, -1, 0\n\tv_mbcnt_hi_u32_b32 %0, -1, %0" : "=v"(l)); return l; }
__device__ __forceinline__ int pe_slice(int e) { return ((e >> 7) + e) & 7; }
__device__ __forceinline__ unsigned pe_local(unsigned e) { return ((e >> 7) << 4) | ((e & 127u) >> 3); }
__device__ __forceinline__ float bf_lo(unsigned w) { return __uint_as_float(w << 16); }
__device__ __forceinline__ float bf_hi(unsigned w) { return __uint_as_float(w & 0xffff0000u); }
__device__ __forceinline__ float bf2f(bf16_t v) { return __uint_as_float((unsigned)v << 16); }
__device__ __forceinline__ bf16_t f2bf(float f) { return (bf16_t)(cvt_pk_bf16(f, 0.f) & 0xffffu); }
__device__ __forceinline__ float wave_sum(float v) {
#pragma unroll
    for (int o = 1; o < 64; o <<= 1) v += __shfl_xor(v, o);
    return v;
}
__device__ __forceinline__ float siluf(float v) { return v / (1.f + __expf(-v)); }
__device__ __forceinline__ float sigmoidf_(float v) { return 1.f / (1.f + __expf(-v)); }
__device__ __forceinline__ float logsigmoidf_(float v) { return fminf(v, 0.f) - log1pf(__expf(-fabsf(v))); }
__device__ __forceinline__ int crow(int r, int hi) { return (r & 3) + 8 * (r >> 2) + 4 * hi; }

struct Params {
    const float *x, *c, *ctx, *c_ctx, *w_ada, *b_ada, *g_norm1, *w_in, *g_cq, *w_uq, *g_ckv, *w_ukv, *g_qn, *g_kn, *conv_qk, *b_igate, *b_fgate, *g_mlstm, *w_out, *g_norm2,
        *w_pq, *sub_keys, *expert_u, *expert_v;
    float* out; unsigned char* ws;
    int ph_lo, ph_hi, dup, pad_;
};

namespace pg8 {
constexpr int BM = 256, BK = 64, HALF = 128, HTB = HALF * BK * 2, STAGE_BYTES = 8 * HTB, NXCD = 8, WGM = 8;
__host__ __device__ __forceinline__ int lds_byte(int r, int c) { const int st = (r >> 4) * 2 + (c >> 5), rr = r & 15, cc = c & 31, ob = rr * 64 + cc * 2; return st * 1024 + (ob ^ (((ob >> 9) & 1) << 5)); }
__host__ __device__ __forceinline__ void stage_rc(int b, int& R, int& C) { const int st = b / 1024, sb = b % 1024, swz = sb ^ (((sb >> 9) & 1) << 5); R = (st >> 1) * 16 + swz / 64; C = (st & 1) * 32 + (swz % 64) / 2; }
__host__ __device__ __forceinline__ int perm32(int rho) { const int n = rho >> 4, i = rho & 15; return 8 * (i >> 2) + 4 * n + (i & 3); }
struct Unit { int pm, pn; };
struct Gemm { const bf16_t* A; const bf16_t* Bt; int M, N, K, lda, ldb, a_pn_off; };
struct StaticOrder {
    int nM, nN, nwg, G, c;
    __host__ __device__ void init(int M, int N, int G_, int c_) { nM = M / BM; nN = N / BM; nwg = nM * nN; G = G_; c = c_; }
    __host__ __device__ bool next(int i, Unit& u) const {
        const long L = (long)i * G + c; if (L >= nwg) return false;
        int wgid = (int)L; { const int q = nwg / NXCD, r = nwg % NXCD, xcd = wgid % NXCD, off = wgid / NXCD; wgid = (xcd < r ? xcd * (q + 1) : r * (q + 1) + (xcd - r) * q) + off; }
        const int nig = WGM * nN, gid = wgid / nig, fm = gid * WGM, gsz = (nM - fm) < WGM ? (nM - fm) : WGM;
        u.pm = fm + ((wgid % nig) % gsz); u.pn = (wgid % nig) / gsz; return true;
    }
};
template <class Epi, class Sched>
__device__ __forceinline__ void gemm_phase(LAS unsigned char* lds, const Gemm g, const Sched& S, const Epi& E, const int tidx) {
    const int tid = tidx, wid = __builtin_amdgcn_readfirstlane(tid >> 6), lane = tid & 63, wr = wid >> 2, wc = wid & 3, fr = lane & 15, fq = lane >> 4;
    const int K = g.K, nt = K / BK;
    unsigned voffA[2], voffB[2];
#pragma unroll
    for (int i = 0; i < 2; ++i) { int R, C; stage_rc(tid * 16 + i * 8192, R, C); const int Rb = Epi::PERM ? ((R & ~31) + perm32(R & 31)) : R;
        voffA[i] = (unsigned)(R * g.lda + C) * 2u; voffB[i] = (unsigned)(Rb * g.ldb + C) * 2u; }
    const size_t kstep = (size_t)(BK * 2);
    const size_t hstepA = (size_t)HALF * g.lda * 2, hstepB = (size_t)HALF * g.ldb * 2;
    const size_t tstepA = 2 * hstepA, tstepB = 2 * hstepB;
    const unsigned ldsw = (unsigned)wid * 1024u;
    const int aoff = lds_byte(wr * 64 + fr, fq * 8), boff = lds_byte(wc * 32 + fr, fq * 8);
#define PG8_SA(b, h) (((b) * 2 + (h)) * HTB)
#define PG8_SB(b, h) ((4 + (b) * 2 + (h)) * HTB)
#define PG8_STAGE(bufoff, gbase, voff) do { _Pragma("unroll") for (int _i = 0; _i < 2; ++_i) \
        __builtin_amdgcn_global_load_lds((const unsigned*)((const char*)(gbase) + (voff)[_i]), (LAS unsigned*)(lds + (bufoff) + ldsw + _i * 8192), 16, 0, 0); } while (0)
#define PG8_LDA(dst, b, h) do { _Pragma("unroll") for (int m = 0; m < 4; ++m) _Pragma("unroll") for (int k = 0; k < 2; ++k) dst[m][k] = *(const LAS bf16x8*)(lds + PG8_SA(b, h) + aoff + m * 2048 + k * 1024); } while (0)
#define PG8_LDB(dst, b, h) do { _Pragma("unroll") for (int n = 0; n < 2; ++n) _Pragma("unroll") for (int k = 0; k < 2; ++k) dst[n][k] = *(const LAS bf16x8*)(lds + PG8_SB(b, h) + boff + n * 2048 + k * 1024); } while (0)
#define PG8_MMA(ai, bj, At, Bt) do { __builtin_amdgcn_s_setprio(1); _Pragma("unroll") for (int m = 0; m < 4; ++m) _Pragma("unroll") for (int n = 0; n < 2; ++n) _Pragma("unroll") for (int k = 0; k < 2; ++k) \
        acc[ai][bj][m][n] = __builtin_amdgcn_mfma_f32_16x16x32_bf16(Bt[n][k], At[m][k], acc[ai][bj][m][n], 0, 0, 0); __builtin_amdgcn_s_setprio(0); } while (0)
#define PG8_WAIT_V(n) asm volatile("s_waitcnt vmcnt(" #n ")" ::: "memory")
#define PG8_WAIT_L(n) asm volatile("s_waitcnt lgkmcnt(" #n ")" ::: "memory")
#define PG8_BAR __builtin_amdgcn_s_barrier()
#define PG8_SCHED __builtin_amdgcn_sched_barrier(0)
    Unit cur, nxt; int ui = 0;
    if (!S.next(0, cur)) return;
    f32x4 acc[2][2][4][2];
#pragma unroll
    for (int a = 0; a < 2; ++a)
#pragma unroll
        for (int b = 0; b < 2; ++b)
#pragma unroll
            for (int m = 0; m < 4; ++m)
#pragma unroll
                for (int n = 0; n < 2; ++n) acc[a][b][m][n] = (f32x4){0.f, 0.f, 0.f, 0.f};
    bf16x8 At[4][2], B0[2][2], B1[2][2];
    const char* cA = (const char*)g.A + (size_t)cur.pm * tstepA + (size_t)cur.pn * g.a_pn_off * 2; const char* cB = (const char*)g.Bt + (size_t)cur.pn * tstepB;
    PG8_STAGE(PG8_SB(0, 0), cB, voffB); PG8_STAGE(PG8_SB(0, 1), cB + hstepB, voffB); PG8_STAGE(PG8_SA(0, 0), cA, voffA); PG8_STAGE(PG8_SA(0, 1), cA + hstepA, voffA);
    if (wr == 1) PG8_BAR;
    PG8_WAIT_V(2); PG8_BAR;
    PG8_STAGE(PG8_SB(1, 0), cB + kstep, voffB); PG8_STAGE(PG8_SA(1, 0), cA + kstep, voffA); PG8_STAGE(PG8_SB(1, 1), cB + hstepB + kstep, voffB);
    PG8_WAIT_V(6); PG8_BAR;
    for (;;) {
        const bool has_next = S.next(ui + 1, nxt);
        const char* nA = has_next ? (const char*)g.A + (size_t)nxt.pm * tstepA + (size_t)nxt.pn * g.a_pn_off * 2 : cA; const char* nB = has_next ? (const char*)g.Bt + (size_t)nxt.pn * tstepB : cB;
        for (int t = 0; t < nt; t += 2) {
            const bool last = (t == nt - 2);
            const char* a1 = cA + (size_t)(t + 1) * kstep;
            const char* a2 = last ? nA : cA + (size_t)(t + 2) * kstep; const char* b2 = last ? nB : cB + (size_t)(t + 2) * kstep;
            const char* a3 = a2 + kstep; const char* b3 = b2 + kstep;
            PG8_LDB(B0, 0, 0); PG8_LDB(B1, 0, 1); PG8_SCHED; PG8_LDA(At, 0, 0); PG8_STAGE(PG8_SA(1, 1), a1 + hstepA, voffA);
            PG8_WAIT_V(8); PG8_WAIT_L(0); PG8_BAR; PG8_MMA(0, 0, At, B0); PG8_MMA(0, 1, At, B1); PG8_BAR; PG8_SCHED;
            PG8_LDA(At, 0, 1); PG8_STAGE(PG8_SB(0, 0), b2, voffB); PG8_STAGE(PG8_SB(0, 1), b2 + hstepB, voffB); PG8_STAGE(PG8_SA(0, 0), a2, voffA);
            PG8_WAIT_V(8); PG8_WAIT_L(0); PG8_BAR; PG8_MMA(1, 0, At, B0); PG8_MMA(1, 1, At, B1); PG8_BAR; PG8_SCHED;
            PG8_LDB(B0, 1, 0); PG8_LDB(B1, 1, 1); PG8_SCHED; PG8_LDA(At, 1, 0); PG8_STAGE(PG8_SA(0, 1), a2 + hstepA, voffA);
            PG8_WAIT_V(8); PG8_WAIT_L(0); PG8_BAR; PG8_MMA(0, 0, At, B0); PG8_MMA(0, 1, At, B1); PG8_BAR; PG8_SCHED;
            PG8_LDA(At, 1, 1); PG8_STAGE(PG8_SB(1, 0), b3, voffB); PG8_STAGE(PG8_SB(1, 1), b3 + hstepB, voffB); PG8_STAGE(PG8_SA(1, 0), a3, voffA);
            PG8_WAIT_V(8); PG8_WAIT_L(0); PG8_BAR; PG8_MMA(1, 0, At, B0); PG8_MMA(1, 1, At, B1); PG8_BAR; PG8_SCHED;
        }
        if (wr == 0) PG8_BAR;
        E(acc, cur, wr, wc, fr, fq);
        if (!has_next) break;
#pragma unroll
        for (int a = 0; a < 2; ++a)
#pragma unroll
            for (int b = 0; b < 2; ++b)
#pragma unroll
                for (int m = 0; m < 4; ++m)
#pragma unroll
                    for (int n = 0; n < 2; ++n) acc[a][b][m][n] = (f32x4){0.f, 0.f, 0.f, 0.f};
        cur = nxt; cA = nA; cB = nB; ++ui;
        if (wr == 1) PG8_BAR;
    }
    PG8_WAIT_V(0);
    PG8_BAR;
#undef PG8_SA
#undef PG8_SB
#undef PG8_STAGE
#undef PG8_LDA
#undef PG8_LDB
#undef PG8_MMA
#undef PG8_WAIT_V
#undef PG8_WAIT_L
#undef PG8_BAR
#undef PG8_SCHED
}

struct EpiBf16 {
    static constexpr bool PERM = true;
    bf16_t* O; int ldc;
    __device__ __forceinline__ void operator()(const f32x4 (&acc)[2][2][4][2], const Unit& u, int wr, int wc, int fr, int fq) const {
        const int row0 = u.pm * BM + wr * 64 + fr, col0 = u.pn * BM + wc * 32 + 8 * fq;
#pragma unroll
        for (int ai = 0; ai < 2; ++ai)
#pragma unroll
            for (int m = 0; m < 4; ++m) { bf16_t* rowp = O + (size_t)(row0 + ai * HALF + m * 16) * ldc + col0;
#pragma unroll
                for (int bj = 0; bj < 2; ++bj) { const f32x4 v0 = acc[ai][bj][m][0], v1 = acc[ai][bj][m][1]; u32x4 w;
                    w.x = cvt_pk_bf16(v0[0], v0[1]); w.y = cvt_pk_bf16(v0[2], v0[3]); w.z = cvt_pk_bf16(v1[0], v1[1]); w.w = cvt_pk_bf16(v1[2], v1[3]);
                    *(u32x4*)(rowp + bj * HALF) = w; } }
    }
};
struct EpiCols {
    static constexpr bool PERM = true;
    bf16_t* O; float* gates; float* ssq;
    __device__ __forceinline__ void operator()(const f32x4 (&acc)[2][2][4][2], const Unit& u, int wr, int wc, int fr, int fq) const {
        const int row0 = u.pm * BM + wr * 64 + fr, col0 = u.pn * BM + wc * 32 + 8 * fq;
#pragma unroll
        for (int ai = 0; ai < 2; ++ai)
#pragma unroll
            for (int m = 0; m < 4; ++m) { const int row = row0 + ai * HALF + m * 16; bf16_t* rowp = O + (size_t)row * INCP + col0;
                float s0 = 0.f, s1 = 0.f;
#pragma unroll
                for (int bj = 0; bj < 2; ++bj) { const f32x4 v0 = acc[ai][bj][m][0], v1 = acc[ai][bj][m][1]; u32x4 w;
                    w.x = cvt_pk_bf16(v0[0], v0[1]); w.y = cvt_pk_bf16(v0[2], v0[3]); w.z = cvt_pk_bf16(v1[0], v1[1]); w.w = cvt_pk_bf16(v1[2], v1[3]);
                    *(u32x4*)(rowp + bj * HALF) = w;
                    const float s = (v0[0] * v0[0] + v0[1] * v0[1]) + (v0[2] * v0[2] + v0[3] * v0[3]) + (v1[0] * v1[0] + v1[1] * v1[1]) + (v1[2] * v1[2] + v1[3] * v1[3]);
                    if (bj == 0) s0 = s; else s1 = s; }
                if (u.pn == 0) { float s = s0 + s1; s += __shfl_xor(s, 16); s += __shfl_xor(s, 32); if (fq == 0) ssq[row * 8 + wc] = s; }
                if (u.pn == 1) { float s = s0; s += __shfl_xor(s, 16); s += __shfl_xor(s, 32); if (fq == 0) ssq[row * 8 + 4 + wc] = s; }
                if (u.pn == 7 && wc == 2 && fq < 2) { *(f32x4*)(gates + (size_t)row * 16 + 8 * fq) = acc[ai][1][m][0]; *(f32x4*)(gates + (size_t)row * 16 + 8 * fq + 4) = acc[ai][1][m][1]; }
            }
    }
};
struct EpiResid {
    static constexpr bool PERM = false;
    const float* base; float* out; const float* mod; int gate_off; float gscale;
    __device__ __forceinline__ void operator()(const f32x4 (&acc)[2][2][4][2], const Unit& u, int wr, int wc, int fr, int fq) const {
        const int row0 = u.pm * BM + wr * 64 + fr, col0 = u.pn * BM + wc * 32 + 4 * fq;
        const int b = (u.pm * BM) / T;
        f32x4 gv[2][2];
#pragma unroll
        for (int bj = 0; bj < 2; ++bj)
#pragma unroll
            for (int n = 0; n < 2; ++n) gv[bj][n] = *(const f32x4*)(mod + (size_t)b * NMOD + gate_off + col0 + bj * HALF + n * 16) * gscale;
#pragma unroll
        for (int ai = 0; ai < 2; ++ai)
#pragma unroll
            for (int m = 0; m < 4; ++m) { const size_t off = (size_t)(row0 + ai * HALF + m * 16) * D + col0;
#pragma unroll
                for (int bj = 0; bj < 2; ++bj)
#pragma unroll
                    for (int n = 0; n < 2; ++n) { const f32x4 bs = *(const f32x4*)(base + off + bj * HALF + n * 16); *(f32x4*)(out + off + bj * HALF + n * 16) = bs + gv[bj][n] * acc[ai][bj][m][n]; } }
    }
};
struct EpiKV {
    static constexpr bool PERM = true;
    const bf16_t* cols; const float* ssq; const float* g_kn; const float* rt; bf16_t* Kb; bf16_t* Vb; LAS unsigned char* xl; int tidx;
    __device__ __forceinline__ void operator()(const f32x4 (&acc)[2][2][4][2], const Unit& u, int wr_, int wc_, int fr_, int fq_) const {
        int fr = fr_, fq = fq_, tix = tidx, wr = wr_, wc = wc_; asm volatile("" : "+v"(fr), "+v"(fq), "+v"(tix), "+s"(wr), "+s"(wc));
        LAS float* P = (LAS float*)xl;
        LAS float* KR = P + 1024;
        LAS float* RK = KR + 256;
        LAS float* RKV = RK + 256;
        const int h = u.pn, rowbase = u.pm * BM;
        const bool lat = rowbase < NLAT; const int b = lat ? rowbase / T : (rowbase - NLAT) / TC; const int key0 = lat ? TC + rowbase % T : 0, t0 = lat ? rowbase % T : 0;
#pragma unroll
        for (int ai = 0; ai < 2; ++ai)
#pragma unroll
            for (int m = 0; m < 4; ++m) { const f32x4 v0 = acc[ai][0][m][0], v1 = acc[ai][0][m][1];
                float s = (v0[0] * v0[0] + v0[1] * v0[1]) + (v0[2] * v0[2] + v0[3] * v0[3]) + (v1[0] * v1[0] + v1[1] * v1[1]) + (v1[2] * v1[2] + v1[3] * v1[3]);
                s += __shfl_xor(s, 16); s += __shfl_xor(s, 32);
                if (fq == 0) P[(ai * HALF + wr * 64 + m * 16 + fr) * 4 + wc] = s; }
        const int rrow = tix >> 1, half = tix & 1;
        const bf16_t* krp = cols + (size_t)(rowbase + rrow) * INCP + C_KR + 32 * half;
        { float ss = 0.f;
#pragma unroll
          for (int c4 = 0; c4 < 4; ++c4) { const u32x4 kk = *(const u32x4*)(krp + 8 * c4);
#pragma unroll
              for (int q = 0; q < 4; ++q) { const float lo = bf_lo(kk[q]), hi = bf_hi(kk[q]); ss += lo * lo + hi * hi; } }
          ss += __shfl_xor(ss, 1); if (half == 0) KR[rrow] = ss; }
        asm volatile("s_waitcnt lgkmcnt(0)" ::: "memory"); __builtin_amdgcn_s_barrier(); asm volatile("" ::: "memory");
        if (tix < 256) { const f32x4 sk4 = *(const f32x4*)(ssq + (size_t)(rowbase + tix) * 8 + 4);
            const float rkv = rsqrtf(((sk4[0] + sk4[1]) + (sk4[2] + sk4[3])) * (1.f / 128.f) + EPS);
            const float sn = ((P[tix * 4] + P[tix * 4 + 1]) + (P[tix * 4 + 2] + P[tix * 4 + 3])) * rkv * rkv;
            RKV[tix] = rkv; RK[tix] = rsqrtf((sn + KR[tix]) * (1.f / 192.f) + EPS); }
        asm volatile("s_waitcnt lgkmcnt(0)" ::: "memory"); __builtin_amdgcn_s_barrier(); asm volatile("" ::: "memory");
        const int col0 = wc * 32 + 8 * fq;
        f32x4 g0 = *(const f32x4*)(g_kn + col0), g1 = *(const f32x4*)(g_kn + col0 + 4);
#pragma unroll
        for (int ai = 0; ai < 2; ++ai)
#pragma unroll
            for (int m = 0; m < 4; ++m) { const int r = ai * HALF + wr * 64 + m * 16 + fr; const float rkv = RKV[r], sk = rkv * RK[r];
                const size_t kvrow = ((size_t)b * NH + h) * NKEY + key0 + r;
                { const f32x4 v0 = acc[ai][0][m][0] * sk * g0, v1 = acc[ai][0][m][1] * sk * g1; u32x4 w;
                  w.x = cvt_pk_bf16(v0[0], v0[1]); w.y = cvt_pk_bf16(v0[2], v0[3]); w.z = cvt_pk_bf16(v1[0], v1[1]); w.w = cvt_pk_bf16(v1[2], v1[3]); *(u32x4*)(Kb + kvrow * DQK + col0) = w; }
                { const f32x4 v0 = acc[ai][1][m][0] * rkv, v1 = acc[ai][1][m][1] * rkv; u32x4 w;
                  w.x = cvt_pk_bf16(v0[0], v0[1]); w.y = cvt_pk_bf16(v0[2], v0[3]); w.z = cvt_pk_bf16(v1[0], v1[1]); w.w = cvt_pk_bf16(v1[2], v1[3]); *(u32x4*)(Vb + kvrow * DV + col0) = w; } }
        { const float rk = RK[rrow]; const int t = t0 + rrow; const int pos = half ? (t & 63) : (t >> 6);
          const float* gk = g_kn + 128 + 32 * half;
          bf16_t* kp = Kb + (((size_t)b * NH + h) * NKEY + key0 + rrow) * DQK + 128 + 32 * half;
#pragma unroll
          for (int hf = 0; hf < 2; ++hf) {
              const u32x4 ka = *(const u32x4*)(krp + 8 * hf), kb2 = *(const u32x4*)(krp + 16 + 8 * hf);
              float oa[8], ob[8];
#pragma unroll
              for (int q = 0; q < 8; ++q) { const int j = 8 * hf + q; float cs = 1.f, sn = 0.f; if (lat) { cs = rt[(pos * 16 + j) * 2]; sn = rt[(pos * 16 + j) * 2 + 1]; }
                  const float av = ((q & 1) ? bf_hi(ka[q >> 1]) : bf_lo(ka[q >> 1])) * rk * gk[j], cv = ((q & 1) ? bf_hi(kb2[q >> 1]) : bf_lo(kb2[q >> 1])) * rk * gk[16 + j];
                  oa[q] = av * cs - cv * sn; ob[q] = cv * cs + av * sn; }
              u32x4 w; w.x = cvt_pk_bf16(oa[0], oa[1]); w.y = cvt_pk_bf16(oa[2], oa[3]); w.z = cvt_pk_bf16(oa[4], oa[5]); w.w = cvt_pk_bf16(oa[6], oa[7]); *(u32x4*)(kp + 8 * hf) = w;
              w.x = cvt_pk_bf16(ob[0], ob[1]); w.y = cvt_pk_bf16(ob[2], ob[3]); w.z = cvt_pk_bf16(ob[4], ob[5]); w.w = cvt_pk_bf16(ob[6], ob[7]); *(u32x4*)(kp + 16 + 8 * hf) = w; } }
        asm volatile("s_waitcnt lgkmcnt(0)" ::: "memory"); __builtin_amdgcn_s_barrier(); asm volatile("" ::: "memory");
    }
};
struct EpiQ {
    static constexpr bool PERM = true;
    const float* ssq; const float* g_qn; const float* rt; bf16_t* Q; LAS unsigned char* xl; int tidx;
    __device__ __forceinline__ void operator()(const f32x4 (&acc)[2][2][4][2], const Unit& u, int wr_, int wc_, int fr_, int fq_) const {
        int fr = fr_, fq = fq_, tix = tidx, wr = wr_, wc = wc_; asm volatile("" : "+v"(fr), "+v"(fq), "+v"(tix), "+s"(wr), "+s"(wc));
        LAS float* P = (LAS float*)xl;
        LAS float* RS = P + 1024;
        const int h = u.pn, rowbase = u.pm * BM; const int b = rowbase / T, t0 = rowbase % T;
#pragma unroll
        for (int ai = 0; ai < 2; ++ai)
#pragma unroll
            for (int m = 0; m < 4; ++m) { float s = 0.f;
#pragma unroll
                for (int bj = 0; bj < 2; ++bj) { const f32x4 v0 = acc[ai][bj][m][0], v1 = acc[ai][bj][m][1];
                    s += (v0[0] * v0[0] + v0[1] * v0[1]) + (v0[2] * v0[2] + v0[3] * v0[3]) + (v1[0] * v1[0] + v1[1] * v1[1]) + (v1[2] * v1[2] + v1[3] * v1[3]); }
                s += __shfl_xor(s, 16); s += __shfl_xor(s, 32);
                if (fq == 0) P[(ai * HALF + wr * 64 + m * 16 + fr) * 4 + wc] = s; }
        asm volatile("s_waitcnt lgkmcnt(0)" ::: "memory"); __builtin_amdgcn_s_barrier(); asm volatile("" ::: "memory");
        if (tix < 256) { const f32x4 sq4 = *(const f32x4*)(ssq + (size_t)(rowbase + tix) * 8);
            const float rq = rsqrtf(((sq4[0] + sq4[1]) + (sq4[2] + sq4[3])) * (1.f / 256.f) + EPS);
            const float sn = ((P[tix * 4] + P[tix * 4 + 1]) + (P[tix * 4 + 2] + P[tix * 4 + 3])) * rq * rq;
            RS[tix] = rq * rsqrtf(sn * (1.f / 192.f) + EPS); }
        asm volatile("s_waitcnt lgkmcnt(0)" ::: "memory"); __builtin_amdgcn_s_barrier(); asm volatile("" ::: "memory");
        const int col0 = wc * 32 + 8 * fq;
        { const f32x4 g0 = *(const f32x4*)(g_qn + col0), g1 = *(const f32x4*)(g_qn + col0 + 4);
#pragma unroll
          for (int ai = 0; ai < 2; ++ai)
#pragma unroll
            for (int m = 0; m < 4; ++m) { const int r = ai * HALF + wr * 64 + m * 16 + fr; const float sc = RS[r];
                const f32x4 v0 = acc[ai][0][m][0] * sc * g0, v1 = acc[ai][0][m][1] * sc * g1; u32x4 w;
                w.x = cvt_pk_bf16(v0[0], v0[1]); w.y = cvt_pk_bf16(v0[2], v0[3]); w.z = cvt_pk_bf16(v1[0], v1[1]); w.w = cvt_pk_bf16(v1[2], v1[3]);
                *(u32x4*)(Q + (((size_t)b * NH + h) * T + t0 + r) * DQK + col0) = w; } }
        if (wc < 2) {
            const f32x4 g0 = *(const f32x4*)(g_qn + 128 + col0), g1 = *(const f32x4*)(g_qn + 128 + col0 + 4);
            const bool second = fq >= 2; const int fi0 = (8 * fq) & 15;
#pragma unroll
            for (int ai = 0; ai < 2; ++ai)
#pragma unroll
                for (int m = 0; m < 4; ++m) { const int r = ai * HALF + wr * 64 + m * 16 + fr; const float sc = RS[r];
                    const int t = t0 + r; const int pos = wc ? (t & 63) : (t >> 6);
                    const f32x4 v0 = acc[ai][1][m][0] * sc * g0, v1 = acc[ai][1][m][1] * sc * g1; float o[8];
#pragma unroll
                    for (int q = 0; q < 8; ++q) { const float own = q < 4 ? v0[q & 3] : v1[q & 3];
                        auto r_ = __builtin_amdgcn_permlane32_swap(__float_as_uint(own), __float_as_uint(own), false, false);
                        const float oth = second ? __uint_as_float(r_[0]) : __uint_as_float(r_[1]);
                        const f32x2 cs = *(const f32x2*)(rt + (pos * 16 + fi0 + q) * 2);
                        o[q] = second ? (own * cs[0] + oth * cs[1]) : (own * cs[0] - oth * cs[1]); }
                    u32x4 w; w.x = cvt_pk_bf16(o[0], o[1]); w.y = cvt_pk_bf16(o[2], o[3]); w.z = cvt_pk_bf16(o[4], o[5]); w.w = cvt_pk_bf16(o[6], o[7]);
                    *(u32x4*)(Q + (((size_t)b * NH + h) * T + t0 + r) * DQK + 128 + col0) = w; } }
        asm volatile("s_waitcnt lgkmcnt(0)" ::: "memory"); __builtin_amdgcn_s_barrier(); asm volatile("" ::: "memory");
    }
};
}

template <int CTRL> __device__ __forceinline__ int dppi(int v) { return __builtin_amdgcn_update_dpp(0, v, CTRL, 0xf, 0xf, true); }
template <int CTRL> __device__ __forceinline__ float dppf(float v) { return __int_as_float(__builtin_amdgcn_update_dpp(0, __float_as_int(v), CTRL, 0xf, 0xf, true)); }
__device__ __forceinline__ int row_sum_i(int d) { d += dppi<0xB1>(d); d += dppi<0x4E>(d); d += dppi<0x141>(d); d += dppi<0x140>(d); return d; }
__device__ __forceinline__ float row_sum_f(float d) { d += dppf<0xB1>(d); d += dppf<0x4E>(d); d += dppf<0x141>(d); d += dppf<0x140>(d); return d; }
__device__ __forceinline__ float wave_sum_fast(float v) {
    v = row_sum_f(v);
    { auto r = __builtin_amdgcn_permlane16_swap(__float_as_uint(v), __float_as_uint(v), false, false); v = __uint_as_float(r[0]) + __uint_as_float(r[1]); }
    { auto r = __builtin_amdgcn_permlane32_swap(__float_as_uint(v), __float_as_uint(v), false, false); v = __uint_as_float(r[0]) + __uint_as_float(r[1]); }
    return v;
}
__device__ __forceinline__ float wave_max_fast(float v) {
    v = fmaxf(v, dppf<0xB1>(v)); v = fmaxf(v, dppf<0x4E>(v)); v = fmaxf(v, dppf<0x141>(v)); v = fmaxf(v, dppf<0x140>(v));
    { auto r = __builtin_amdgcn_permlane16_swap(__float_as_uint(v), __float_as_uint(v), false, false); v = fmaxf(__uint_as_float(r[0]), __uint_as_float(r[1])); }
    { auto r = __builtin_amdgcn_permlane32_swap(__float_as_uint(v), __float_as_uint(v), false, false); v = fmaxf(__uint_as_float(r[0]), __uint_as_float(r[1])); }
    return v;
}
__device__ __forceinline__ float wave_max(float v) {
#pragma unroll
    for (int o = 1; o < 64; o <<= 1) v = fmaxf(v, __shfl_xor(v, o));
    return v;
}
__device__ __forceinline__ unsigned q8pack(f32x4 v, float inv, int bias) {
    int a = __float2int_rn(v[0] * inv), b = __float2int_rn(v[1] * inv), c = __float2int_rn(v[2] * inv), d = __float2int_rn(v[3] * inv);
    a = min(127, max(-127, a)) + bias; b = min(127, max(-127, b)) + bias; c = min(127, max(-127, c)) + bias; d = min(127, max(-127, d)) + bias;
    return (unsigned)(a & 0xff) | ((unsigned)(b & 0xff) << 8) | ((unsigned)(c & 0xff) << 16) | ((unsigned)(d & 0xff) << 24);
}
template <bool SLICED> __device__ __forceinline__ void quant_row(const float* src, unsigned* dst, float* scale, int bias, int lane, int row) {
    f32x4 v[4]; float m = 0.f;
#pragma unroll
    for (int j = 0; j < 4; ++j) { v[j] = ((const f32x4*)src)[lane + 64 * j]; m = fmaxf(m, fmaxf(fmaxf(fabsf(v[j][0]), fabsf(v[j][1])), fmaxf(fabsf(v[j][2]), fabsf(v[j][3])))); }
    m = fmaxf(wave_max(m), 1e-30f); const float inv = 127.f / m;
#pragma unroll
    for (int j = 0; j < 4; ++j) { if (SLICED) dst[(size_t)(2 * j + (lane >> 5)) * (NEXP * 32) + (size_t)row * 32 + (lane & 31)] = q8pack(v[j], inv, bias); else { const int d_ = lane + 64 * j; dst[((size_t)(pe_slice(row) * 32 + (d_ >> 3)) * 2048 + pe_local((unsigned)row)) * 8 + (d_ & 7)] = q8pack(v[j], inv, bias); } }
    if (lane == 0) *scale = m * (1.f / 127.f);
}
template <bool QPAD = false> __device__ __forceinline__ void transpose_item(const float* W, int K, int N, int Npad, const float* kscale, bf16_t* WT, LAS float* scr, int item, int lane) {
    const int nblk = Npad / 32, kb = item / nblk, nb = item % nblk, k0 = 64 * kb, n0 = 32 * nb;
    const int d0 = QPAD ? (nb / 6) * 256 + (nb % 6) * 32 : n0;
#pragma unroll 8
    for (int i = 0; i < 32; ++i) { const int kk = 2 * i + (lane >> 5); const int n = n0 + (lane & 31);
        float v = (n < N) ? W[(size_t)(k0 + kk) * N + n] : 0.f; if (kscale) v *= kscale[k0 + kk]; scr[kk * 33 + (lane & 31)] = v; }
    asm volatile("s_waitcnt lgkmcnt(0)" ::: "memory");
    const int c = lane & 7;
#pragma unroll
    for (int j = 0; j < 4; ++j) { const int n = (lane >> 3) + 8 * j; const LAS float* s = scr + (8 * c) * 33 + n;
        u32x4 o; o.x = cvt_pk_bf16(s[0 * 33], s[1 * 33]); o.y = cvt_pk_bf16(s[2 * 33], s[3 * 33]); o.z = cvt_pk_bf16(s[4 * 33], s[5 * 33]); o.w = cvt_pk_bf16(s[6 * 33], s[7 * 33]);
        *(u32x4*)(WT + (size_t)(d0 + n) * K + k0 + 8 * c) = o; }
    asm volatile("s_waitcnt lgkmcnt(0)" ::: "memory");
}

__device__ __forceinline__ void phase_prep(const Params& p, LAS unsigned char* lds, const int tidx) {
    const int tid = tidx, lane = tid & 63, wave = tid >> 6;
    const int gw = blockIdx.x * NWAVES + wave, NGW = gridDim.x * NWAVES;
    LAS float* scr = (LAS float*)(lds + wave * 8704);
    unsigned char* ws = p.ws;
    constexpr int I_IN = (D / 64) * (INCP / 32), I_UQ = (256 / 64) * (768 / 32), I_UKV = (128 / 64) * (1024 / 32), I_OUT = (D / 64) * (D / 32), I_PQ = (D / 64) * (2048 / 32);
    constexpr int NITEMS = I_IN + I_UQ + I_UKV + I_OUT + I_PQ;
    if (blockIdx.x < 96) {
      LAS float* part = (LAS float*)(lds + 8 * 8704);
      LAS float* sil = part + 8 * 9 * 64;
      for (int i = tid; i < 9 * D; i += NTHREADS) { const int q = i >> 10, k = i & 1023; sil[i] = siluf(q < 8 ? p.c[q * D + k] : p.c_ctx[k]); }
      __syncthreads();
      for (int cgp = blockIdx.x; cgp < 96; cgp += gridDim.x) {
        const int col = cgp * 64 + lane;
        float acc[9];
#pragma unroll
        for (int q = 0; q < 9; ++q) acc[q] = 0.f;
#pragma unroll 8
        for (int kk = 0; kk < 128; ++kk) { const int k = wave * 128 + kk; const float w = p.w_ada[(size_t)k * NMOD + col];
#pragma unroll
            for (int q = 0; q < 9; ++q) acc[q] += sil[q * D + k] * w; }
        __syncthreads();
#pragma unroll
        for (int q = 0; q < 9; ++q) part[(wave * 9 + q) * 64 + lane] = acc[q];
        __syncthreads();
        float* mod = (float*)(ws + WS_MOD);
        for (int o = tid; o < 9 * 64; o += NTHREADS) { const int q = o >> 6, cl = o & 63; float s = p.b_ada[cgp * 64 + cl];
#pragma unroll
            for (int w8 = 0; w8 < 8; ++w8) s += part[(w8 * 9 + q) * 64 + cl];
            mod[q * NMOD + cgp * 64 + cl] = s; }
      } }
    for (int it = gw; it < NITEMS; it += NGW) {
        int r = it;
        if (r < I_IN) { transpose_item(p.w_in, D, INC, INCP, nullptr, (bf16_t*)(ws + WS_WIN), scr, r, lane); continue; } r -= I_IN;
        if (r < I_UQ) { transpose_item<true>(p.w_uq, 256, 768, 768, p.g_cq, (bf16_t*)(ws + WS_WUQ), scr, r, lane); continue; } r -= I_UQ;
        if (r < I_UKV) { transpose_item(p.w_ukv, 128, 1024, 1024, p.g_ckv, (bf16_t*)(ws + WS_WUKV), scr, r, lane); continue; } r -= I_UKV;
        if (r < I_OUT) { transpose_item(p.w_out, D, D, D, nullptr, (bf16_t*)(ws + WS_WOUT), scr, r, lane); continue; } r -= I_OUT;
        transpose_item(p.w_pq, D, 2048, 2048, nullptr, (bf16_t*)(ws + WS_WPQ), scr, r, lane);
    }
    const int gt = blockIdx.x * NTHREADS + tid, NGT = gridDim.x * NTHREADS;
    { bf16_t* wq = (bf16_t*)(ws + WS_WUQ);
      for (int i = gt; i < 4 * 64 * 256 / 8; i += NGT) { const int hd = i / (64 * 32), rem = i % (64 * 32); *(u32x4*)(wq + ((size_t)hd * 256 + 192) * 256 + (size_t)rem * 8) = (u32x4){0u, 0u, 0u, 0u}; } }
    { bf16_t* skb = (bf16_t*)(ws + WS_SKB);
      for (int i = gt; i < PH * 2 * NKEYS * 128 / 4; i += NGT) { const f32x4 v = ((const f32x4*)p.sub_keys)[i]; u32x2 o; o.x = cvt_pk_bf16(v[0], v[1]); o.y = cvt_pk_bf16(v[2], v[3]); ((u32x2*)skb)[i] = o; } }
    { float* rt = (float*)(ws + WS_ROPE);
      for (int i = gt; i < 64 * 16; i += NGT) { const int pos = i >> 4, j = i & 15; const float inv = powf(10000.f, -(float)j * (2.0f / 32.0f)); const float ang = (float)pos * inv;
          rt[2 * i] = cosf(ang); rt[2 * i + 1] = sinf(ang); } }
}

__device__ __forceinline__ void quant_experts(const Params& p, int vb, int nvb, const int tidx) {
    const int lane = tidx & 63, wave = tidx >> 6; unsigned char* ws = p.ws;
    unsigned* eu8 = (unsigned*)(ws + WS_EU8); unsigned* ev8 = (unsigned*)(ws + WS_EV8); float* su = (float*)(ws + WS_SU); float* sv = (float*)(ws + WS_SV);
    for (int r = vb * NWAVES + wave; r < 2 * NEXP; r += nvb * NWAVES) {
        if (r < NEXP) quant_row<false>(p.expert_u + (size_t)r * D, eu8, su + r, 0, lane, r);
        else { const int e = r - NEXP; quant_row<true>(p.expert_v + (size_t)e * D, ev8, sv + e, 0, lane, e); } }
}
__device__ __forceinline__ void norm_mod_row(const float* src, const float* g, const float* sh, const float* sc, bf16_t* dst, int lane) {
    f32x4 v[4]; float s = 0.f;
#pragma unroll
    for (int j = 0; j < 4; ++j) { v[j] = ((const f32x4*)src)[lane + 64 * j]; s += (v[j][0] * v[j][0] + v[j][1] * v[j][1]) + (v[j][2] * v[j][2] + v[j][3] * v[j][3]); }
    const float rstd = rsqrtf(wave_sum(s) * (1.f / D) + EPS);
#pragma unroll
    for (int j = 0; j < 4; ++j) { const int i4 = lane + 64 * j; const f32x4 gg = ((const f32x4*)g)[i4], s1 = ((const f32x4*)sc)[i4], h1 = ((const f32x4*)sh)[i4];
        const f32x4 o = v[j] * rstd * gg * (s1 + 1.f) + h1; u32x2 w; w.x = cvt_pk_bf16(o[0], o[1]); w.y = cvt_pk_bf16(o[2], o[3]); ((u32x2*)dst)[i4] = w; }
}
__device__ __forceinline__ void phase_hnorm(const Params& p, const int tidx) {
    const int lane = tidx & 63, wave = tidx >> 6;
    const int gw = blockIdx.x * NWAVES + wave, NGW = gridDim.x * NWAVES;
    const float* mod = (const float*)(p.ws + WS_MOD); bf16_t* hb = (bf16_t*)(p.ws + WS_HB);
    f32x4 na[4] = {}, nb[4] = {};
    auto srcof = [&](int row) { return row < NLAT ? p.x + (size_t)row * D : p.ctx + (size_t)(row - NLAT) * D; };
    auto fetch = [&](f32x4 (&d)[4], int row) { if (row < NTOK) { const float* s_ = srcof(row);
#pragma unroll
        for (int j = 0; j < 4; ++j) d[j] = ((const f32x4*)s_)[lane + 64 * j]; } };
    auto finish = [&](const f32x4 (&v)[4], int row) {
        const int mr = row < NLAT ? row / T : 8; const float* sh = mod + (size_t)mr * NMOD, * sc = sh + D; bf16_t* dst = hb + (size_t)row * D;
        float s = 0.f;
#pragma unroll
        for (int j = 0; j < 4; ++j) s += (v[j][0] * v[j][0] + v[j][1] * v[j][1]) + (v[j][2] * v[j][2] + v[j][3] * v[j][3]);
        const float rstd = rsqrtf(wave_sum_fast(s) * (1.f / D) + EPS);
#pragma unroll
        for (int j = 0; j < 4; ++j) { const int i4 = lane + 64 * j; const f32x4 gg = ((const f32x4*)p.g_norm1)[i4], s1 = ((const f32x4*)sc)[i4], h1 = ((const f32x4*)sh)[i4];
            const f32x4 o = v[j] * rstd * gg * (s1 + 1.f) + h1; u32x2 w; w.x = cvt_pk_bf16(o[0], o[1]); w.y = cvt_pk_bf16(o[2], o[3]); ((u32x2*)dst)[i4] = w; } };
    fetch(na, gw); fetch(nb, gw + NGW);
    for (int row = gw; row < NTOK; row += 2 * NGW) {
        f32x4 ca[4];
#pragma unroll
        for (int j = 0; j < 4; ++j) ca[j] = na[j];
        fetch(na, row + 2 * NGW);
        finish(ca, row);
        if (row + NGW < NTOK) {
#pragma unroll
            for (int j = 0; j < 4; ++j) ca[j] = nb[j];
            fetch(nb, row + 3 * NGW);
            finish(ca, row + NGW);
        }
    }
}

__device__ __forceinline__ int ml_row0(int b, int blk) { return blk == 0 ? NLAT + b * TC : b * T + (blk - 1) * MCH; }
__device__ __forceinline__ void conv_silu8(const bf16_t* cols, const float* convw, int row, int seg_lo, int seg_hi, int ch0, float (&o)[8]) {
    const u32x4 z = {0u, 0u, 0u, 0u};
    const u32x4 a = (row - 1 >= seg_lo) ? *(const u32x4*)(cols + (size_t)(row - 1) * INCP + C_MQ + ch0) : z;
    const u32x4 b = *(const u32x4*)(cols + (size_t)row * INCP + C_MQ + ch0);
    const u32x4 c = (row + 1 < seg_hi) ? *(const u32x4*)(cols + (size_t)(row + 1) * INCP + C_MQ + ch0) : z;
#pragma unroll
    for (int i = 0; i < 4; ++i) {
        const float w0a = convw[0 * 512 + ch0 + 2 * i], w1a = convw[1 * 512 + ch0 + 2 * i], w2a = convw[2 * 512 + ch0 + 2 * i];
        const float w0b = convw[0 * 512 + ch0 + 2 * i + 1], w1b = convw[1 * 512 + ch0 + 2 * i + 1], w2b = convw[2 * 512 + ch0 + 2 * i + 1];
        o[2 * i] = siluf(w0a * bf_lo(a[i]) + w1a * bf_lo(b[i]) + w2a * bf_lo(c[i]));
        o[2 * i + 1] = siluf(w0b * bf_hi(a[i]) + w1b * bf_hi(b[i]) + w2b * bf_hi(c[i]));
    }
}
__device__ __forceinline__ float scan_sum256(LAS float* sc, float v, int tid) {
    const int i = tid & 255; __syncthreads(); sc[tid] = v; __syncthreads();
#pragma unroll
    for (int off = 1; off < 256; off <<= 1) { float t = sc[tid]; if (i >= off) t += sc[tid - off]; __syncthreads(); sc[tid] = t; __syncthreads(); }
    return sc[tid];
}
__device__ __forceinline__ float scan_max256(LAS float* sc, float v, int tid) {
    const int i = tid & 255; __syncthreads(); sc[tid] = v; __syncthreads();
#pragma unroll
    for (int off = 1; off < 256; off <<= 1) { float t = sc[tid]; if (i >= off) t = fmaxf(t, sc[tid - off]); __syncthreads(); sc[tid] = t; __syncthreads(); }
    return sc[tid];
}

constexpr int VT_LD = 264;
__device__ __forceinline__ void ml_summary_unit(const Params& p, LAS unsigned char* lds, int unit, const int tidx) {
    const int tid = tidx, lane = tid & 63, wave = tid >> 6;
    const int blk = unit % 17, h = (unit / 17) % MH, b = unit / (17 * MH);
    const int row0 = ml_row0(b, blk), seg_lo = blk == 0 ? NLAT + b * TC : b * T, seg_hi = blk == 0 ? seg_lo + TC : seg_lo + T;
    const bf16_t* cols = (const bf16_t*)(p.ws + WS_COLS); const float* gates = (const float*)(p.ws + WS_GATES);
    LAS bf16_t* vT = (LAS bf16_t*)lds;
    LAS bf16_t* kfT = vT + 128 * VT_LD;
    LAS bf16_t* kbT = kfT + 64 * VT_LD;
    LAS float* sc = (LAS float*)(kbT + 64 * VT_LD);
    LAS float* wgt = sc + 512;
    LAS float* red = wgt + 512;
    __syncthreads();
    const int d = tid >> 8, i = tid & 255, tau = d ? 255 - i : i;
    const float graw_i = gates[(size_t)(row0 + tau) * 16 + d * 4 + h], graw_f = gates[(size_t)(row0 + tau) * 16 + 8 + d * 4 + h];
    const float ig = graw_i + p.b_igate[d * 4 + h], lf = logsigmoidf_(graw_f + p.b_fgate[d * 4 + h]);
    const float cum = scan_sum256(sc, lf, tid);
    const float F = sc[d * 256 + 255];
    const float a = (F - cum) + ig;
    const float mloc = scan_max256(sc, a, tid);
    const float mx = sc[d * 256 + 255];
    (void)mloc;
    wgt[d * 256 + tau] = __expf(a - mx);
    if (i == 0) { float* ms = (float*)(p.ws + WS_MSCAL) + ((((size_t)d * NB + b) * MH + h) * 17 + blk) * 2; ms[0] = F; ms[1] = mx; }
    __syncthreads();
    { const int t = tid & 255, hf = tid >> 8; const int row = row0 + t;
      const float wf = wgt[t], wb = wgt[256 + t];
#pragma unroll 2
      for (int c8 = 0; c8 < 8; ++c8) { const int ch = 64 * hf + 8 * c8; const u32x4 v = *(const u32x4*)(cols + (size_t)row * INCP + C_MV + h * MDV + ch);
#pragma unroll
          for (int q = 0; q < 4; ++q) { vT[(ch + 2 * q) * VT_LD + t] = (bf16_t)(v[q] & 0xffffu); vT[(ch + 2 * q + 1) * VT_LD + t] = (bf16_t)(v[q] >> 16); } }
#pragma unroll 1
      for (int c8 = 0; c8 < 4; ++c8) { const int ch = 32 * hf + 8 * c8; float kv[8]; conv_silu8(cols, p.conv_qk, row, seg_lo, seg_hi, 256 + h * MDK + ch, kv);
#pragma unroll
          for (int q = 0; q < 8; ++q) { kfT[(ch + q) * VT_LD + t] = f2bf(kv[q] * wf); kbT[(ch + q) * VT_LD + t] = f2bf(kv[q] * wb); } }
    }
    __syncthreads();
    { const int dvb = wave & 3, dkb = wave >> 2, r = lane & 31, hh = lane >> 5;
      f32x16 accf = {}, accb = {};
#pragma unroll 2
      for (int ks = 0; ks < 16; ++ks) { const int t0 = 16 * ks + 8 * hh;
          const bf16x8 av = *(const LAS bf16x8*)(vT + (dvb * 32 + r) * VT_LD + t0);
          const bf16x8 bf = *(const LAS bf16x8*)(kfT + (dkb * 32 + r) * VT_LD + t0);
          const bf16x8 bb = *(const LAS bf16x8*)(kbT + (dkb * 32 + r) * VT_LD + t0);
          accf = __builtin_amdgcn_mfma_f32_32x32x16_bf16(av, bf, accf, 0, 0, 0);
          accb = __builtin_amdgcn_mfma_f32_32x32x16_bf16(av, bb, accb, 0, 0, 0); }
      float* Uf = (float*)(p.ws + WS_U) + ((((size_t)0 * NB + b) * MH + h) * 17 + blk) * (MDV * MDK);
      float* Ub = (float*)(p.ws + WS_U) + ((((size_t)1 * NB + b) * MH + h) * 17 + blk) * (MDV * MDK);
#pragma unroll
      for (int q = 0; q < 16; ++q) { const int dv = dvb * 32 + crow(q, hh), dk = dkb * 32 + r; Uf[dv * MDK + dk] = accf[q]; Ub[dv * MDK + dk] = accb[q]; }
    }
    if (tid < 128) { const int dd = tid >> 6, dk = tid & 63; const LAS bf16_t* rowp = (dd ? kbT : kfT) + dk * VT_LD; float s = 0.f;
        for (int t = 0; t < 256; ++t) s += bf2f(rowp[t]);
        ((float*)(p.ws + WS_NL))[((((size_t)dd * NB + b) * MH + h) * 17 + blk) * MDK + dk] = s; }
    (void)red;
}

__device__ __forceinline__ int ml_blkof(int d, int j) { return d == 0 ? j : (j == 0 ? 0 : 17 - j); }
__device__ __forceinline__ void phase_ml_scan(const Params& p, const int tidx) {
    const int gt = blockIdx.x * NTHREADS + tidx, NGT = gridDim.x * NTHREADS;
    const float* ms = (const float*)(p.ws + WS_MSCAL); const float* U = (const float*)(p.ws + WS_U); const float* NL = (const float*)(p.ws + WS_NL);
    bf16_t* cst = (bf16_t*)(p.ws + WS_CST); float* nst = (float*)(p.ws + WS_NST); float* mst = (float*)(p.ws + WS_MST);
    constexpr int EPS_ = MDV * MDK + MDK;
    for (int e = gt; e < 64 * EPS_; e += NGT) {
        const int s = e / EPS_, el = e % EPS_;
        const int d = s / (NB * MH);
        float u[16];
#pragma unroll
        for (int j = 0; j < 16; ++j) { const int blk = ml_blkof(d, j); u[j] = (el < MDV * MDK) ? U[((size_t)s * 17 + blk) * (MDV * MDK) + el] : NL[((size_t)s * 17 + blk) * MDK + (el - MDV * MDK)]; }
        float m = 0.f, C = 0.f;
#pragma unroll
        for (int j = 0; j < 16; ++j) { const int blk = ml_blkof(d, j); const float F = ms[((size_t)s * 17 + blk) * 2], ml = ms[((size_t)s * 17 + blk) * 2 + 1];
            const float mn = fmaxf(F + m, ml); C = __expf(F + m - mn) * C + __expf(ml - mn) * u[j]; m = mn;
            if (el < MDV * MDK) cst[((size_t)s * 16 + j) * (MDV * MDK) + el] = f2bf(C); else nst[((size_t)s * 16 + j) * MDK + (el - MDV * MDK)] = C;
            if (el == 0) mst[(size_t)s * 16 + j] = m; }
    }
}

constexpr int QK_LD = 72;
__device__ __forceinline__ void ml_output_unit(const Params& p, LAS unsigned char* lds, int unit, const int tidx) {
    const int tid = tidx, lane = tid & 63, wave = tid >> 6;
    const int ib = unit % NBLK, h = (unit / NBLK) % MH, b = unit / (NBLK * MH);
    const int blk = ib + 1, row0 = ml_row0(b, blk), seg_lo = b * T, seg_hi = seg_lo + T;
    const bf16_t* cols = (const bf16_t*)(p.ws + WS_COLS); const float* gates = (const float*)(p.ws + WS_GATES);
    LAS bf16_t* vT = (LAS bf16_t*)lds;
    LAS bf16_t* qs = vT + 128 * VT_LD;
    LAS bf16_t* ks_ = qs + 256 * QK_LD;
    LAS float* sc = (LAS float*)(ks_ + 256 * QK_LD);
    LAS float* alpha = sc + 512;
    LAS float* beta = alpha + 512, *sint = beta + 512, *flr = sint + 512;
    LAS float* nv = flr + 512;
    __syncthreads();
    {
        const int d = tid >> 8, i = tid & 255, tau = d ? 255 - i : i;
        const float graw_i = gates[(size_t)(row0 + tau) * 16 + d * 4 + h], graw_f = gates[(size_t)(row0 + tau) * 16 + 8 + d * 4 + h];
        const float ig = graw_i + p.b_igate[d * 4 + h], lf = logsigmoidf_(graw_f + p.b_fgate[d * 4 + h]);
        const float cum = scan_sum256(sc, lf, tid);
        const float bt = ig - cum;
        const float pm = scan_max256(sc, bt, tid);
        const int sidx = d == 0 ? ib : 15 - ib;
        const int s = (d * NB + b) * MH + h;
        const float mprev = ((const float*)(p.ws + WS_MST))[(size_t)s * 16 + sidx];
        const float mt = fmaxf(cum + mprev, cum + pm);
        alpha[d * 256 + tau] = cum - mt; beta[d * 256 + tau] = bt; sint[d * 256 + tau] = __expf(cum + mprev - mt); flr[d * 256 + tau] = __expf(-mt);
        if (i < 64) nv[d * 64 + i] = ((const float*)(p.ws + WS_NST))[((size_t)s * 16 + sidx) * MDK + i];
    }
    {
        const int t = tid & 255, hf = tid >> 8; const int row = row0 + t;
#pragma unroll
        for (int c8 = 0; c8 < 8; ++c8) { const int ch = 64 * hf + 8 * c8; const u32x4 v = *(const u32x4*)(cols + (size_t)row * INCP + C_MV + h * MDV + ch);
#pragma unroll
            for (int q = 0; q < 4; ++q) { vT[(ch + 2 * q) * VT_LD + t] = (bf16_t)(v[q] & 0xffffu); vT[(ch + 2 * q + 1) * VT_LD + t] = (bf16_t)(v[q] >> 16); } }
#pragma unroll
        for (int c8 = 0; c8 < 4; ++c8) { const int ch = 32 * hf + 8 * c8; float kv[8], qv[8];
            conv_silu8(cols, p.conv_qk, row, seg_lo, seg_hi, 256 + h * MDK + ch, kv); conv_silu8(cols, p.conv_qk, row, seg_lo, seg_hi, h * MDK + ch, qv);
            u32x4 kw, qw;
#pragma unroll
            for (int q = 0; q < 4; ++q) { kw[q] = cvt_pk_bf16(kv[2 * q], kv[2 * q + 1]); qw[q] = cvt_pk_bf16(qv[2 * q] * 0.125f, qv[2 * q + 1] * 0.125f); }
            *(LAS u32x4*)(ks_ + t * QK_LD + ch) = kw; *(LAS u32x4*)(qs + t * QK_LD + ch) = qw; }
    }
    __syncthreads();
    const int c = lane & 31, hh = lane >> 5, tq = 32 * wave + c;
    bf16x8 qf[4];
#pragma unroll
    for (int ks = 0; ks < 4; ++ks) qf[ks] = *(const LAS bf16x8*)(qs + tq * QK_LD + 16 * ks + 8 * hh);
    f32x16 hsum[4];
#pragma unroll
    for (int dvb = 0; dvb < 4; ++dvb) hsum[dvb] = (f32x16){};
#pragma unroll 1
    for (int d = 0; d < 2; ++d) {
        const int sidx = d == 0 ? ib : 15 - ib; const int s = (d * NB + b) * MH + h;
        const bf16_t* Cst = (const bf16_t*)(p.ws + WS_CST) + ((size_t)s * 16 + sidx) * (MDV * MDK);
        const float al = alpha[d * 256 + tq], si = sint[d * 256 + tq], fl = flr[d * 256 + tq];
        f32x16 acc[4];
#pragma unroll
        for (int dvb = 0; dvb < 4; ++dvb) { f32x16 t = {};
#pragma unroll
            for (int ks = 0; ks < 4; ++ks) { const bf16x8 af = *(const bf16x8*)(Cst + (size_t)(dvb * 32 + c) * MDK + 16 * ks + 8 * hh); t = __builtin_amdgcn_mfma_f32_32x32x16_bf16(af, qf[ks], t, 0, 0, 0); }
            acc[dvb] = t * si; if (dvb & 1) asm volatile("" ::: "memory"); }
        float nq = 0.f;
#pragma unroll
        for (int j = 0; j < 32; ++j) nq += nv[d * 64 + 32 * hh + j] * bf2f(qs[tq * QK_LD + 32 * hh + j]);
        nq += __shfl_xor(nq, 32);
        float den = 0.f;
        const int sb_lo = d == 0 ? 0 : wave, sb_hi = d == 0 ? wave : 7;
#pragma unroll 1
        for (int sb = sb_lo; sb <= sb_hi; ++sb) {
            f32x16 st = {};
#pragma unroll
            for (int ks = 0; ks < 4; ++ks) { const bf16x8 af = *(const LAS bf16x8*)(ks_ + (32 * sb + c) * QK_LD + 16 * ks + 8 * hh); st = __builtin_amdgcn_mfma_f32_32x32x16_bf16(af, qf[ks], st, 0, 0, 0); }
#pragma unroll
            for (int q = 0; q < 16; ++q) { const int sg = 32 * sb + crow(q, hh); const float w = __expf(al + beta[d * 256 + sg]) * st[q];
                const bool ok = d == 0 ? (sg <= tq) : (sg >= tq); st[q] = ok ? w : 0.f; den += st[q]; }
            bf16x8 wf[2];
#pragma unroll
            for (int s2 = 0; s2 < 2; ++s2) { u32x4 w; w.x = cvt_pk_bf16(st[8 * s2 + 0], st[8 * s2 + 1]); w.y = cvt_pk_bf16(st[8 * s2 + 2], st[8 * s2 + 3]); w.z = cvt_pk_bf16(st[8 * s2 + 4], st[8 * s2 + 5]); w.w = cvt_pk_bf16(st[8 * s2 + 6], st[8 * s2 + 7]);
                wf[s2] = __builtin_bit_cast(bf16x8, w); }
#pragma unroll
            for (int dvb = 0; dvb < 4; ++dvb)
#pragma unroll
                for (int s2 = 0; s2 < 2; ++s2) { const LAS bf16_t* vp = vT + (dvb * 32 + c) * VT_LD + 32 * sb + 16 * s2 + 4 * hh;
                    const s16x4 lo = *(const LAS s16x4*)vp, hi = *(const LAS s16x4*)(vp + 8);
                    const bf16x8 af = {lo[0], lo[1], lo[2], lo[3], hi[0], hi[1], hi[2], hi[3]};
                    acc[dvb] = __builtin_amdgcn_mfma_f32_32x32x16_bf16(af, wf[s2], acc[dvb], 0, 0, 0); }
        }
        den += __shfl_xor(den, 32);
        const float dt = den + si * nq; const float inv = 1.f / fmaxf(fabsf(dt), fl);
#pragma unroll
        for (int dvb = 0; dvb < 4; ++dvb) hsum[dvb] += acc[dvb] * inv;
    }
    float ss = 0.f;
#pragma unroll
    for (int dvb = 0; dvb < 4; ++dvb)
#pragma unroll
        for (int q = 0; q < 16; ++q) ss += hsum[dvb][q] * hsum[dvb][q];
    ss += __shfl_xor(ss, 32);
    const float rstd = rsqrtf(ss * (1.f / MDV) + EPS);
    const int row = row0 + tq; bf16_t* mix = (bf16_t*)(p.ws + WS_MIX) + (size_t)row * D + 512 + h * MDV;
    const bf16_t* orow = cols + (size_t)row * INCP + C_MO + h * MDV;
#pragma unroll
    for (int dvb = 0; dvb < 4; ++dvb)
#pragma unroll
        for (int q4 = 0; q4 < 4; ++q4) { const int dv = dvb * 32 + 8 * q4 + 4 * hh; const u32x2 ow = *(const u32x2*)(orow + dv); const f32x4 gg = *(const f32x4*)(p.g_mlstm + h * MDV + dv);
            const float o0 = sigmoidf_(bf_lo(ow.x)) * hsum[dvb][4 * q4 + 0] * rstd * gg[0], o1 = sigmoidf_(bf_hi(ow.x)) * hsum[dvb][4 * q4 + 1] * rstd * gg[1];
            const float o2 = sigmoidf_(bf_lo(ow.y)) * hsum[dvb][4 * q4 + 2] * rstd * gg[2], o3 = sigmoidf_(bf_hi(ow.y)) * hsum[dvb][4 * q4 + 3] * rstd * gg[3];
            u32x2 w; w.x = cvt_pk_bf16(o0, o1); w.y = cvt_pk_bf16(o2, o3); *(u32x2*)(mix + dv) = w; }
}

__device__ __forceinline__ void phase_mla_fin(const Params& p, LAS unsigned char* lds, const int tidx) {
    const int lane = tidx & 63, wave = tidx >> 6;
    const int gw = blockIdx.x * NWAVES + wave, NGW = gridDim.x * NWAVES;
    LAS float* sq = (LAS float*)(lds + wave * 8192);
    const bf16_t* cols = (const bf16_t*)(p.ws + WS_COLS); const bf16_t* qraw = (const bf16_t*)(p.ws + WS_QRAW); const bf16_t* kvraw = (const bf16_t*)(p.ws + WS_KVRAW);
    const float* ssq = (const float*)(p.ws + WS_SSQ); const float* rt = (const float*)(p.ws + WS_ROPE);
    bf16_t* Q = (bf16_t*)(p.ws + WS_Q); bf16_t* Kb = (bf16_t*)(p.ws + WS_K); bf16_t* VT = (bf16_t*)(p.ws + WS_VT);
#pragma unroll 2
    for (int row = gw; row < NLAT; row += NGW) {
        const int b = row / T; const int t = row % T; const int prow = t >> 6, pcol = t & 63;
        const f32x4 sq4 = *(const f32x4*)(ssq + (size_t)row * 8);
        const float rq = rsqrtf(((sq4[0] + sq4[1]) + (sq4[2] + sq4[3])) * (1.f / 256.f) + EPS);
        {
            const bf16_t* qp = qraw + (size_t)row * 768 + 12 * lane;
            const u32x2 a0 = *(const u32x2*)qp, a1 = *(const u32x2*)(qp + 4), a2 = *(const u32x2*)(qp + 8);
            float v[12] = {bf_lo(a0.x), bf_hi(a0.x), bf_lo(a0.y), bf_hi(a0.y), bf_lo(a1.x), bf_hi(a1.x), bf_lo(a1.y), bf_hi(a1.y), bf_lo(a2.x), bf_hi(a2.x), bf_lo(a2.y), bf_hi(a2.y)};
            float s = 0.f;
#pragma unroll
            for (int q = 0; q < 12; ++q) { v[q] *= rq; s += v[q] * v[q]; }
            s = row_sum_f(s);
            const float rh = rsqrtf(s * (1.f / 192.f) + EPS);
            const int hd = lane >> 4, off = (lane & 15) * 12;
#pragma unroll
            for (int q = 0; q < 12; ++q) sq[12 * lane + q] = v[q] * rh * p.g_qn[off + q];
            asm volatile("s_waitcnt lgkmcnt(0)" ::: "memory");
            bf16_t* qo = Q + (((size_t)b * NH + hd) * T + t) * DQK + off;
            float o[12];
#pragma unroll
            for (int q = 0; q < 12; ++q) { const int dd = off + q; float val = sq[12 * lane + q];
                if (dd >= 128) { const int j = dd - 128, part = j >> 5, jj = j & 31, fi = jj & 15; const bool second = jj >= 16; const int pos = part ? pcol : prow;
                    const float cs = rt[(pos * 16 + fi) * 2], sn = rt[(pos * 16 + fi) * 2 + 1];
                    const float pt = sq[hd * 192 + 128 + part * 32 + (jj ^ 16)];
                    val = second ? (val * cs + pt * sn) : (val * cs - pt * sn); }
                o[q] = val; }
            u32x2 w0, w1, w2; w0.x = cvt_pk_bf16(o[0], o[1]); w0.y = cvt_pk_bf16(o[2], o[3]); w1.x = cvt_pk_bf16(o[4], o[5]); w1.y = cvt_pk_bf16(o[6], o[7]); w2.x = cvt_pk_bf16(o[8], o[9]); w2.y = cvt_pk_bf16(o[10], o[11]);
            *(u32x2*)qo = w0; *(u32x2*)(qo + 4) = w1; *(u32x2*)(qo + 8) = w2;
            asm volatile("s_waitcnt lgkmcnt(0)" ::: "memory");
        }
    }
}

constexpr int AK_LD = 200;
constexpr int AV_LD = 68;
constexpr int A_KBYTES = 64 * AK_LD * 2, A_VBYTES = 128 * AV_LD * 2;
constexpr int AQ_LD = 72;
__device__ __forceinline__ void attn_unit(const Params& p, LAS unsigned char* lds, int unit, const int tidx) {
    const int tid = tidx, lane = tid & 63, wave = tid >> 6;
    const int qb = unit % (T / 256), h = (unit / (T / 256)) % NH, b = unit / ((T / 256) * NH);
    const bf16_t* Q = (const bf16_t*)(p.ws + WS_Q) + (((size_t)b * NH + h) * T + qb * 256) * DQK;
    const bf16_t* Kg = (const bf16_t*)(p.ws + WS_K) + ((size_t)b * NH + h) * NKEY * DQK;
    const bf16_t* Vg = (const bf16_t*)(p.ws + WS_VT) + ((size_t)b * NH + h) * NKEY * DV;
    const int c = lane & 31, hh = lane >> 5, tq = 32 * wave + c;
    constexpr float CS = 0.07216878364870322f * 1.4426950408889634f;
    bf16x8 qf[8];
#pragma unroll
    for (int ks = 0; ks < 8; ++ks) qf[ks] = *(const bf16x8*)(Q + (size_t)tq * DQK + 16 * ks + 8 * hh);
    LAS bf16_t* Qr = (LAS bf16_t*)(lds + 2 * (A_KBYTES + A_VBYTES));
    __syncthreads();
#pragma unroll
    for (int ks = 8; ks < 12; ++ks) *(LAS bf16x8*)(Qr + tq * AQ_LD + 16 * (ks - 8) + 8 * hh) = *(const bf16x8*)(Q + (size_t)tq * DQK + 16 * ks + 8 * hh);
    f32x16 o[4];
#pragma unroll
    for (int dvb = 0; dvb < 4; ++dvb) o[dvb] = (f32x16){};
    float m = -INFINITY, l = 0.f;
    u32x4 kreg[3], vreg[2];
    const unsigned kofs = (unsigned)tid * 16u, vofs = (unsigned)(tid & 63) * (unsigned)(DV * 2) + (unsigned)(tid >> 6) * 16u;
    unsigned klo[3];
#pragma unroll
    for (int i = 0; i < 3; ++i) { const int ch = tid + 512 * i; klo[i] = (unsigned)((ch / 24) * (AK_LD * 2) + (ch % 24) * 16); }
    const unsigned vlo = (unsigned)(tid >> 6) * 8u * (unsigned)(AV_LD * 2) + (unsigned)(tid & 63) * 2u;
    auto load_k = [&](int kt) { const char* kb = (const char*)Kg + (size_t)kt * (64 * DQK * 2);
#pragma unroll
        for (int i = 0; i < 3; ++i) kreg[i] = *(const u32x4*)(kb + kofs + i * 8192); };
    auto load_v = [&](int kt) { const char* vb = (const char*)Vg + (size_t)kt * (64 * DV * 2);
#pragma unroll
        for (int i = 0; i < 2; ++i) vreg[i] = *(const u32x4*)(vb + vofs + i * 128); };
    auto store_k = [&](int buf) { LAS unsigned char* Ks = lds + buf * A_KBYTES;
#pragma unroll
        for (int i = 0; i < 3; ++i) *(LAS u32x4*)(Ks + klo[i]) = kreg[i]; };
    auto store_v = [&](int buf) { LAS unsigned char* Vs = lds + 2 * A_KBYTES + buf * A_VBYTES;
#pragma unroll
        for (int i = 0; i < 2; ++i) { LAS bf16_t* dp = (LAS bf16_t*)(Vs + vlo + i * (64 * AV_LD * 2));
            dp[0 * AV_LD] = (bf16_t)(vreg[i].x & 0xffffu); dp[1 * AV_LD] = (bf16_t)(vreg[i].x >> 16); dp[2 * AV_LD] = (bf16_t)(vreg[i].y & 0xffffu); dp[3 * AV_LD] = (bf16_t)(vreg[i].y >> 16);
            dp[4 * AV_LD] = (bf16_t)(vreg[i].z & 0xffffu); dp[5 * AV_LD] = (bf16_t)(vreg[i].z >> 16); dp[6 * AV_LD] = (bf16_t)(vreg[i].w & 0xffffu); dp[7 * AV_LD] = (bf16_t)(vreg[i].w >> 16); } };
    constexpr int NT = NKEY / 64;
    f32x16 p0 = {}, p1 = {}; bf16x8 pf[4] = {};
#define AT_QK(kbuf) do { const LAS bf16_t* Ks = (const LAS bf16_t*)(lds + (kbuf) * A_KBYTES); p0 = (f32x16){}; p1 = (f32x16){}; \
        _Pragma("unroll") for (int ks = 0; ks < 12; ++ks) { \
            const bf16x8 a0 = *(const LAS bf16x8*)(Ks + c * AK_LD + 16 * ks + 8 * hh), a1 = *(const LAS bf16x8*)(Ks + (32 + c) * AK_LD + 16 * ks + 8 * hh); \
            const bf16x8 qv = ks < 8 ? qf[ks < 8 ? ks : 0] : *(const LAS bf16x8*)(Qr + tq * AQ_LD + 16 * (ks - 8) + 8 * hh); \
            p0 = __builtin_amdgcn_mfma_f32_32x32x16_bf16(a0, qv, p0, 0, 0, 0); p1 = __builtin_amdgcn_mfma_f32_32x32x16_bf16(a1, qv, p1, 0, 0, 0); } } while (0)
#define AT_SM() do { float mx = p0[0]; \
        _Pragma("unroll") for (int q = 1; q < 16; ++q) mx = fmaxf(mx, p0[q]); \
        _Pragma("unroll") for (int q = 0; q < 16; ++q) mx = fmaxf(mx, p1[q]); \
        { auto r_ = __builtin_amdgcn_permlane32_swap(__float_as_uint(mx), __float_as_uint(mx), false, false); mx = fmaxf(__uint_as_float(r_[0]), __uint_as_float(r_[1])); } \
        const float mxs = mx * CS; \
        if (!__all(mxs <= m + 8.0f)) { const float mn = fmaxf(m, mxs), al = __builtin_amdgcn_exp2f(m - mn); m = mn; l *= al; \
            _Pragma("unroll") for (int dvb = 0; dvb < 4; ++dvb) o[dvb] *= al; } \
        float ps = 0.f; \
        _Pragma("unroll") for (int q = 0; q < 16; ++q) { p0[q] = __builtin_amdgcn_exp2f(fmaf(p0[q], CS, -m)); p1[q] = __builtin_amdgcn_exp2f(fmaf(p1[q], CS, -m)); ps += p0[q] + p1[q]; } \
        { auto r_ = __builtin_amdgcn_permlane32_swap(__float_as_uint(ps), __float_as_uint(ps), false, false); ps = __uint_as_float(r_[0]) + __uint_as_float(r_[1]); } \
        l += ps; \
        _Pragma("unroll") for (int s2 = 0; s2 < 2; ++s2) { u32x4 w; \
            w.x = cvt_pk_bf16(p0[8 * s2 + 0], p0[8 * s2 + 1]); w.y = cvt_pk_bf16(p0[8 * s2 + 2], p0[8 * s2 + 3]); w.z = cvt_pk_bf16(p0[8 * s2 + 4], p0[8 * s2 + 5]); w.w = cvt_pk_bf16(p0[8 * s2 + 6], p0[8 * s2 + 7]); pf[s2] = __builtin_bit_cast(bf16x8, w); \
            w.x = cvt_pk_bf16(p1[8 * s2 + 0], p1[8 * s2 + 1]); w.y = cvt_pk_bf16(p1[8 * s2 + 2], p1[8 * s2 + 3]); w.z = cvt_pk_bf16(p1[8 * s2 + 4], p1[8 * s2 + 5]); w.w = cvt_pk_bf16(p1[8 * s2 + 6], p1[8 * s2 + 7]); pf[2 + s2] = __builtin_bit_cast(bf16x8, w); } } while (0)
#define AT_PV(vbuf) do { const LAS bf16_t* Vs = (const LAS bf16_t*)(lds + 2 * A_KBYTES + (vbuf) * A_VBYTES); \
        _Pragma("unroll") for (int dvb = 0; dvb < 4; ++dvb) _Pragma("unroll") for (int s4 = 0; s4 < 4; ++s4) { const LAS bf16_t* vp = Vs + (dvb * 32 + c) * AV_LD + 16 * s4 + 4 * hh; \
            const s16x4 lo = *(const LAS s16x4*)vp, hi = *(const LAS s16x4*)(vp + 8); const bf16x8 af = {lo[0], lo[1], lo[2], lo[3], hi[0], hi[1], hi[2], hi[3]}; \
            o[dvb] = __builtin_amdgcn_mfma_f32_32x32x16_bf16(af, pf[s4], o[dvb], 0, 0, 0); } } while (0)
    __syncthreads();
    load_k(0); store_k(0);
    const bool grpA = __builtin_amdgcn_readfirstlane(wave) < 4;
    if (grpA) {
#pragma unroll 1
        for (int j = 0; j <= NT; ++j) {
            __syncthreads();
            if (j + 1 < NT) load_k(j + 1);
            if (j < NT) load_v(j);
            if (j > 0) AT_PV((j - 1) & 1);
            if (j < NT) { AT_QK(j & 1); AT_SM(); }
            if (j + 1 < NT) store_k((j + 1) & 1);
            if (j < NT) store_v(j & 1);
        }
    } else {
#pragma unroll 1
        for (int j = 0; j <= NT; ++j) {
            __syncthreads();
            if (j + 1 < NT) load_k(j + 1);
            if (j < NT) load_v(j);
            if (j > 0) { AT_SM(); AT_PV((j - 1) & 1); }
            if (j < NT) AT_QK(j & 1);
            if (j + 1 < NT) store_k((j + 1) & 1);
            if (j < NT) store_v(j & 1);
        }
    }
#undef AT_QK
#undef AT_SM
#undef AT_PV
    const float inv = 1.f / l;
    bf16_t* mix = (bf16_t*)(p.ws + WS_MIX) + (size_t)(b * T + qb * 256 + tq) * D + h * DV;
#pragma unroll
    for (int dvb = 0; dvb < 4; ++dvb)
#pragma unroll
        for (int q4 = 0; q4 < 4; ++q4) { const int dv = dvb * 32 + 8 * q4 + 4 * hh; u32x2 w; w.x = cvt_pk_bf16(o[dvb][4 * q4] * inv, o[dvb][4 * q4 + 1] * inv); w.y = cvt_pk_bf16(o[dvb][4 * q4 + 2] * inv, o[dvb][4 * q4 + 3] * inv); *(u32x2*)(mix + dv) = w; }
}

__device__ __forceinline__ void phase_h2(const Params& p, const int tidx) {
    const int lane = tidx & 63, wave = tidx >> 6;
    const int gw = blockIdx.x * NWAVES + wave, NGW = gridDim.x * NWAVES;
    const float* mod = (const float*)(p.ws + WS_MOD); bf16_t* h2 = (bf16_t*)(p.ws + WS_H2);
    unsigned* h2q = (unsigned*)(p.ws + WS_H2Q); float* hs = (float*)(p.ws + WS_HS);
    f32x4 na[4] = {}, nb[4] = {};
    auto fetch = [&](f32x4 (&d)[4], int row) { if (row < NLAT) { const float* s_ = p.out + (size_t)row * D;
#pragma unroll
        for (int j = 0; j < 4; ++j) d[j] = ((const f32x4*)s_)[lane + 64 * j]; } };
    auto finish = [&](f32x4 (&v)[4], int row) {
        const int mr = row / T; const float* sh = mod + (size_t)mr * NMOD + 3 * D, * sc = mod + (size_t)mr * NMOD + 4 * D;
        float s = 0.f;
#pragma unroll
        for (int j = 0; j < 4; ++j) s += (v[j][0] * v[j][0] + v[j][1] * v[j][1]) + (v[j][2] * v[j][2] + v[j][3] * v[j][3]);
        const float rstd = rsqrtf(wave_sum_fast(s) * (1.f / D) + EPS); float m = 0.f;
#pragma unroll
        for (int j = 0; j < 4; ++j) { const int i4 = lane + 64 * j; const f32x4 gg = ((const f32x4*)p.g_norm2)[i4], s1 = ((const f32x4*)sc)[i4], h1 = ((const f32x4*)sh)[i4];
            v[j] = v[j] * rstd * gg * (s1 + 1.f) + h1; u32x2 w; w.x = cvt_pk_bf16(v[j][0], v[j][1]); w.y = cvt_pk_bf16(v[j][2], v[j][3]); ((u32x2*)(h2 + (size_t)row * D))[i4] = w;
            m = fmaxf(m, fmaxf(fmaxf(fabsf(v[j][0]), fabsf(v[j][1])), fmaxf(fabsf(v[j][2]), fabsf(v[j][3])))); }
        m = fmaxf(wave_max_fast(m), 1e-30f); const float inv = 127.f / m;
#pragma unroll
        for (int j = 0; j < 4; ++j) { const int d_ = lane + 64 * j; h2q[((size_t)(d_ >> 3) * NLAT + row) * 8 + (d_ & 7)] = q8pack(v[j], inv, 0); }
        if (lane == 0) hs[row] = m * (1.f / 127.f); };
    fetch(na, gw); fetch(nb, gw + NGW);
    for (int row = gw; row < NLAT; row += 2 * NGW) {
        f32x4 ca[4];
#pragma unroll
        for (int j = 0; j < 4; ++j) ca[j] = na[j];
        fetch(na, row + 2 * NGW);
        finish(ca, row);
        if (row + NGW < NLAT) {
#pragma unroll
            for (int j = 0; j < 4; ++j) ca[j] = nb[j];
            fetch(nb, row + 3 * NGW);
            finish(ca, row + NGW);
        }
    }
}

__device__ __forceinline__ unsigned ord_key(float v) { const unsigned u = __float_as_uint(v); return (u & 0x80000000u) ? ~u : (u | 0x80000000u); }
__device__ __forceinline__ float ord_val(unsigned k) { const unsigned u = (k & 0x80000000u) ? (k & 0x7fffffffu) : ~k; return __uint_as_float(u); }
__device__ __forceinline__ unsigned med3u(unsigned a, unsigned b, unsigned c) { const unsigned mx = a > b ? a : b, mn = a > b ? b : a; const unsigned t = mx < c ? mx : c; return mn > t ? mn : t; }
__device__ __forceinline__ void ins16(unsigned (&top)[16], unsigned x) {
    unsigned n[16];
    n[0] = top[0] > x ? top[0] : x;
#pragma unroll
    for (int i = 1; i < 16; ++i) n[i] = med3u(x, top[i - 1], top[i]);
#pragma unroll
    for (int i = 0; i < 16; ++i) top[i] = n[i];
}
__device__ __forceinline__ void peer_topk_unit(const Params& p, LAS unsigned char* lds, int unit, const int tidx) {
    const int lane = tidx & 63, h = tidx >> 6;
    const int c = lane & 31, hh = lane >> 5, tok = unit * 32 + c;
    const bf16_t* qp = (const bf16_t*)(p.ws + WS_QP) + (size_t)tok * 2048 + h * 256;
    const bf16_t* skb = (const bf16_t*)(p.ws + WS_SKB) + (size_t)h * 2 * NKEYS * 128;
    unsigned top[2][16];
    {
        unsigned cur[16], sav[16];
#pragma unroll
        for (int i = 0; i < 16; ++i) sav[i] = 0u;
        bf16x8 qf[8], afA[8], afB[8];
#define TK_LOADA(dst, pp_, kb_) do { _Pragma("unroll") for (int ks = 0; ks < 8; ++ks) dst[ks] = *(const bf16x8*)(skb + ((size_t)(pp_) * NKEYS + (kb_) * 32 + c) * 128 + 16 * ks + 8 * hh); } while (0)
#define TK_STAGE(af, kb_) do { f32x16 s; _Pragma("unroll") for (int q = 0; q < 16; ++q) s[q] = 64.f; \
        _Pragma("unroll") for (int ks = 0; ks < 8; ++ks) s = __builtin_amdgcn_mfma_f32_32x32x16_bf16(af[ks], qf[ks], s, 0, 0, 0); \
        _Pragma("unroll") for (int q = 0; q < 16; ++q) { const unsigned key = (__float_as_uint(fmaxf(s[q], 0.f)) & ~127u) | (unsigned)((kb_) * 32 + crow(q, hh)); ins16(cur, key); } } while (0)
#pragma unroll 1
        for (int pp = 0; pp < 2; ++pp) {
#pragma unroll
            for (int i = 0; i < 16; ++i) cur[i] = 0u;
#pragma unroll
            for (int ks = 0; ks < 8; ++ks) qf[ks] = *(const bf16x8*)(qp + pp * 128 + 16 * ks + 8 * hh);
            TK_LOADA(afA, pp, 0);
#pragma unroll 1
            for (int kb = 0; kb < 4; kb += 2) {
                TK_LOADA(afB, pp, kb + 1);
                TK_STAGE(afA, kb);
                if (kb + 2 < 4) TK_LOADA(afA, pp, kb + 2);
                TK_STAGE(afB, kb + 1);
            }
            unsigned oth[16];
#pragma unroll
            for (int i = 0; i < 16; ++i) { auto r_ = __builtin_amdgcn_permlane32_swap(cur[i], cur[i], false, false); oth[i] = hh ? r_[0] : r_[1]; }
#pragma unroll
            for (int i = 0; i < 16; ++i) ins16(cur, oth[i]);
            if (pp == 0) {
#pragma unroll
                for (int i = 0; i < 16; ++i) sav[i] = cur[i];
            }
        }
#undef TK_LOADA
#undef TK_STAGE
#pragma unroll
        for (int i = 0; i < 16; ++i) { top[0][i] = sav[i]; top[1][i] = cur[i]; }
    }
    float va[16], vb[16];
#pragma unroll
    for (int i = 0; i < 16; ++i) { va[i] = __uint_as_float(top[0][i] & ~127u) - 112.f; vb[i] = __uint_as_float(top[1][i] & ~127u); }
    unsigned best[16];
#pragma unroll
    for (int i = 0; i < 16; ++i) best[i] = 0u;
#pragma unroll
    for (int i = 0; i < 16; ++i)
#pragma unroll
        for (int j = 0; j < 16; ++j) if ((i + 1) * (j + 1) <= 16) { const unsigned key = (__float_as_uint(fmaxf(va[i] + vb[j], 0.f)) & ~255u) | (unsigned)(i * 16 + j); ins16(best, key); }
    float sv[16]; float mx = -INFINITY;
#pragma unroll
    for (int i = 0; i < 16; ++i) { sv[i] = __uint_as_float(best[i] & ~255u); mx = fmaxf(mx, sv[i]); }
    float sum = 0.f;
#pragma unroll
    for (int i = 0; i < 16; ++i) { sv[i] = __expf(sv[i] - mx); sum += sv[i]; }
    const float inv = 1.f / sum;
    int eid[16]; unsigned tsel[16]; const unsigned hmask = hh ? 0xffffffffu : 0u;
#pragma unroll
    for (int q = 0; q < 16; ++q) tsel[q] = ((top[1][q] & hmask) | (top[0][q] & ~hmask)) & 127u;
#pragma unroll
    for (int i = 0; i < 16; ++i) { const unsigned pi = best[i] & 255u; const unsigned sel = hh ? (pi & 15u) : (pi >> 4);
        unsigned mine_ = 0;
#pragma unroll
        for (int q = 0; q < 16; ++q) mine_ = (sel == (unsigned)q) ? tsel[q] : mine_;
        auto r_ = __builtin_amdgcn_permlane32_swap(mine_, mine_, false, false); const unsigned oth_ = hh ? r_[0] : r_[1];
        eid[i] = hh ? (int)(oth_ * NKEYS + mine_) : (int)(mine_ * NKEYS + oth_); }
    LAS unsigned long long* cnt = (LAS unsigned long long*)lds;
    __syncthreads();
    if (hh == 0) { unsigned long long mine = 0ull;
#pragma unroll
        for (int i = 0; i < 16; ++i) mine += 1ull << (8 * pe_slice(eid[i]));
        cnt[c * 8 + h] = mine; }
    __syncthreads();
    {
        unsigned long long tot = 0ull, bhead = 0ull;
#pragma unroll
        for (int h2 = 0; h2 < 8; ++h2) { const unsigned long long w = cnt[c * 8 + h2]; tot += w; bhead += (h2 < h) ? w : 0ull; }
        unsigned long long incl = tot; incl += incl << 8; incl += incl << 16; incl += incl << 32;
        const unsigned long long start = incl << 8;
        unsigned long long base = start + bhead;
        LAS u32x2* lp_ = (LAS u32x2*)(lds + 4096); LAS float* ls_ = (LAS float*)(lds + 4096 + 32768);
        const float* su_t = (const float*)(p.ws + WS_SU); const float* sv_t = (const float*)(p.ws + WS_SV);
#pragma unroll
        for (int i = 0; i < 16; ++i) { const int sh = 8 * pe_slice(eid[i]); const unsigned pos = (unsigned)(base >> sh) & 0xffu; base += 1ull << sh;
            if ((i >> 3) == hh) { lp_[c * 128 + pos] = (u32x2){(unsigned)eid[i], __float_as_uint(sv[i] * inv * sv_t[eid[i]])}; ls_[c * 128 + pos] = su_t[eid[i]]; } }
        __syncthreads();
        { const int tok0 = unit * 32; const int tid_ = tidx;
          u32x4* gp = (u32x4*)((u32x2*)(p.ws + WS_CE) + (size_t)tok0 * 128); u32x4* gs = (u32x4*)((float*)(p.ws + WS_SUE) + (size_t)tok0 * 128);
#pragma unroll
          for (int r = 0; r < 4; ++r) { const int i4 = tid_ + 512 * r; gp[i4] = *(const LAS u32x4*)((LAS unsigned*)lp_ + 4 * i4); }
#pragma unroll
          for (int r = 0; r < 2; ++r) { const int i4 = tid_ + 512 * r; gs[i4] = *(const LAS u32x4*)(ls_ + 4 * i4); } }
        if (h == 0 && hh == 0) { unsigned char* of = (unsigned char*)(p.ws + WS_OFFS) + (size_t)tok * 16; *(unsigned long long*)of = start; of[8] = 128; }
    }
}

__device__ __forceinline__ float ub0(unsigned w) { float f; asm("v_cvt_f32_ubyte0 %0, %1" : "=v"(f) : "v"(w)); return f; }
__device__ __forceinline__ float ub1(unsigned w) { float f; asm("v_cvt_f32_ubyte1 %0, %1" : "=v"(f) : "v"(w)); return f; }
__device__ __forceinline__ float ub2(unsigned w) { float f; asm("v_cvt_f32_ubyte2 %0, %1" : "=v"(f) : "v"(w)); return f; }
__device__ __forceinline__ float ub3(unsigned w) { float f; asm("v_cvt_f32_ubyte3 %0, %1" : "=v"(f) : "v"(w)); return f; }
__device__ __forceinline__ void fma_ub4(float& a0, float& a1, float& a2, float& a3, float c, unsigned w) {
    float t0, t1, t2, t3;
    asm("v_cvt_f32_ubyte0 %4, %9\n\tv_cvt_f32_ubyte1 %5, %9\n\tv_cvt_f32_ubyte2 %6, %9\n\tv_cvt_f32_ubyte3 %7, %9\n\t"
        "v_fmac_f32 %0, %8, %4\n\tv_fmac_f32 %1, %8, %5\n\tv_fmac_f32 %2, %8, %6\n\tv_fmac_f32 %3, %8, %7"
        : "+v"(a0), "+v"(a1), "+v"(a2), "+v"(a3), "=&v"(t0), "=&v"(t1), "=&v"(t2), "=&v"(t3) : "v"(c), "v"(w));
}
__device__ __forceinline__ void fma_ub4m(float& a0, float& a1, float& a2, float& a3, float c, unsigned w, unsigned k64, unsigned s01, unsigned s23) {
    unsigned h0, h1;
    asm("v_perm_b32 %4, %7, %6, %8\n\tv_perm_b32 %5, %7, %6, %9\n\t"
        "v_fma_mix_f32 %0, %4, %10, %0 op_sel:[0,0,0] op_sel_hi:[1,0,0]\n\tv_fma_mix_f32 %1, %4, %10, %1 op_sel:[1,0,0] op_sel_hi:[1,0,0]\n\t"
        "v_fma_mix_f32 %2, %5, %10, %2 op_sel:[0,0,0] op_sel_hi:[1,0,0]\n\tv_fma_mix_f32 %3, %5, %10, %3 op_sel:[1,0,0] op_sel_hi:[1,0,0]"
        : "+v"(a0), "+v"(a1), "+v"(a2), "+v"(a3), "=&v"(h0), "=&v"(h1) : "v"(w), "v"(k64), "v"(s01), "v"(s23), "v"(c));
}
__device__ __forceinline__ int idot16(const u32x4 a, const u32x4 b, int acc) {
    acc = __builtin_amdgcn_sdot4((int)a.x, (int)b.x, acc, false); acc = __builtin_amdgcn_sdot4((int)a.y, (int)b.y, acc, false);
    acc = __builtin_amdgcn_sdot4((int)a.z, (int)b.z, acc, false); acc = __builtin_amdgcn_sdot4((int)a.w, (int)b.w, acc, false); return acc;
}
__device__ __forceinline__ float gelu_erf(float v) {
    const float av = fabsf(v), t = __builtin_amdgcn_rcpf(fmaf(av, 0.2316418882f, 1.0f));
    float q = fmaf(t, 0.5307027145f, -0.7265760135f); q = fmaf(q, t, 0.7107068705f); q = fmaf(q, t, -0.142248368f); q = fmaf(q, t, 0.127414796f); q *= t;
    const float e = __builtin_amdgcn_exp2f(v * v * -0.72134752044f), m = v * (q * e);
    return v < 0.f ? m : v - m;
}
#ifndef UKMAIN
#define UKMAIN 32
#endif
__device__ __forceinline__ void phase_peer_u(const Params& p, LAS unsigned char* lds, const int tidx) {
    const int lane = tidx & 63, wave = tidx >> 6, l32 = lane & 31, hf = lane >> 5, par = lane & 1;
    const int x = blockIdx.x & 7, nbx = ((int)gridDim.x - x + 7) >> 3, bl = (int)blockIdx.x >> 3;
    const int tpb = (NLAT + nbx - 1) / nbx, t0 = bl * tpb, t1 = min(NLAT, t0 + tpb);
    const int nsweep = (max(t1 - t0, 0) + NTHREADS - 1) / NTHREADS, nit = nsweep * 32;
    const unsigned char* tabg = (const unsigned char*)(p.ws + WS_EU8) + (size_t)x * (32 * 65536);
    const unsigned char* h2q = (const unsigned char*)(p.ws + WS_H2Q);
    const float* sue = (const float*)(p.ws + WS_SUE); const float* hs = (const float*)(p.ws + WS_HS);
    const u32x2* ce = (const u32x2*)(p.ws + WS_CE); const unsigned char* offs = (const unsigned char*)(p.ws + WS_OFFS);
    u32x2* cdst = p.dup ? (u32x2*)(p.ws + WS_CE + 48 * MiB) : (u32x2*)(p.ws + WS_CE);
    if (nit == 0) return;
    const unsigned wreg = (unsigned)wave * 8192u;
    auto stage = [&](int buf, int cs) { const unsigned char* g = tabg + (size_t)cs * 65536 + wreg + lane * 16;
#pragma unroll
        for (int i = 0; i < 8; ++i) __builtin_amdgcn_global_load_lds((const unsigned*)(g + i * 1024), (LAS unsigned*)(lds + buf * 65536 + wreg + i * 1024), 16, 0, 0); };
    int acc[32]; unsigned ids[16]; int o0 = 0, n = 0, tk = t0, nch = 0; float hsv = 0.f;
    u32x4 hA = {}, hB = {}, nA = {}, nB = {};
#pragma unroll
    for (int k = 0; k < 32; ++k) acc[k] = 0;
#pragma unroll
    for (int k = 0; k < 16; ++k) ids[k] = 0;
    stage(0, 0);
    for (int it = 0; it <= nit; ++it) {
        asm volatile("s_waitcnt vmcnt(0)" ::: "memory"); __syncthreads();
        const int cs = it & 31;
        if (cs == 0) {
            LAS unsigned* st = (LAS unsigned*)(lds + ((it + 1) & 1) * 65536 + wreg);
            if (it > 0) {
#pragma unroll
                for (int j = 0; j < 8; ++j) *(LAS f32x4*)(st + lane * 32 + 4 * j) = (f32x4){(float)acc[4 * j], (float)acc[4 * j + 1], (float)acc[4 * j + 2], (float)acc[4 * j + 3]};
                asm volatile("s_waitcnt lgkmcnt(0)" ::: "memory");
                { u32x2 pr_[32]; float su_[32];
#pragma unroll
                  for (int i = 0; i < 32; ++i) {
                    const int oa = __builtin_amdgcn_readlane(o0, 2 * i), ob = __builtin_amdgcn_readlane(o0, 2 * i + 1);
                    const int ta = __builtin_amdgcn_readlane(tk, 2 * i), tb = __builtin_amdgcn_readlane(tk, 2 * i + 1);
                    const int oi = hf ? ob : oa, tki = hf ? tb : ta;
                    const size_t idx = (size_t)tki * 128 + min(oi + l32, 127); pr_[i] = ce[idx]; su_[i] = sue[idx]; }
#pragma unroll
                  for (int i = 0; i < 32; ++i) {
                    const int oa = __builtin_amdgcn_readlane(o0, 2 * i), ob = __builtin_amdgcn_readlane(o0, 2 * i + 1), na_ = __builtin_amdgcn_readlane(n, 2 * i), nb_ = __builtin_amdgcn_readlane(n, 2 * i + 1);
                    const float ha = __uint_as_float((unsigned)__builtin_amdgcn_readlane((int)__float_as_uint(hsv), 2 * i)), hb = __uint_as_float((unsigned)__builtin_amdgcn_readlane((int)__float_as_uint(hsv), 2 * i + 1));
                    const int ta = __builtin_amdgcn_readlane(tk, 2 * i), tb = __builtin_amdgcn_readlane(tk, 2 * i + 1);
                    const int ti = 2 * i + hf, oi = hf ? ob : oa, ni = min(hf ? nb_ : na_, UKMAIN), tki = hf ? tb : ta;
                    const float z = __uint_as_float(st[ti * 32 + l32]) * su_[i] * (hf ? hb : ha); const float c_ = __uint_as_float(pr_[i].y) * gelu_erf(z);
                    if (l32 < ni) ((float*)(cdst + (size_t)tki * 128 + oi + l32))[1] = c_; } }
                { unsigned long long hvm = __ballot(n > UKMAIN);
                  while (hvm) { const int i = (int)__builtin_ctzll(hvm); hvm &= hvm - 1ull;
                    const int ni = __builtin_amdgcn_readlane(n, i), oi = __builtin_amdgcn_readlane(o0, i), tki = __builtin_amdgcn_readlane(tk, i);
                    const float hsi = __uint_as_float((unsigned)__builtin_amdgcn_readlane((int)__float_as_uint(hsv), i));
                    const u32x4 h_ = *(const u32x4*)(h2q + ((size_t)(lane >> 1) * NLAT + tki) * 32 + par * 16);
                    for (int j0 = UKMAIN; j0 < ni; j0 += 8) {
                        u32x2 pr_[8]; float su_[8]; u32x4 a_[8];
#pragma unroll
                        for (int q = 0; q < 8; ++q) { const size_t idx = (size_t)tki * 128 + oi + min(j0 + q, ni - 1); pr_[q] = ce[idx]; su_[q] = sue[idx]; }
#pragma unroll
                        for (int q = 0; q < 8; ++q) a_[q] = *(const u32x4*)(tabg + ((size_t)(lane >> 1) * 2048 + pe_local(pr_[q].x)) * 32 + par * 16);
                        float mine = 0.f, myg = 0.f, mys = 0.f;
#pragma unroll
                        for (int q = 0; q < 8; ++q) { const float d = wave_sum((float)idot16(a_[q], h_, 0));
                            const bool me = lane == q; mine = me ? d : mine; myg = me ? __uint_as_float(pr_[q].y) : myg; mys = me ? su_[q] : mys; }
                        if (lane < 8 && j0 + lane < ni) { const float z = mine * mys * hsi; ((float*)(cdst + (size_t)tki * 128 + oi + j0 + lane))[1] = myg * gelu_erf(z); } } } }
                asm volatile("s_waitcnt lgkmcnt(0)" ::: "memory");
            }
            if (it == nit) break;
            {
              LAS unsigned* hist = (LAS unsigned*)(lds + 131072); LAS unsigned* pre = hist + 64; LAS unsigned* perm = hist + 128;
              const int swb = t0 + (it >> 5) * NTHREADS, tok0 = swb + tidx; const bool tv0 = tok0 < t1; const int tkc = tv0 ? tok0 : t1 - 1;
              const unsigned o2 = *(const unsigned short*)(offs + (size_t)tkc * 16 + x); const unsigned o0a = o2 & 0xffu, na = tv0 ? (o2 >> 8) - o0a : 0u;
              const unsigned bin = 32u - min(na, 32u);
              if (tidx < 64) hist[tidx] = 0u;
              __syncthreads();
              const unsigned slot = __hip_atomic_fetch_add(hist + bin, 1u, __ATOMIC_RELAXED, __HIP_MEMORY_SCOPE_WORKGROUP);
              __syncthreads();
              if (wave == 0) { unsigned v = hist[lane]; const unsigned own = v;
#pragma unroll
                  for (int o = 1; o < 64; o <<= 1) { const unsigned t_ = (unsigned)__shfl_up((int)v, o); v += (lane >= o) ? t_ : 0u; }
                  pre[lane] = v - own; }
              __syncthreads();
              { const unsigned r = pre[bin] + slot, oct = r >> 6, w_ = oct < 4u ? oct : 11u - oct;
                perm[w_ * 64u + (r & 63u)] = (unsigned)(tkc - swb) | (o0a << 9) | (na << 17); }
              __syncthreads();
              const unsigned pm = perm[tidx]; tk = swb + (int)(pm & 511u); o0 = (int)((pm >> 9) & 0xffu); n = (int)(pm >> 17); hsv = hs[tk]; }
            { unsigned ev_[32];
#pragma unroll
              for (int i = 0; i < 32; ++i) {
                const int oa = __builtin_amdgcn_readlane(o0, 2 * i), ob = __builtin_amdgcn_readlane(o0, 2 * i + 1);
                const int ta = __builtin_amdgcn_readlane(tk, 2 * i), tb = __builtin_amdgcn_readlane(tk, 2 * i + 1);
                const int oi = hf ? ob : oa, tki = hf ? tb : ta;
                ev_[i] = ce[(size_t)tki * 128 + min(oi + l32, 127)].x; }
#pragma unroll
              for (int i = 0; i < 32; ++i) {
                const int na_ = __builtin_amdgcn_readlane(n, 2 * i), nb_ = __builtin_amdgcn_readlane(n, 2 * i + 1);
                const int ti = 2 * i + hf, ni = min(hf ? nb_ : na_, UKMAIN);
                st[ti * 32 + l32] = (l32 < ni) ? (pe_local(ev_[i]) << 5) : 0u; } }
            asm volatile("s_waitcnt lgkmcnt(0)" ::: "memory");
            { const unsigned po = (unsigned)par * 16u * 0x10001u;
#pragma unroll
              for (int j = 0; j < 8; ++j) { const u32x4 q = *(const LAS u32x4*)(st + lane * 32 + 4 * j); ids[2 * j] = (q.x | (q.y << 16)) + po; ids[2 * j + 1] = (q.z | (q.w << 16)) + po; } }
            asm volatile("s_waitcnt lgkmcnt(0)" ::: "memory");
            { const int nm = min(n, UKMAIN); const int mx = __builtin_amdgcn_readfirstlane((int)wave_max_fast((float)nm)); nch = (mx + 3) >> 2; }
#pragma unroll
            for (int k = 0; k < 32; ++k) acc[k] = 0;
            { const unsigned char* hp = h2q + (size_t)tk * 32; nA = *(const u32x4*)(hp + par * 16); nB = *(const u32x4*)(hp + (par ^ 1) * 16); }
        }
        if (it + 1 < nit) stage((it + 1) & 1, (cs + 1) & 31);
        hA = nA; hB = nB;
        if (cs < 31) { const unsigned char* hp = h2q + ((size_t)(cs + 1) * NLAT + tk) * 32; nA = *(const u32x4*)(hp + par * 16); nB = *(const u32x4*)(hp + (par ^ 1) * 16); }
        const unsigned lA = (unsigned)(size_t)lds + (unsigned)((it & 1) * 65536), lB = lA + 16u - 32u * (unsigned)par;
        u32x4 ra[4][2], rb[4][2];
#define PU_OF(k) ((((k) & 1) ? (ids[(k) >> 1] >> 16) : (ids[(k) >> 1] & 0xffffu)))
#define PU_LD(R, c) do { _Pragma("unroll") for (int q_ = 0; q_ < 4; ++q_) { const unsigned of_ = PU_OF(4 * (c) + q_); const unsigned a0_ = lA + of_, a1_ = lB + of_; \
            asm volatile("ds_read_b128 %0, %1" : "=v"(R[q_][0]) : "v"(a0_)); asm volatile("ds_read_b128 %0, %1" : "=v"(R[q_][1]) : "v"(a1_)); } } while (0)
#define PU_WAIT(n) asm volatile("s_waitcnt lgkmcnt(" #n ")" ::: "memory")
#define PU_CP(R, c) do { _Pragma("unroll") for (int q_ = 0; q_ < 4; ++q_) acc[4 * (c) + q_] = idot16(R[q_][1], hB, idot16(R[q_][0], hA, acc[4 * (c) + q_])); } while (0)
#define PU_BODY(N) do { PU_LD(ra, 0); \
            _Pragma("unroll") for (int c = 0; c < (N); c += 2) { \
                if (c + 1 < (N)) { PU_LD(rb, c + 1); PU_WAIT(8); } else PU_WAIT(0); \
                __builtin_amdgcn_sched_barrier(0); PU_CP(ra, c); __builtin_amdgcn_sched_barrier(0); \
                if (c + 1 < (N)) { if (c + 2 < (N)) { PU_LD(ra, c + 2); PU_WAIT(8); } else PU_WAIT(0); \
                    __builtin_amdgcn_sched_barrier(0); PU_CP(rb, c + 1); __builtin_amdgcn_sched_barrier(0); } } } while (0)
        switch (nch) { case 1: PU_BODY(1); break; case 2: PU_BODY(2); break; case 3: PU_BODY(3); break; case 4: PU_BODY(4); break;
                       case 5: PU_BODY(5); break; case 6: PU_BODY(6); break; case 7: PU_BODY(7); break; case 8: PU_BODY(8); break; default: break; }
#undef PU_BODY
#undef PU_OF
#undef PU_LD
#undef PU_WAIT
#undef PU_CP
    }
}
__device__ __forceinline__ void phase_peer_v(const Params& p, LAS unsigned char* lds, const int tidx) {
    const int lane = tidx & 63, wave = tidx >> 6;
    const int x = blockIdx.x & 7, nbx = ((int)gridDim.x - x + 7) >> 3, wl = ((int)blockIdx.x >> 3) * NWAVES + wave, wstride = nbx * NWAVES;
    const unsigned char* ev8 = (const unsigned char*)(p.ws + WS_EV8) + (size_t)x * (NEXP * 128) + (lane & 7) * 16;
    const u32x4* ce4 = (const u32x4*)(p.ws + WS_CE); const float* mod = (const float*)(p.ws + WS_MOD);
    LAS int* le = (LAS int*)(lds + wave * 2048);
    LAS unsigned char* lc8 = (LAS unsigned char*)(lds + wave * 2048 + 1024);
    const int rg = lane >> 3, cg = lane & 7; const bool b3 = lane & 8;
    const int colo = cg * 16 + ((lane & 32) ? 8 : 0) + ((lane & 16) ? 4 : 0) + (b3 ? 2 : 0);
    const int ntok_w = (NLAT - wl + wstride - 1) / wstride;
    const float pscale = p.dup ? 0.f : DBG_PSCALE;
    float n_c0 = 0.f, n_c1 = 0.f; int n_e0 = 0, n_e1 = 0;
    auto fetch = [&](int i) { if (i < ntok_w) { const u32x4 q_ = ce4[(size_t)(wl + wstride * i) * 64 + lane]; n_e0 = (int)q_.x; n_c0 = __uint_as_float(q_.y); n_e1 = (int)q_.z; n_c1 = __uint_as_float(q_.w); } };
    auto stage = [&](int buf, float& cscale) {
        const float cm = fmaxf(wave_max_fast(fmaxf(fabsf(n_c0), fabsf(n_c1))), 1e-30f); const float inv = 127.f / cm; cscale = cm * (1.f / 127.f);
        *(LAS u32x2*)(le + buf * 128 + 2 * lane) = (u32x2){(unsigned)n_e0, (unsigned)n_e1};
        lc8[buf * 128 + ((2 * lane) & 7) * 16 + (lane >> 2)] = (unsigned char)(__float2int_rn(n_c0 * inv) & 0xff);
        lc8[buf * 128 + ((2 * lane + 1) & 7) * 16 + (lane >> 2)] = (unsigned char)(__float2int_rn(n_c1 * inv) & 0xff);
        asm volatile("s_waitcnt lgkmcnt(0)" ::: "memory"); };
    u32x4 ra[16], rb[16]; float csa = 0.f, csb = 0.f; int gb_ = -1; f32x2 gq_ = {0.f, 0.f};
#define PV_LOAD(buf, R) do { _Pragma("unroll") for (int it = 0; it < 16; ++it) { const int e_ = le[(buf) * 128 + 8 * it + rg]; R[it] = *(const u32x4*)(ev8 + (size_t)e_ * 128); } } while (0)
#define PV_T4(r0, r1, r2, r3, cq_, A0, A1, A2, A3) do { \
        const unsigned t0 = __builtin_amdgcn_perm(r1, r0, 0x05010400u), t1 = __builtin_amdgcn_perm(r1, r0, 0x07030602u); \
        const unsigned u0 = __builtin_amdgcn_perm(r3, r2, 0x05010400u), u1 = __builtin_amdgcn_perm(r3, r2, 0x07030602u); \
        A0 = __builtin_amdgcn_sdot4((int)__builtin_amdgcn_perm(u0, t0, 0x05040100u), (int)(cq_), A0, false); \
        A1 = __builtin_amdgcn_sdot4((int)__builtin_amdgcn_perm(u0, t0, 0x07060302u), (int)(cq_), A1, false); \
        A2 = __builtin_amdgcn_sdot4((int)__builtin_amdgcn_perm(u1, t1, 0x05040100u), (int)(cq_), A2, false); \
        A3 = __builtin_amdgcn_sdot4((int)__builtin_amdgcn_perm(u1, t1, 0x07060302u), (int)(cq_), A3, false); } while (0)
#define PV_COMP(buf, R, i_, cs_) do { int acc[16]; \
        const int tok = wl + wstride * (i_); const int b = tok / T; float* op = p.out + (size_t)tok * D + x * 128 + colo; \
        if (b != gb_) { gb_ = b; gq_ = *(const f32x2*)(mod + (size_t)b * NMOD + 5 * D + x * 128 + colo) * pscale; }     \
        const f32x2 xv = *(const f32x2*)op; const f32x2 gg = gq_ * (cs_); \
        const u32x4 cq = *(const LAS u32x4*)(lc8 + (buf) * 128 + rg * 16); \
        _Pragma("unroll") for (int q = 0; q < 16; ++q) acc[q] = 0; \
        _Pragma("unroll") for (int a = 0; a < 4; ++a) { const unsigned cqa = cq[a]; \
            PV_T4(R[4 * a].x, R[4 * a + 1].x, R[4 * a + 2].x, R[4 * a + 3].x, cqa, acc[0], acc[1], acc[2], acc[3]); \
            PV_T4(R[4 * a].y, R[4 * a + 1].y, R[4 * a + 2].y, R[4 * a + 3].y, cqa, acc[4], acc[5], acc[6], acc[7]); \
            PV_T4(R[4 * a].z, R[4 * a + 1].z, R[4 * a + 2].z, R[4 * a + 3].z, cqa, acc[8], acc[9], acc[10], acc[11]); \
            PV_T4(R[4 * a].w, R[4 * a + 1].w, R[4 * a + 2].w, R[4 * a + 3].w, cqa, acc[12], acc[13], acc[14], acc[15]); } \
        int a8[8], a4[4], a2[2]; \
        _Pragma("unroll") for (int q = 0; q < 8; ++q) { auto r_ = __builtin_amdgcn_permlane32_swap((unsigned)acc[q], (unsigned)acc[8 + q], false, false); a8[q] = (int)r_[0] + (int)r_[1]; } \
        _Pragma("unroll") for (int q = 0; q < 4; ++q) { auto r_ = __builtin_amdgcn_permlane16_swap((unsigned)a8[q], (unsigned)a8[4 + q], false, false); a4[q] = (int)r_[0] + (int)r_[1]; } \
        _Pragma("unroll") for (int q = 0; q < 2; ++q) { const int snd = b3 ? a4[q] : a4[2 + q], kp = b3 ? a4[2 + q] : a4[q]; a2[q] = kp + dppi<0x128>(snd); } \
        f32x2 rr; rr[0] = xv[0] + gg[0] * (float)a2[0]; rr[1] = xv[1] + gg[1] * (float)a2[1]; *(f32x2*)op = rr; } while (0)
    if (ntok_w > 0) { fetch(0); stage(0, csa); fetch(1); PV_LOAD(0, ra); }
    for (int i = 0; i < ntok_w; i += 2) {
        if (i + 1 < ntok_w) { stage(1, csb); fetch(i + 2); PV_LOAD(1, rb); }
        PV_COMP(0, ra, i, csa);
        if (i + 2 < ntok_w) { stage(0, csa); fetch(i + 3); PV_LOAD(0, ra); }
        if (i + 1 < ntok_w) PV_COMP(1, rb, i + 1, csb);
    }
#undef PV_LOAD
#undef PV_T4
#undef PV_COMP
}

#ifndef DBG_CHECK
#define DBG_CHECK 0
#endif
#ifndef DBG_SEL
#define DBG_SEL 4
#endif
__device__ __forceinline__ int dbg_tok(int slot) { return slot * 128 + 37; }
__device__ __forceinline__ float block_sum(float v, LAS float* red, const int tidx) {
    v = wave_sum(v); __syncthreads(); if ((tidx & 63) == 0) red[tidx >> 6] = v; __syncthreads();
    float s = 0.f; for (int w = 0; w < 8; ++w) s += red[w]; return s;
}
__device__ __forceinline__ void dbg_peer_check(const Params& p, LAS unsigned char* lds, const int tidx) {
    const int tid = tidx, lane = tid & 63, wave = tid >> 6;
    LAS float* h2f = (LAS float*)lds;
    LAS float* q = h2f + 1024;
    LAS float* sp = q + 2048;
    LAS float* topv = sp + 256;
    LAS int* topi = (LAS int*)(topv + 32);
    LAS float* cv = (LAS float*)(topi + 32);
    LAS float* bestv = cv + 256;
    LAS int* eref = (LAS int*)(bestv + 16);
    LAS float* gref = (LAS float*)(eref + 128);
    LAS float* wref = gref + 128;
    LAS float* red = wref + 128;
    for (int slot = blockIdx.x; slot < 256; slot += gridDim.x) {
        const int tok = dbg_tok(slot);
        const bf16_t* h2 = (const bf16_t*)(p.ws + WS_H2) + (size_t)tok * D;
        __syncthreads();
        for (int i = tid; i < D; i += NTHREADS) h2f[i] = bf2f(h2[i]);
        __syncthreads();
        for (int n = tid; n < 2048; n += NTHREADS) { float s = 0.f; for (int k = 0; k < D; ++k) s += h2f[k] * p.w_pq[(size_t)k * 2048 + n]; q[n] = s; }
        __syncthreads();
        for (int h = 0; h < PH; ++h) {
            if (tid < 256) { const int pp = tid >> 7, k = tid & 127; float s = 0.f; const float* sk = p.sub_keys + ((size_t)(h * 2 + pp) * NKEYS + k) * 128;
                for (int d = 0; d < 128; ++d) s += q[h * 256 + pp * 128 + d] * sk[d]; sp[tid] = s; }
            __syncthreads();
            if (tid < 256) { const int pp = tid >> 7, k = tid & 127; const float v = sp[tid]; int r = 0;
                for (int k2 = 0; k2 < 128; ++k2) { const float v2 = sp[pp * 128 + k2]; r += (v2 > v || (v2 == v && k2 < k)) ? 1 : 0; }
                if (r < 16) { topv[pp * 16 + r] = v; topi[pp * 16 + r] = k; } }
            __syncthreads();
            if (tid < 256) cv[tid] = topv[tid >> 4] + topv[16 + (tid & 15)];
            __syncthreads();
            if (tid < 256) { const float v = cv[tid]; int r = 0;
                for (int t2 = 0; t2 < 256; ++t2) { const float v2 = cv[t2]; r += (v2 > v || (v2 == v && t2 < tid)) ? 1 : 0; }
                if (r < 16) { bestv[r] = v; eref[h * 16 + r] = topi[tid >> 4] * NKEYS + topi[16 + (tid & 15)]; } }
            __syncthreads();
            if (tid < 16) { float mx = bestv[0]; for (int i = 1; i < 16; ++i) mx = fmaxf(mx, bestv[i]); float sum = 0.f; for (int i = 0; i < 16; ++i) sum += expf(bestv[i] - mx);
                gref[h * 16 + tid] = expf(bestv[tid] - mx) / sum; }
            __syncthreads();
        }
        float terr = 0.f, tden = 0.f;
        { const bf16_t* eub = (const bf16_t*)(p.ws + WS_EU);
          for (int k = 0; k < 128; ++k) { const size_t e = (size_t)eref[k]; for (int d = tid; d < D; d += NTHREADS) { const float a = p.expert_u[e * D + d], bq = bf2f(eub[e * D + d]); terr += (a - bq) * (a - bq); tden += a * a; } } }
        terr = block_sum(terr, red, tidx); tden = block_sum(tden, red, tidx);
        for (int kk = 0; kk < 16; ++kk) { const int k = wave * 16 + kk; const float* ur = p.expert_u + (size_t)eref[k] * D; float s = 0.f;
            for (int d = lane; d < D; d += 64) s += ur[d] * h2f[d];
            s = wave_sum(s); if (lane == 0) wref[k] = gref[k] * 0.5f * s * (1.f + erff(s * 0.70710678118654752f)); }
        __syncthreads();
        const float* pf = (const float*)(p.ws + WS_DBGP) + (size_t)slot * D;
        float num = 0.f, den = 0.f;
        for (int d = tid; d < D; d += NTHREADS) { float o = 0.f; for (int k = 0; k < 128; ++k) o += wref[k] * p.expert_v[(size_t)eref[k] * D + d];
            const float f = pf[d]; num += (f - o) * (f - o); den += o * o; }
        num = block_sum(num, red, tidx); den = block_sum(den, red, tidx);
        const int* ef = (const int*)(p.ws + WS_EIDX) + (size_t)tok * 128; const float* gf = (const float*)(p.ws + WS_GW) + (size_t)tok * 128;
        float miss = 0.f, gerr = 0.f, gden = 0.f, werr = 0.f, wden = 0.f; const float* wf = (const float*)(p.ws + WS_DBGP + MiB) + (size_t)slot * 128;
        if (tid < 128) { const int e = ef[tid]; int found = -1; for (int k = 0; k < 128; ++k) if (eref[k] == e && (k >> 4) == (tid >> 4)) found = k;
            if (found < 0) miss = 1.f; else { const float dg = gf[tid] - gref[found]; gerr = dg * dg; gden = gref[found] * gref[found]; const float dw = wf[tid] - wref[found]; werr = dw * dw; wden = wref[found] * wref[found]; } }
        werr = block_sum(werr, red, tidx); wden = block_sum(wden, red, tidx);
        miss = block_sum(miss, red, tidx); gerr = block_sum(gerr, red, tidx); gden = block_sum(gden, red, tidx);
        if (tid == 0) { float* r = (float*)(p.ws + WS_DBGR) + slot * 8; r[0] = num; r[1] = den; r[2] = miss; r[3] = gerr; r[4] = gden; r[5] = werr; r[6] = wden; r[7] = terr / tden; }
    }
}
__device__ __forceinline__ void dbg_report(const Params& p, const int tidx) {
    const float* r = (const float*)(p.ws + WS_DBGR);
    float num = 0.f, den = 0.f, miss = 0.f, gerr = 0.f, gden = 0.f, werr = 0.f, wden = 0.f;
    for (int s = 0; s < 256; ++s) { num += r[s * 8]; den += r[s * 8 + 1]; miss += r[s * 8 + 2]; gerr += r[s * 8 + 3]; gden += r[s * 8 + 4]; werr += r[s * 8 + 5]; wden += r[s * 8 + 6]; }
    float val = 0.f;
    if (DBG_SEL == 1) val = num / den;
    if (DBG_SEL == 2) val = miss / (256.f * 128.f);
    if (DBG_SEL == 3) val = gerr / gden;
    if (DBG_SEL == 5) { float t = 0.f; for (int s = 0; s < 256; ++s) t += r[s * 8 + 7]; val = t / 256.f; }
    if (DBG_SEL == 4) val = werr / wden;
    const float sc = 1.f + sqrtf(fminf(val, 100.f));
    const int gt = blockIdx.x * NTHREADS + tidx, NGT = gridDim.x * NTHREADS;
    for (int i = gt; i < NLAT * D / 4; i += NGT) ((f32x4*)p.out)[i] = ((const f32x4*)p.x)[i] * sc;
}

#define XB_TMO      128
#define XB_XCNT(j)  (256  + 64 * (j))
#define XB_XSUB(j)  (1280 + 64 * (j))
#define XB_XGEN(j)  (2304 + 64 * (j))
#define XB_TOP      3328
#define XB_TOPGEN   3392
#define XCD_BAR_WORDS 3456
#define XB_SPIN_CAP (1u << 22)
__device__ __forceinline__ unsigned xb_ld(unsigned* p)              { return __hip_atomic_load(p, __ATOMIC_RELAXED, __HIP_MEMORY_SCOPE_AGENT); }
__device__ __forceinline__ unsigned xb_add(unsigned* p, unsigned v) { return __hip_atomic_fetch_add(p, v, __ATOMIC_RELAXED, __HIP_MEMORY_SCOPE_AGENT); }
__device__ __forceinline__ unsigned xb_xcc_id() { return (unsigned)__builtin_amdgcn_s_getreg((3 << 11) | 20) & 0xFu; }
#define XB_SPIN(cond, bar) do { unsigned _sp = 0; while (cond) { __builtin_amdgcn_s_sleep(1); \
    if ((++_sp & 255u) == 0u) { if (xb_ld(&(bar)[XB_TMO])) break; if (_sp > XB_SPIN_CAP) { atomicAdd(&(bar)[XB_TMO], 1u); break; } } } } while (0)
struct XcdBarrier { unsigned* bar; unsigned x; volatile LAS unsigned* st; };
__device__ __forceinline__ XcdBarrier xcd_barrier_post(unsigned* bar, volatile LAS unsigned* st) {
    XcdBarrier b; b.bar = bar; b.x = xb_xcc_id(); b.st = st;
    if (threadIdx.x == 0) (void)xb_add(&bar[XB_XCNT(b.x)], 1u);
    return b;
}
__device__ __forceinline__ void xcd_barrier_complete(unsigned* bar, unsigned x, unsigned& nloc, unsigned& nx) {
    const unsigned G = gridDim.x * gridDim.y * gridDim.z;
    unsigned sum, cnt, mine, sp = 0u;
    for (;;) {
        sum = 0u; cnt = 0u; mine = 0u;
#pragma unroll
        for (unsigned j = 0; j < 16; ++j) { const unsigned c = xb_ld(&bar[XB_XCNT(j)]); sum += c; cnt += (c > 0u) ? 1u : 0u; mine = (j == x) ? c : mine; }
        if (sum == G) break;
        __builtin_amdgcn_s_sleep(1);
        if ((++sp & 255u) == 0u) { if (xb_ld(&bar[XB_TMO])) break; if (sp > XB_SPIN_CAP) { atomicAdd(&bar[XB_TMO], 1u); break; } }
    }
    nloc = mine > 0u ? mine : 1u; nx = cnt > 0u ? cnt : 1u;
}
__device__ __forceinline__ void xcd_barrier(const XcdBarrier& b, const int tidx) {
    asm volatile("s_waitcnt vmcnt(0)" ::: "memory");
    __syncthreads();
    if (tidx == 0) {
        unsigned* bar = b.bar;
        __builtin_amdgcn_s_waitcnt(0);
        unsigned nloc = b.st[0], nx = b.st[1];
        if (nloc == 0u) { xcd_barrier_complete(bar, b.x, nloc, nx); b.st[0] = nloc; b.st[1] = nx; }
        const unsigned old = xb_add(&bar[XB_XSUB(b.x)], 1u);
        const unsigned gen = old / nloc;
        if (old + 1u == (gen + 1u) * nloc) {
            __builtin_amdgcn_fence(__ATOMIC_RELEASE, "agent");
            asm volatile("s_waitcnt vmcnt(0)" ::: "memory");
            const unsigned og = xb_add(&bar[XB_TOP], 1u);
            const unsigned tg = og / nx;
            if (og + 1u == (tg + 1u) * nx) xb_add(&bar[XB_TOPGEN], 1u);
            else XB_SPIN(xb_ld(&bar[XB_TOPGEN]) == tg, bar);
            __builtin_amdgcn_fence(__ATOMIC_ACQUIRE, "agent");
            xb_add(&bar[XB_XGEN(b.x)], 1u);
            asm volatile("s_waitcnt vmcnt(0)" ::: "memory");
        } else {
            XB_SPIN(xb_ld(&bar[XB_XGEN(b.x)]) == gen, bar);
            __builtin_amdgcn_fence(__ATOMIC_ACQUIRE, "agent");
            asm volatile("s_waitcnt vmcnt(0)" ::: "memory");
        }
    }
    __syncthreads();
}
constexpr int NPHASE = 12 + 2 * DBG_CHECK;
constexpr int LDS_BYTES = 160 * 1024;
typedef const __attribute__((address_space(4))) Params* KargPtr;
#if defined(__HIP_DEVICE_COMPILE__)
#define PLOAD() KargPtr kq_ = kp; asm volatile("" : "+s"(kq_)); const Params p = *kq_; unsigned char* ws = p.ws; (void)ws; const int tidx = (wave_s << 6) | lane_id_v()
#else
#define PLOAD() const Params p = p_unused; unsigned char* ws = p.ws; (void)ws; const int tidx = (wave_s << 6) | lane_id_v()
#endif
__global__ void __launch_bounds__(NTHREADS, 2) mega(Params p_unused) {
    extern __shared__ __attribute__((aligned(16))) unsigned char lds_raw[];
    LAS unsigned char* lds = (LAS unsigned char*)lds_raw;
    KargPtr kp = (KargPtr)__builtin_amdgcn_kernarg_segment_ptr();
    const int lo = kp->ph_lo, hi = kp->ph_hi;
    const int G = gridDim.x, bid = blockIdx.x;
    const int wave_s = __builtin_amdgcn_readfirstlane(threadIdx.x >> 6);
#if !MK_MULTI && !MK_CGSYNC
    volatile LAS unsigned* xst = (volatile LAS unsigned*)(lds + LDS_BYTES - 64);
    if (threadIdx.x < 2) xst[threadIdx.x] = 0u;
    __syncthreads();
    const XcdBarrier xbar = xcd_barrier_post((unsigned*)(kp->ws + WS_BAR), xst);
#endif
#ifndef PHMASK
#define PHMASK 0xFFFFF
#endif
#define IN(k) (((PHMASK >> (k)) & 1) && lo <= (k) && (k) < hi)
#define TIDX() ((wave_s << 6) | lane_id_v())
#if MK_MULTI
#define SEAM(k) do { } while (0)
#else
#if MK_CGSYNC
#define SEAM(k) do { if (IN(k) && IN((k) + 1)) cg::this_grid().sync(); } while (0)
#else
#define SEAM(k) do { if (IN(k) && IN((k) + 1)) xcd_barrier(xbar, (wave_s << 6) | lane_id_v()); } while (0)
#endif
#endif
    if (IN(0)) { PLOAD(); phase_prep(p, lds, tidx); }
    SEAM(0);
    if (IN(1)) { PLOAD(); phase_hnorm(p, tidx); }
    SEAM(1);
    if (IN(2)) { PLOAD(); pg8::Gemm g{(const bf16_t*)(ws + WS_HB), (const bf16_t*)(ws + WS_WIN), NTOK, INCP, D, D, D, 0}; pg8::StaticOrder S; S.init(NTOK, INCP, G, bid);
        pg8::EpiCols E{(bf16_t*)(ws + WS_COLS), (float*)(ws + WS_GATES), (float*)(ws + WS_SSQ)}; pg8::gemm_phase(lds, g, S, E, tidx);
        { const int nt = (NTOK / 256) * (INCP / 256), extra = nt % G;
          if (extra == 0 || extra >= G) quant_experts(p, bid, G, TIDX()); else if (bid >= extra) quant_experts(p, bid - extra, G - extra, TIDX()); } }
    SEAM(2);
    if (IN(3)) { PLOAD();
        { pg8::Gemm g{(const bf16_t*)(ws + WS_COLS) + C_CQ, (const bf16_t*)(ws + WS_WUQ), NLAT, 1024, 256, INCP, 256, 0}; pg8::StaticOrder S; S.init(NLAT, 1024, G, bid);
          const int t_ = TIDX(); pg8::EpiQ E{(const float*)(ws + WS_SSQ), p.g_qn, (const float*)(ws + WS_ROPE), (bf16_t*)(ws + WS_Q), lds + 128 * 1024, t_}; pg8::gemm_phase(lds, g, S, E, t_); }
        { pg8::Gemm g{(const bf16_t*)(ws + WS_COLS) + C_CKV, (const bf16_t*)(ws + WS_WUKV), NTOK, 1024, 128, INCP, 128, 0}; pg8::StaticOrder S; S.init(NTOK, 1024, G, bid);
          const int t_ = TIDX(); pg8::EpiKV E{(const bf16_t*)(ws + WS_COLS), (const float*)(ws + WS_SSQ), p.g_kn, (const float*)(ws + WS_ROPE), (bf16_t*)(ws + WS_K), (bf16_t*)(ws + WS_VT), lds + 128 * 1024, t_}; pg8::gemm_phase(lds, g, S, E, t_); }
        { const int t_ = TIDX(); for (int u = (bid + G / 2) % G; u < NB * MH * 17; u += G) ml_summary_unit(p, lds, u, t_); }
    }
    SEAM(3);
    if (IN(4)) { PLOAD(); phase_ml_scan(p, tidx); }
    SEAM(4);
    if (IN(5)) { PLOAD();
        if (!p.dup || DUP_SUB == 0) { const int t_ = TIDX(); for (int u = bid; u < NB * NH * (T / 256); u += G) attn_unit(p, lds, u, t_); }
        if (!p.dup || DUP_SUB == 1) { const int t_ = TIDX(); for (int u = bid; u < NB * MH * NBLK; u += G) ml_output_unit(p, lds, u, t_); }
    }
    SEAM(5);
    if (IN(6)) { PLOAD(); pg8::Gemm g{(const bf16_t*)(ws + WS_MIX), (const bf16_t*)(ws + WS_WOUT), NLAT, D, D, D, D, 0}; pg8::StaticOrder S; S.init(NLAT, D, G, bid);
        pg8::EpiResid E{p.x, p.out, (const float*)(ws + WS_MOD), 2 * D, (DBG_MODE == 1 || DBG_MODE == 5) ? 0.f : 1.f}; pg8::gemm_phase(lds, g, S, E, tidx); }
    SEAM(6);
#if DBG_MODE == 0 || DBG_MODE == 5
    if (IN(7)) { PLOAD(); phase_h2(p, tidx); }
    SEAM(7);
    if (IN(8)) { PLOAD(); pg8::Gemm g{(const bf16_t*)(ws + WS_H2), (const bf16_t*)(ws + WS_WPQ), NLAT, 2048, D, D, D, 0}; pg8::StaticOrder S; S.init(NLAT, 2048, G, bid);
        pg8::EpiBf16 E{(bf16_t*)(ws + WS_QP), 2048}; pg8::gemm_phase(lds, g, S, E, tidx); }
    SEAM(8);
    if (IN(9)) { PLOAD(); for (int u = bid; u < NLAT / 32; u += G) peer_topk_unit(p, lds, u, tidx); }
    SEAM(9);
    if (IN(10)) { PLOAD(); phase_peer_u(p, lds, tidx); }
    SEAM(10);
    if (IN(11)) { PLOAD(); phase_peer_v(p, lds, tidx); }
#endif
#if DBG_CHECK
    SEAM(11);
    if (IN(12)) { PLOAD(); dbg_peer_check(p, lds, tidx); }
    SEAM(12);
    if (IN(13)) { PLOAD(); dbg_report(p, tidx); }
#endif
#undef IN
#undef SEAM
}

extern "C" void kernel_launch(void* const* d_in, const int* in_sizes, int n_in, void* d_out, int out_size, void* d_ws, size_t ws_size, hipStream_t stream) {
    static int grid = 0;
    if (grid == 0) {
        if (n_in != 24 || out_size != NLAT * D || ws_size < WS_END) { fprintf(stderr, "kernel_launch: unexpected shapes (n_in %d out %d ws %zu, need %zu)\n", n_in, out_size, ws_size, (size_t)WS_END); grid = -1; return; }
        int dev = 0, cus = 0, per_cu = 0;
        hipGetDevice(&dev); hipDeviceGetAttribute(&cus, hipDeviceAttributeMultiprocessorCount, dev);
        hipFuncSetAttribute((const void*)mega, hipFuncAttributeMaxDynamicSharedMemorySize, LDS_BYTES);
        hipOccupancyMaxActiveBlocksPerMultiprocessor(&per_cu, (const void*)mega, NTHREADS, LDS_BYTES);
        (void)hipGetLastError();
        if (per_cu < 1) { fprintf(stderr, "kernel_launch: occupancy query says %d blocks per CU\n", per_cu); per_cu = 1; }
        grid = cus;
    }
    if (grid < 0) return;
    Params p{};
    const float** pp = (const float**)&p;
    for (int i = 0; i < 24; ++i) pp[i] = (const float*)d_in[i];
    p.out = (float*)d_out; p.ws = (unsigned char*)d_ws;
#if MK_MULTI
    for (int ph = 0; ph < NPHASE; ++ph) for (int rep = 0; rep <= ((DUP_MASK >> ph) & 1); ++rep) { p.ph_lo = ph; p.ph_hi = ph + 1; p.dup = rep; hipLaunchKernelGGL(mega, dim3(grid), dim3(NTHREADS), LDS_BYTES, stream, p); }
#else
    p.ph_lo = 0; p.ph_hi = NPHASE;
#if MK_CGSYNC
    void* args[] = {&p};
    hipError_t e = hipLaunchCooperativeKernel((void*)mega, dim3(grid), dim3(NTHREADS), args, LDS_BYTES, stream);
    if (e != hipSuccess) fprintf(stderr, "cooperative launch failed: %s (grid %d)\n", hipGetErrorString(e), grid);
#else
    (void)hipMemsetAsync((char*)d_ws + WS_BAR, 0, XCD_BAR_WORDS * 4, stream);
    hipLaunchKernelGGL(mega, dim3(grid), dim3(NTHREADS), LDS_BYTES, stream, p);
#endif
#endif
}
```

```cpp
#include <hip/hip_runtime.h>
#include <hip/hip_cooperative_groups.h>
#include <cstdio>
#include <cstdint>
namespace cg = cooperative_groups;

#ifndef MK_MULTI
#define MK_MULTI 0
#endif
#ifndef MK_CGSYNC
#define MK_CGSYNC 0
#endif
#ifndef DUP_MASK
#define DUP_MASK 0
#endif
#ifndef DUP_SUB
#define DUP_SUB 0
#endif
#define DBG_CHECK 0
#define DBG_SEL 4
#ifndef DBG_MODE
#define DBG_MODE 0
#endif
#ifndef DBG_PSCALE
#define DBG_PSCALE 1.0f
#endif

#define LAS __attribute__((address_space(3)))
typedef unsigned short bf16_t;
typedef short bf16x8 __attribute__((ext_vector_type(8)));
typedef short s16x4 __attribute__((ext_vector_type(4)));
typedef float f32x4 __attribute__((ext_vector_type(4)));
typedef float f32x2 __attribute__((ext_vector_type(2)));
typedef float f32x16 __attribute__((ext_vector_type(16)));
typedef unsigned u32x4 __attribute__((ext_vector_type(4)));
typedef unsigned u32x2 __attribute__((ext_vector_type(2)));
typedef __bf16 bf16v2 __attribute__((ext_vector_type(2)));

constexpr int NB = 8, T = 4096, TC = 256, D = 1024;
constexpr int NLAT = NB * T, NCTX = NB * TC, NTOK = NLAT + NCTX;
constexpr int NMOD = 6 * D;
constexpr int INC = 2000, INCP = 2048;
constexpr int C_CQ = 0, C_CKV = 256, C_KR = 384, C_MQ = 448, C_MK = 704, C_MV = 960, C_MO = 1472, C_G = 1984;
constexpr int NH = 4, DQK = 192, DNOPE = 128, DROPE = 64, DV = 128;
constexpr int NKEY = TC + T;
constexpr int MH = 4, MDK = 64, MDV = 128, MCH = 256, NBLK = T / MCH;
constexpr int PH = 8, NKEYS = 128, PDK = 256, PTOP = 16, NEXP = NKEYS * NKEYS;
constexpr float EPS = 1e-6f;
constexpr int NTHREADS = 512, NWAVES = 8;

constexpr size_t MiB = 1u << 20;
constexpr size_t WS_ZERO = 0;
constexpr size_t WS_MOD = 0;
constexpr size_t WS_SSQ = 18 * MiB + 512 * 1024;
constexpr size_t ZERO_BYTES = 1 * MiB;
constexpr size_t WS_BAR = 512 * 1024;
constexpr size_t WS_ROPE = 1 * MiB;
constexpr size_t WS_SKB = WS_ROPE + 64 * 1024;
constexpr size_t WS_MSCAL = WS_SKB + 512 * 1024;
constexpr size_t WS_MST = WS_MSCAL + 64 * 1024;
constexpr size_t WS_NST = WS_MST + 64 * 1024;
constexpr size_t WS_NL = WS_NST + 512 * 1024;
constexpr size_t WS_WIN = 4 * MiB;
constexpr size_t WS_WUQ = 8 * MiB;
constexpr size_t WS_WUKV = 9 * MiB;
constexpr size_t WS_WOUT = 10 * MiB;
constexpr size_t WS_WPQ = 12 * MiB;
constexpr size_t WS_GATES = 16 * MiB;
constexpr size_t WS_R1 = 20 * MiB;
constexpr size_t WS_HB = WS_R1, WS_Q = WS_R1, WS_CST = WS_R1 + 48 * MiB, WS_H2 = WS_R1;
constexpr size_t WS_COLS = 88 * MiB;
constexpr size_t WS_QP = WS_COLS;
constexpr size_t WS_R2 = 224 * MiB;
constexpr size_t WS_QRAW = WS_R2, WS_KVRAW = WS_R2 + 48 * MiB, WS_MIX = WS_R2;
constexpr size_t WS_EIDX = WS_R2 + 64 * MiB, WS_GW = WS_R2 + 80 * MiB;
constexpr size_t WS_CE = WS_EIDX;
constexpr size_t WS_SUE = WS_R2 + 96 * MiB;
constexpr size_t WS_U = 340 * MiB;
constexpr size_t WS_K = 376 * MiB;
constexpr size_t WS_VT = 428 * MiB;
constexpr size_t WS_EU = 376 * MiB;
constexpr size_t WS_EV = 408 * MiB;
constexpr size_t WS_EU8 = 464 * MiB;
constexpr size_t WS_EV8 = 480 * MiB;
constexpr size_t WS_H2Q = 408 * MiB;
constexpr size_t WS_SU = 3 * MiB;
constexpr size_t WS_SV = 3 * MiB + 64 * 1024;
constexpr size_t WS_HS = 3 * MiB + 128 * 1024;
constexpr size_t WS_OFFS = 3 * MiB + 256 * 1024;
constexpr size_t WS_X1B = 340 * MiB;
constexpr size_t WS_END = 496 * MiB;
constexpr size_t WS_DBGP = 340 * MiB;
constexpr size_t WS_DBGR = 342 * MiB;

__device__ __forceinline__ unsigned cvt_pk_bf16(float lo, float hi) { unsigned r; asm volatile("v_cvt_pk_bf16_f32 %0, %1, %2" : "=v"(r) : "v"(lo), "v"(hi)); return r; }
__device__ __forceinline__ int lane_id_v() { int l; asm volatile("v_mbcnt_lo_u32_b32 %0, -1, 0\n\tv_mbcnt_hi_u32_b32 %0, -1, %0" : "=v"(l)); return l; }
__device__ __forceinline__ int pe_slice(int e) { return ((e >> 7) + e) & 7; }
__device__ __forceinline__ unsigned pe_local(unsigned e) { return ((e >> 7) << 4) | ((e & 127u) >> 3); }
__device__ __forceinline__ float bf_lo(unsigned w) { return __uint_as_float(w << 16); }
__device__ __forceinline__ float bf_hi(unsigned w) { return __uint_as_float(w & 0xffff0000u); }
__device__ __forceinline__ float bf2f(bf16_t v) { return __uint_as_float((unsigned)v << 16); }
__device__ __forceinline__ bf16_t f2bf(float f) { return (bf16_t)(cvt_pk_bf16(f, 0.f) & 0xffffu); }
__device__ __forceinline__ float wave_sum(float v) {
#pragma unroll
    for (int o = 1; o < 64; o <<= 1) v += __shfl_xor(v, o);
    return v;
}
__device__ __forceinline__ float siluf(float v) { return v / (1.f + __expf(-v)); }
__device__ __forceinline__ float sigmoidf_(float v) { return 1.f / (1.f + __expf(-v)); }
__device__ __forceinline__ float logsigmoidf_(float v) { return fminf(v, 0.f) - log1pf(__expf(-fabsf(v))); }
__device__ __forceinline__ int crow(int r, int hi) { return (r & 3) + 8 * (r >> 2) + 4 * hi; }

struct Params {
    const float *x, *c, *ctx, *c_ctx, *w_ada, *b_ada, *g_norm1, *w_in, *g_cq, *w_uq, *g_ckv, *w_ukv, *g_qn, *g_kn, *conv_qk, *b_igate, *b_fgate, *g_mlstm, *w_out, *g_norm2,
        *w_pq, *sub_keys, *expert_u, *expert_v;
    float* out; unsigned char* ws;
    int ph_lo, ph_hi, dup, pad_;
};

namespace pg8 {
constexpr int BM = 256, BK = 64, HALF = 128, HTB = HALF * BK * 2, STAGE_BYTES = 8 * HTB, NXCD = 8, WGM = 8;
__host__ __device__ __forceinline__ int lds_byte(int r, int c) { const int st = (r >> 4) * 2 + (c >> 5), rr = r & 15, cc = c & 31, ob = rr * 64 + cc * 2; return st * 1024 + (ob ^ (((ob >> 9) & 1) << 5)); }
__host__ __device__ __forceinline__ void stage_rc(int b, int& R, int& C) { const int st = b / 1024, sb = b % 1024, swz = sb ^ (((sb >> 9) & 1) << 5); R = (st >> 1) * 16 + swz / 64; C = (st & 1) * 32 + (swz % 64) / 2; }
__host__ __device__ __forceinline__ int perm32(int rho) { const int n = rho >> 4, i = rho & 15; return 8 * (i >> 2) + 4 * n + (i & 3); }
struct Unit { int pm, pn; };
struct Gemm { const bf16_t* A; const bf16_t* Bt; int M, N, K, lda, ldb, a_pn_off; };
struct StaticOrder {
    int nM, nN, nwg, G, c;
    __host__ __device__ void init(int M, int N, int G_, int c_) { nM = M / BM; nN = N / BM; nwg = nM * nN; G = G_; c = c_; }
    __host__ __device__ bool next(int i, Unit& u) const {
        const long L = (long)i * G + c; if (L >= nwg) return false;
        int wgid = (int)L; { const int q = nwg / NXCD, r = nwg % NXCD, xcd = wgid % NXCD, off = wgid / NXCD; wgid = (xcd < r ? xcd * (q + 1) : r * (q + 1) + (xcd - r) * q) + off; }
        const int nig = WGM * nN, gid = wgid / nig, fm = gid * WGM, gsz = (nM - fm) < WGM ? (nM - fm) : WGM;
        u.pm = fm + ((wgid % nig) % gsz); u.pn = (wgid % nig) / gsz; return true;
    }
};
template <class Epi, class Sched>
__device__ __forceinline__ void gemm_phase(LAS unsigned char* lds, const Gemm g, const Sched& S, const Epi& E, const int tidx) {
    const int tid = tidx, wid = __builtin_amdgcn_readfirstlane(tid >> 6), lane = tid & 63, wr = wid >> 2, wc = wid & 3, fr = lane & 15, fq = lane >> 4;
    const int K = g.K, nt = K / BK;
    unsigned voffA[2], voffB[2];
#pragma unroll
    for (int i = 0; i < 2; ++i) { int R, C; stage_rc(tid * 16 + i * 8192, R, C); const int Rb = Epi::PERM ? ((R & ~31) + perm32(R & 31)) : R;
        voffA[i] = (unsigned)(R * g.lda + C) * 2u; voffB[i] = (unsigned)(Rb * g.ldb + C) * 2u; }
    const size_t kstep = (size_t)(BK * 2);
    const size_t hstepA = (size_t)HALF * g.lda * 2, hstepB = (size_t)HALF * g.ldb * 2;
    const size_t tstepA = 2 * hstepA, tstepB = 2 * hstepB;
    const unsigned ldsw = (unsigned)wid * 1024u;
    const int aoff = lds_byte(wr * 64 + fr, fq * 8), boff = lds_byte(wc * 32 + fr, fq * 8);
#define PG8_SA(b, h) (((b) * 2 + (h)) * HTB)
#define PG8_SB(b, h) ((4 + (b) * 2 + (h)) * HTB)
#define PG8_STAGE(bufoff, gbase, voff) do { _Pragma("unroll") for (int _i = 0; _i < 2; ++_i) \
        __builtin_amdgcn_global_load_lds((const unsigned*)((const char*)(gbase) + (voff)[_i]), (LAS unsigned*)(lds + (bufoff) + ldsw + _i * 8192), 16, 0, 0); } while (0)
#define PG8_LDA(dst, b, h) do { _Pragma("unroll") for (int m = 0; m < 4; ++m) _Pragma("unroll") for (int k = 0; k < 2; ++k) dst[m][k] = *(const LAS bf16x8*)(lds + PG8_SA(b, h) + aoff + m * 2048 + k * 1024); } while (0)
#define PG8_LDB(dst, b, h) do { _Pragma("unroll") for (int n = 0; n < 2; ++n) _Pragma("unroll") for (int k = 0; k < 2; ++k) dst[n][k] = *(const LAS bf16x8*)(lds + PG8_SB(b, h) + boff + n * 2048 + k * 1024); } while (0)
#define PG8_MMA(ai, bj, At, Bt) do { __builtin_amdgcn_s_setprio(1); _Pragma("unroll") for (int m = 0; m < 4; ++m) _Pragma("unroll") for (int n = 0; n < 2; ++n) _Pragma("unroll") for (int k = 0; k < 2; ++k) \
        acc[ai][bj][m][n] = __builtin_amdgcn_mfma_f32_16x16x32_bf16(Bt[n][k], At[m][k], acc[ai][bj][m][n], 0, 0, 0); __builtin_amdgcn_s_setprio(0); } while (0)
#define PG8_WAIT_V(n) asm volatile("s_waitcnt vmcnt(" #n ")" ::: "memory")
#define PG8_WAIT_L(n) asm volatile("s_waitcnt lgkmcnt(" #n ")" ::: "memory")
#define PG8_BAR __builtin_amdgcn_s_barrier()
#define PG8_SCHED __builtin_amdgcn_sched_barrier(0)
    Unit cur, nxt; int ui = 0;
    if (!S.next(0, cur)) return;
    f32x4 acc[2][2][4][2];
#pragma unroll
    for (int a = 0; a < 2; ++a)
#pragma unroll
        for (int b = 0; b < 2; ++b)
#pragma unroll
            for (int m = 0; m < 4; ++m)
#pragma unroll
                for (int n = 0; n < 2; ++n) acc[a][b][m][n] = (f32x4){0.f, 0.f, 0.f, 0.f};
    bf16x8 At[4][2], B0[2][2], B1[2][2];
    const char* cA = (const char*)g.A + (size_t)cur.pm * tstepA + (size_t)cur.pn * g.a_pn_off * 2; const char* cB = (const char*)g.Bt + (size_t)cur.pn * tstepB;
    PG8_STAGE(PG8_SB(0, 0), cB, voffB); PG8_STAGE(PG8_SB(0, 1), cB + hstepB, voffB); PG8_STAGE(PG8_SA(0, 0), cA, voffA); PG8_STAGE(PG8_SA(0, 1), cA + hstepA, voffA);
    if (wr == 1) PG8_BAR;
    PG8_WAIT_V(2); PG8_BAR;
    PG8_STAGE(PG8_SB(1, 0), cB + kstep, voffB); PG8_STAGE(PG8_SA(1, 0), cA + kstep, voffA); PG8_STAGE(PG8_SB(1, 1), cB + hstepB + kstep, voffB);
    PG8_WAIT_V(6); PG8_BAR;
    for (;;) {
        const bool has_next = S.next(ui + 1, nxt);
        const char* nA = has_next ? (const char*)g.A + (size_t)nxt.pm * tstepA + (size_t)nxt.pn * g.a_pn_off * 2 : cA; const char* nB = has_next ? (const char*)g.Bt + (size_t)nxt.pn * tstepB : cB;
        for (int t = 0; t < nt; t += 2) {
            const bool last = (t == nt - 2);
            const char* a1 = cA + (size_t)(t + 1) * kstep;
            const char* a2 = last ? nA : cA + (size_t)(t + 2) * kstep; const char* b2 = last ? nB : cB + (size_t)(t + 2) * kstep;
            const char* a3 = a2 + kstep; const char* b3 = b2 + kstep;
            PG8_LDB(B0, 0, 0); PG8_LDB(B1, 0, 1); PG8_SCHED; PG8_LDA(At, 0, 0); PG8_STAGE(PG8_SA(1, 1), a1 + hstepA, voffA);
            PG8_WAIT_V(8); PG8_WAIT_L(0); PG8_BAR; PG8_MMA(0, 0, At, B0); PG8_MMA(0, 1, At, B1); PG8_BAR; PG8_SCHED;
            PG8_LDA(At, 0, 1); PG8_STAGE(PG8_SB(0, 0), b2, voffB); PG8_STAGE(PG8_SB(0, 1), b2 + hstepB, voffB); PG8_STAGE(PG8_SA(0, 0), a2, voffA);
            PG8_WAIT_V(8); PG8_WAIT_L(0); PG8_BAR; PG8_MMA(1, 0, At, B0); PG8_MMA(1, 1, At, B1); PG8_BAR; PG8_SCHED;
            PG8_LDB(B0, 1, 0); PG8_LDB(B1, 1, 1); PG8_SCHED; PG8_LDA(At, 1, 0); PG8_STAGE(PG8_SA(0, 1), a2 + hstepA, voffA);
            PG8_WAIT_V(8); PG8_WAIT_L(0); PG8_BAR; PG8_MMA(0, 0, At, B0); PG8_MMA(0, 1, At, B1); PG8_BAR; PG8_SCHED;
            PG8_LDA(At, 1, 1); PG8_STAGE(PG8_SB(1, 0), b3, voffB); PG8_STAGE(PG8_SB(1, 1), b3 + hstepB, voffB); PG8_STAGE(PG8_SA(1, 0), a3, voffA);
            PG8_WAIT_V(8); PG8_WAIT_L(0); PG8_BAR; PG8_MMA(1, 0, At, B0); PG8_MMA(1, 1, At, B1); PG8_BAR; PG8_SCHED;
        }
        if (wr == 0) PG8_BAR;
        E(acc, cur, wr, wc, fr, fq);
        if (!has_next) break;
#pragma unroll
        for (int a = 0; a < 2; ++a)
#pragma unroll
            for (int b = 0; b < 2; ++b)
#pragma unroll
                for (int m = 0; m < 4; ++m)
#pragma unroll
                    for (int n = 0; n < 2; ++n) acc[a][b][m][n] = (f32x4){0.f, 0.f, 0.f, 0.f};
        cur = nxt; cA = nA; cB = nB; ++ui;
        if (wr == 1) PG8_BAR;
    }
    PG8_WAIT_V(0);
    PG8_BAR;
#undef PG8_SA
#undef PG8_SB
#undef PG8_STAGE
#undef PG8_LDA
#undef PG8_LDB
#undef PG8_MMA
#undef PG8_WAIT_V
#undef PG8_WAIT_L
#undef PG8_BAR
#undef PG8_SCHED
}

struct EpiBf16 {
    static constexpr bool PERM = true;
    bf16_t* O; int ldc;
    __device__ __forceinline__ void operator()(const f32x4 (&acc)[2][2][4][2], const Unit& u, int wr, int wc, int fr, int fq) const {
        const int row0 = u.pm * BM + wr * 64 + fr, col0 = u.pn * BM + wc * 32 + 8 * fq;
#pragma unroll
        for (int ai = 0; ai < 2; ++ai)
#pragma unroll
            for (int m = 0; m < 4; ++m) { bf16_t* rowp = O + (size_t)(row0 + ai * HALF + m * 16) * ldc + col0;
#pragma unroll
                for (int bj = 0; bj < 2; ++bj) { const f32x4 v0 = acc[ai][bj][m][0], v1 = acc[ai][bj][m][1]; u32x4 w;
                    w.x = cvt_pk_bf16(v0[0], v0[1]); w.y = cvt_pk_bf16(v0[2], v0[3]); w.z = cvt_pk_bf16(v1[0], v1[1]); w.w = cvt_pk_bf16(v1[2], v1[3]);
                    *(u32x4*)(rowp + bj * HALF) = w; } }
    }
};
struct EpiCols {
    static constexpr bool PERM = true;
    bf16_t* O; float* gates; float* ssq;
    __device__ __forceinline__ void operator()(const f32x4 (&acc)[2][2][4][2], const Unit& u, int wr, int wc, int fr, int fq) const {
        const int row0 = u.pm * BM + wr * 64 + fr, col0 = u.pn * BM + wc * 32 + 8 * fq;
#pragma unroll
        for (int ai = 0; ai < 2; ++ai)
#pragma unroll
            for (int m = 0; m < 4; ++m) { const int row = row0 + ai * HALF + m * 16; bf16_t* rowp = O + (size_t)row * INCP + col0;
                float s0 = 0.f, s1 = 0.f;
#pragma unroll
                for (int bj = 0; bj < 2; ++bj) { const f32x4 v0 = acc[ai][bj][m][0], v1 = acc[ai][bj][m][1]; u32x4 w;
                    w.x = cvt_pk_bf16(v0[0], v0[1]); w.y = cvt_pk_bf16(v0[2], v0[3]); w.z = cvt_pk_bf16(v1[0], v1[1]); w.w = cvt_pk_bf16(v1[2], v1[3]);
                    *(u32x4*)(rowp + bj * HALF) = w;
                    const float s = (v0[0] * v0[0] + v0[1] * v0[1]) + (v0[2] * v0[2] + v0[3] * v0[3]) + (v1[0] * v1[0] + v1[1] * v1[1]) + (v1[2] * v1[2] + v1[3] * v1[3]);
                    if (bj == 0) s0 = s; else s1 = s; }
                if (u.pn == 0) { float s = s0 + s1; s += __shfl_xor(s, 16); s += __shfl_xor(s, 32); if (fq == 0) ssq[row * 8 + wc] = s; }
                if (u.pn == 1) { float s = s0; s += __shfl_xor(s, 16); s += __shfl_xor(s, 32); if (fq == 0) ssq[row * 8 + 4 + wc] = s; }
                if (u.pn == 7 && wc == 2 && fq < 2) { *(f32x4*)(gates + (size_t)row * 16 + 8 * fq) = acc[ai][1][m][0]; *(f32x4*)(gates + (size_t)row * 16 + 8 * fq + 4) = acc[ai][1][m][1]; }
            }
    }
};
struct EpiResid {
    static constexpr bool PERM = true;
    const float* base; bf16_t* out; const float* mod; int gate_off; float gscale;
    __device__ __forceinline__ void operator()(const f32x4 (&acc)[2][2][4][2], const Unit& u, int wr, int wc, int fr, int fq) const {
        const int row0 = u.pm * BM + wr * 64 + fr, col0 = u.pn * BM + wc * 32 + 8 * fq;
        const int b = (u.pm * BM) / T;
        f32x4 gv[2][2];
#pragma unroll
        for (int bj = 0; bj < 2; ++bj)
#pragma unroll
            for (int n = 0; n < 2; ++n) gv[bj][n] = *(const f32x4*)(mod + (size_t)b * NMOD + gate_off + col0 + bj * HALF + n * 4) * gscale;
#pragma unroll
        for (int ai = 0; ai < 2; ++ai)
#pragma unroll
            for (int m2 = 0; m2 < 4; m2 += 2) { f32x4 bs[2][2][2];
#pragma unroll
                for (int mm = 0; mm < 2; ++mm) { const size_t off = (size_t)(row0 + ai * HALF + (m2 + mm) * 16) * D + col0;
#pragma unroll
                    for (int bj = 0; bj < 2; ++bj)
#pragma unroll
                        for (int n = 0; n < 2; ++n) bs[mm][bj][n] = *(const f32x4*)(base + off + bj * HALF + n * 4); }
#pragma unroll
                for (int mm = 0; mm < 2; ++mm) { const size_t off = (size_t)(row0 + ai * HALF + (m2 + mm) * 16) * D + col0;
#pragma unroll
                    for (int bj = 0; bj < 2; ++bj) { const f32x4 r0 = bs[mm][bj][0] + gv[bj][0] * acc[ai][bj][m2 + mm][0], r1 = bs[mm][bj][1] + gv[bj][1] * acc[ai][bj][m2 + mm][1]; u32x4 w_;
                        w_.x = cvt_pk_bf16(r0[0], r0[1]); w_.y = cvt_pk_bf16(r0[2], r0[3]); w_.z = cvt_pk_bf16(r1[0], r1[1]); w_.w = cvt_pk_bf16(r1[2], r1[3]);
                        *(u32x4*)(out + off + bj * HALF) = w_; } } }
    }
};
struct EpiKV {
    static constexpr bool PERM = true;
    const bf16_t* cols; const float* ssq; const float* g_kn; const float* rt; bf16_t* Kb; bf16_t* Vb; LAS unsigned char* xl; int tidx;
    __device__ __forceinline__ void operator()(const f32x4 (&acc)[2][2][4][2], const Unit& u, int wr_, int wc_, int fr_, int fq_) const {
        int fr = fr_, fq = fq_, tix = tidx, wr = wr_, wc = wc_; asm volatile("" : "+v"(fr), "+v"(fq), "+v"(tix), "+s"(wr), "+s"(wc));
        LAS float* P = (LAS float*)xl;
        LAS float* KR = P + 1024;
        LAS float* RK = KR + 256;
        LAS float* RKV = RK + 256;
        const int h = u.pn, rowbase = u.pm * BM;
        const bool lat = rowbase < NLAT; const int b = lat ? rowbase / T : (rowbase - NLAT) / TC; const int key0 = lat ? TC + rowbase % T : 0, t0 = lat ? rowbase % T : 0;
#pragma unroll
        for (int ai = 0; ai < 2; ++ai)
#pragma unroll
            for (int m = 0; m < 4; ++m) { const f32x4 v0 = acc[ai][0][m][0], v1 = acc[ai][0][m][1];
                float s = (v0[0] * v0[0] + v0[1] * v0[1]) + (v0[2] * v0[2] + v0[3] * v0[3]) + (v1[0] * v1[0] + v1[1] * v1[1]) + (v1[2] * v1[2] + v1[3] * v1[3]);
                s += __shfl_xor(s, 16); s += __shfl_xor(s, 32);
                if (fq == 0) P[(ai * HALF + wr * 64 + m * 16 + fr) * 4 + wc] = s; }
        const int rrow = tix >> 1, half = tix & 1;
        const bf16_t* krp = cols + (size_t)(rowbase + rrow) * INCP + C_KR + 32 * half;
        { float ss = 0.f;
#pragma unroll
          for (int c4 = 0; c4 < 4; ++c4) { const u32x4 kk = *(const u32x4*)(krp + 8 * c4);
#pragma unroll
              for (int q = 0; q < 4; ++q) { const float lo = bf_lo(kk[q]), hi = bf_hi(kk[q]); ss += lo * lo + hi * hi; } }
          ss += __shfl_xor(ss, 1); if (half == 0) KR[rrow] = ss; }
        asm volatile("s_waitcnt lgkmcnt(0)" ::: "memory"); __builtin_amdgcn_s_barrier(); asm volatile("" ::: "memory");
        if (tix < 256) { const f32x4 sk4 = *(const f32x4*)(ssq + (size_t)(rowbase + tix) * 8 + 4);
            const float rkv = rsqrtf(((sk4[0] + sk4[1]) + (sk4[2] + sk4[3])) * (1.f / 128.f) + EPS);
            const float sn = ((P[tix * 4] + P[tix * 4 + 1]) + (P[tix * 4 + 2] + P[tix * 4 + 3])) * rkv * rkv;
            RKV[tix] = rkv; RK[tix] = rsqrtf((sn + KR[tix]) * (1.f / 192.f) + EPS); }
        asm volatile("s_waitcnt lgkmcnt(0)" ::: "memory"); __builtin_amdgcn_s_barrier(); asm volatile("" ::: "memory");
        const int col0 = wc * 32 + 8 * fq;
        f32x4 g0 = *(const f32x4*)(g_kn + col0), g1 = *(const f32x4*)(g_kn + col0 + 4);
#pragma unroll
        for (int ai = 0; ai < 2; ++ai)
#pragma unroll
            for (int m = 0; m < 4; ++m) { const int r = ai * HALF + wr * 64 + m * 16 + fr; const float rkv = RKV[r], sk = rkv * RK[r];
                const size_t kvrow = ((size_t)b * NH + h) * NKEY + key0 + r;
                { const f32x4 v0 = acc[ai][0][m][0] * sk * g0, v1 = acc[ai][0][m][1] * sk * g1; u32x4 w;
                  w.x = cvt_pk_bf16(v0[0], v0[1]); w.y = cvt_pk_bf16(v0[2], v0[3]); w.z = cvt_pk_bf16(v1[0], v1[1]); w.w = cvt_pk_bf16(v1[2], v1[3]); *(u32x4*)(Kb + kvrow * DQK + col0) = w; }
                { const f32x4 v0 = acc[ai][1][m][0] * rkv, v1 = acc[ai][1][m][1] * rkv; u32x4 w;
                  w.x = cvt_pk_bf16(v0[0], v0[1]); w.y = cvt_pk_bf16(v0[2], v0[3]); w.z = cvt_pk_bf16(v1[0], v1[1]); w.w = cvt_pk_bf16(v1[2], v1[3]); *(u32x4*)(Vb + kvrow * DV + col0) = w; } }
        { const float rk = RK[rrow]; const int t = t0 + rrow; const int pos = half ? (t & 63) : (t >> 6);
          const float* gk = g_kn + 128 + 32 * half;
          bf16_t* kp = Kb + (((size_t)b * NH + h) * NKEY + key0 + rrow) * DQK + 128 + 32 * half;
#pragma unroll
          for (int hf = 0; hf < 2; ++hf) {
              const u32x4 ka = *(const u32x4*)(krp + 8 * hf), kb2 = *(const u32x4*)(krp + 16 + 8 * hf);
              float oa[8], ob[8];
#pragma unroll
              for (int q = 0; q < 8; ++q) { const int j = 8 * hf + q; float cs = 1.f, sn = 0.f; if (lat) { cs = rt[(pos * 16 + j) * 2]; sn = rt[(pos * 16 + j) * 2 + 1]; }
                  const float av = ((q & 1) ? bf_hi(ka[q >> 1]) : bf_lo(ka[q >> 1])) * rk * gk[j], cv = ((q & 1) ? bf_hi(kb2[q >> 1]) : bf_lo(kb2[q >> 1])) * rk * gk[16 + j];
                  oa[q] = av * cs - cv * sn; ob[q] = cv * cs + av * sn; }
              u32x4 w; w.x = cvt_pk_bf16(oa[0], oa[1]); w.y = cvt_pk_bf16(oa[2], oa[3]); w.z = cvt_pk_bf16(oa[4], oa[5]); w.w = cvt_pk_bf16(oa[6], oa[7]); *(u32x4*)(kp + 8 * hf) = w;
              w.x = cvt_pk_bf16(ob[0], ob[1]); w.y = cvt_pk_bf16(ob[2], ob[3]); w.z = cvt_pk_bf16(ob[4], ob[5]); w.w = cvt_pk_bf16(ob[6], ob[7]); *(u32x4*)(kp + 16 + 8 * hf) = w; } }
        asm volatile("s_waitcnt lgkmcnt(0)" ::: "memory"); __builtin_amdgcn_s_barrier(); asm volatile("" ::: "memory");
    }
};
struct EpiQ {
    static constexpr bool PERM = true;
    const float* ssq; const float* g_qn; const float* rt; bf16_t* Q; LAS unsigned char* xl; int tidx;
    __device__ __forceinline__ void operator()(const f32x4 (&acc)[2][2][4][2], const Unit& u, int wr_, int wc_, int fr_, int fq_) const {
        int fr = fr_, fq = fq_, tix = tidx, wr = wr_, wc = wc_; asm volatile("" : "+v"(fr), "+v"(fq), "+v"(tix), "+s"(wr), "+s"(wc));
        LAS float* P = (LAS float*)xl;
        LAS float* RS = P + 1024;
        const int h = u.pn, rowbase = u.pm * BM; const int b = rowbase / T, t0 = rowbase % T;
#pragma unroll
        for (int ai = 0; ai < 2; ++ai)
#pragma unroll
            for (int m = 0; m < 4; ++m) { float s = 0.f;
#pragma unroll
                for (int bj = 0; bj < 2; ++bj) { const f32x4 v0 = acc[ai][bj][m][0], v1 = acc[ai][bj][m][1];
                    s += (v0[0] * v0[0] + v0[1] * v0[1]) + (v0[2] * v0[2] + v0[3] * v0[3]) + (v1[0] * v1[0] + v1[1] * v1[1]) + (v1[2] * v1[2] + v1[3] * v1[3]); }
                s += __shfl_xor(s, 16); s += __shfl_xor(s, 32);
                if (fq == 0) P[(ai * HALF + wr * 64 + m * 16 + fr) * 4 + wc] = s; }
        asm volatile("s_waitcnt lgkmcnt(0)" ::: "memory"); __builtin_amdgcn_s_barrier(); asm volatile("" ::: "memory");
        if (tix < 256) { const f32x4 sq4 = *(const f32x4*)(ssq + (size_t)(rowbase + tix) * 8);
            const float rq = rsqrtf(((sq4[0] + sq4[1]) + (sq4[2] + sq4[3])) * (1.f / 256.f) + EPS);
            const float sn = ((P[tix * 4] + P[tix * 4 + 1]) + (P[tix * 4 + 2] + P[tix * 4 + 3])) * rq * rq;
            RS[tix] = rq * rsqrtf(sn * (1.f / 192.f) + EPS); }
        asm volatile("s_waitcnt lgkmcnt(0)" ::: "memory"); __builtin_amdgcn_s_barrier(); asm volatile("" ::: "memory");
        const int col0 = wc * 32 + 8 * fq;
        { const f32x4 g0 = *(const f32x4*)(g_qn + col0), g1 = *(const f32x4*)(g_qn + col0 + 4);
#pragma unroll
          for (int ai = 0; ai < 2; ++ai)
#pragma unroll
            for (int m = 0; m < 4; ++m) { const int r = ai * HALF + wr * 64 + m * 16 + fr; const float sc = RS[r];
                const f32x4 v0 = acc[ai][0][m][0] * sc * g0, v1 = acc[ai][0][m][1] * sc * g1; u32x4 w;
                w.x = cvt_pk_bf16(v0[0], v0[1]); w.y = cvt_pk_bf16(v0[2], v0[3]); w.z = cvt_pk_bf16(v1[0], v1[1]); w.w = cvt_pk_bf16(v1[2], v1[3]);
                *(u32x4*)(Q + (((size_t)b * NH + h) * T + t0 + r) * DQK + col0) = w; } }
        if (wc < 2) {
            const f32x4 g0 = *(const f32x4*)(g_qn + 128 + col0), g1 = *(const f32x4*)(g_qn + 128 + col0 + 4);
            const bool second = fq >= 2; const int fi0 = (8 * fq) & 15;
#pragma unroll
            for (int ai = 0; ai < 2; ++ai)
#pragma unroll
                for (int m = 0; m < 4; ++m) { const int r = ai * HALF + wr * 64 + m * 16 + fr; const float sc = RS[r];
                    const int t = t0 + r; const int pos = wc ? (t & 63) : (t >> 6);
                    const f32x4 v0 = acc[ai][1][m][0] * sc * g0, v1 = acc[ai][1][m][1] * sc * g1; float o[8];
#pragma unroll
                    for (int q = 0; q < 8; ++q) { const float own = q < 4 ? v0[q & 3] : v1[q & 3];
                        auto r_ = __builtin_amdgcn_permlane32_swap(__float_as_uint(own), __float_as_uint(own), false, false);
                        const float oth = second ? __uint_as_float(r_[0]) : __uint_as_float(r_[1]);
                        const f32x2 cs = *(const f32x2*)(rt + (pos * 16 + fi0 + q) * 2);
                        o[q] = second ? (own * cs[0] + oth * cs[1]) : (own * cs[0] - oth * cs[1]); }
                    u32x4 w; w.x = cvt_pk_bf16(o[0], o[1]); w.y = cvt_pk_bf16(o[2], o[3]); w.z = cvt_pk_bf16(o[4], o[5]); w.w = cvt_pk_bf16(o[6], o[7]);
                    *(u32x4*)(Q + (((size_t)b * NH + h) * T + t0 + r) * DQK + 128 + col0) = w; } }
        asm volatile("s_waitcnt lgkmcnt(0)" ::: "memory"); __builtin_amdgcn_s_barrier(); asm volatile("" ::: "memory");
    }
};
}

template <int CTRL> __device__ __forceinline__ int dppi(int v) { return __builtin_amdgcn_update_dpp(0, v, CTRL, 0xf, 0xf, true); }
template <int CTRL> __device__ __forceinline__ float dppf(float v) { return __int_as_float(__builtin_amdgcn_update_dpp(0, __float_as_int(v), CTRL, 0xf, 0xf, true)); }
__device__ __forceinline__ int row_sum_i(int d) { d += dppi<0xB1>(d); d += dppi<0x4E>(d); d += dppi<0x141>(d); d += dppi<0x140>(d); return d; }
__device__ __forceinline__ float row_sum_f(float d) { d += dppf<0xB1>(d); d += dppf<0x4E>(d); d += dppf<0x141>(d); d += dppf<0x140>(d); return d; }
__device__ __forceinline__ float wave_sum_fast(float v) {
    v = row_sum_f(v);
    { auto r = __builtin_amdgcn_permlane16_swap(__float_as_uint(v), __float_as_uint(v), false, false); v = __uint_as_float(r[0]) + __uint_as_float(r[1]); }
    { auto r = __builtin_amdgcn_permlane32_swap(__float_as_uint(v), __float_as_uint(v), false, false); v = __uint_as_float(r[0]) + __uint_as_float(r[1]); }
    return v;
}
__device__ __forceinline__ float wave_max_fast(float v) {
    v = fmaxf(v, dppf<0xB1>(v)); v = fmaxf(v, dppf<0x4E>(v)); v = fmaxf(v, dppf<0x141>(v)); v = fmaxf(v, dppf<0x140>(v));
    { auto r = __builtin_amdgcn_permlane16_swap(__float_as_uint(v), __float_as_uint(v), false, false); v = fmaxf(__uint_as_float(r[0]), __uint_as_float(r[1])); }
    { auto r = __builtin_amdgcn_permlane32_swap(__float_as_uint(v), __float_as_uint(v), false, false); v = fmaxf(__uint_as_float(r[0]), __uint_as_float(r[1])); }
    return v;
}
__device__ __forceinline__ float wave_max(float v) {
#pragma unroll
    for (int o = 1; o < 64; o <<= 1) v = fmaxf(v, __shfl_xor(v, o));
    return v;
}
__device__ __forceinline__ unsigned q8pack(f32x4 v, float inv, int bias) {
    int a = __float2int_rn(v[0] * inv), b = __float2int_rn(v[1] * inv), c = __float2int_rn(v[2] * inv), d = __float2int_rn(v[3] * inv);
    a = min(127, max(-127, a)) + bias; b = min(127, max(-127, b)) + bias; c = min(127, max(-127, c)) + bias; d = min(127, max(-127, d)) + bias;
    return (unsigned)(a & 0xff) | ((unsigned)(b & 0xff) << 8) | ((unsigned)(c & 0xff) << 16) | ((unsigned)(d & 0xff) << 24);
}
template <bool SLICED> __device__ __forceinline__ void quant_row(const float* src, unsigned* dst, float* scale, int bias, int lane, int row) {
    f32x4 v[4]; float m = 0.f;
#pragma unroll
    for (int j = 0; j < 4; ++j) { v[j] = ((const f32x4*)src)[lane + 64 * j]; m = fmaxf(m, fmaxf(fmaxf(fabsf(v[j][0]), fabsf(v[j][1])), fmaxf(fabsf(v[j][2]), fabsf(v[j][3])))); }
    m = fmaxf(wave_max(m), 1e-30f); const float inv = 127.f / m;
#pragma unroll
    for (int j = 0; j < 4; ++j) { if (SLICED) dst[(size_t)(2 * j + (lane >> 5)) * (NEXP * 32) + (size_t)row * 32 + (lane & 31)] = q8pack(v[j], inv, bias); else { const int d_ = lane + 64 * j; dst[((size_t)(pe_slice(row) * 32 + (d_ >> 3)) * 2048 + pe_local((unsigned)row)) * 8 + (d_ & 7)] = q8pack(v[j], inv, bias); } }
    if (lane == 0) *scale = m * (1.f / 127.f);
}
template <bool QPAD = false> __device__ __forceinline__ void transpose_item(const float* W, int K, int N, int Npad, const float* kscale, bf16_t* WT, LAS float* scr, int item, int lane) {
    const int nblk = Npad / 32, kb = item / nblk, nb = item % nblk, k0 = 64 * kb, n0 = 32 * nb;
    const int d0 = QPAD ? (nb / 6) * 256 + (nb % 6) * 32 : n0;
#pragma unroll
    for (int i = 0; i < 32; ++i) { const int kk = 2 * i + (lane >> 5); const int n = n0 + (lane & 31);
        float v = (n < N) ? W[(size_t)(k0 + kk) * N + n] : 0.f; if (kscale) v *= kscale[k0 + kk]; scr[kk * 33 + (lane & 31)] = v; }
    asm volatile("s_waitcnt lgkmcnt(0)" ::: "memory");
    const int c = lane & 7;
#pragma unroll
    for (int j = 0; j < 4; ++j) { const int n = (lane >> 3) + 8 * j; const LAS float* s = scr + (8 * c) * 33 + n;
        u32x4 o; o.x = cvt_pk_bf16(s[0 * 33], s[1 * 33]); o.y = cvt_pk_bf16(s[2 * 33], s[3 * 33]); o.z = cvt_pk_bf16(s[4 * 33], s[5 * 33]); o.w = cvt_pk_bf16(s[6 * 33], s[7 * 33]);
        *(u32x4*)(WT + (size_t)(d0 + n) * K + k0 + 8 * c) = o; }
    asm volatile("s_waitcnt lgkmcnt(0)" ::: "memory");
}

__device__ __forceinline__ void phase_prep(const Params& p, LAS unsigned char* lds, const int tidx) {
    const int tid = tidx, lane = tid & 63, wave = tid >> 6;
    const int gw = blockIdx.x * NWAVES + wave, NGW = gridDim.x * NWAVES;
    LAS float* scr = (LAS float*)(lds + wave * 8704);
    unsigned char* ws = p.ws;
    constexpr int I_IN = (D / 64) * (INCP / 32), I_UQ = (256 / 64) * (768 / 32), I_UKV = (128 / 64) * (1024 / 32), I_OUT = (D / 64) * (D / 32), I_PQ = (D / 64) * (2048 / 32);
    constexpr int NITEMS = I_IN + I_UQ + I_UKV + I_OUT + I_PQ;
    if (blockIdx.x < 96) {
      LAS float* part = (LAS float*)(lds + 8 * 8704);
      LAS float* sil = part + 8 * 9 * 64;
      { float cv[9 * D / NTHREADS];
#pragma unroll
        for (int u = 0; u < 9 * D / NTHREADS; ++u) { const int i = tid + u * NTHREADS; const int q = i >> 10, k = i & 1023; cv[u] = q < 8 ? p.c[q * D + k] : p.c_ctx[k]; }
#pragma unroll
        for (int u = 0; u < 9 * D / NTHREADS; ++u) sil[tid + u * NTHREADS] = siluf(cv[u]); }
      __syncthreads();
      for (int cgp = blockIdx.x; cgp < 96; cgp += gridDim.x) {
        const int col = cgp * 64 + lane;
        float acc[9];
#pragma unroll
        for (int q = 0; q < 9; ++q) acc[q] = 0.f;
        for (int k0 = 0; k0 < 128; k0 += 64) { float wv[64];
#pragma unroll
            for (int kk = 0; kk < 64; ++kk) wv[kk] = p.w_ada[(size_t)(wave * 128 + k0 + kk) * NMOD + col];
#pragma unroll
            for (int kk = 0; kk < 64; ++kk) { const int k = wave * 128 + k0 + kk;
#pragma unroll
                for (int q = 0; q < 9; ++q) acc[q] += sil[q * D + k] * wv[kk]; } }
        __syncthreads();
#pragma unroll
        for (int q = 0; q < 9; ++q) part[(wave * 9 + q) * 64 + lane] = acc[q];
        __syncthreads();
        float* mod = (float*)(ws + WS_MOD);
        for (int o = tid; o < 9 * 64; o += NTHREADS) { const int q = o >> 6, cl = o & 63; float s = p.b_ada[cgp * 64 + cl];
#pragma unroll
            for (int w8 = 0; w8 < 8; ++w8) s += part[(w8 * 9 + q) * 64 + cl];
            mod[q * NMOD + cgp * 64 + cl] = s; }
      } }
    const bool split = gridDim.x > 96u + 32u;
    const int tgw = split ? ((int)blockIdx.x - 96) * NWAVES + wave : gw, TNGW = split ? ((int)gridDim.x - 96) * NWAVES : NGW;
    for (int it = (tgw >= 0 ? tgw : NITEMS); it < NITEMS; it += TNGW) {
        int r = it;
        if (r < I_IN) { transpose_item(p.w_in, D, INC, INCP, nullptr, (bf16_t*)(ws + WS_WIN), scr, r, lane); continue; } r -= I_IN;
        if (r < I_UQ) { transpose_item<true>(p.w_uq, 256, 768, 768, p.g_cq, (bf16_t*)(ws + WS_WUQ), scr, r, lane); continue; } r -= I_UQ;
        if (r < I_UKV) { transpose_item(p.w_ukv, 128, 1024, 1024, p.g_ckv, (bf16_t*)(ws + WS_WUKV), scr, r, lane); continue; } r -= I_UKV;
        if (r < I_OUT) { transpose_item(p.w_out, D, D, D, nullptr, (bf16_t*)(ws + WS_WOUT), scr, r, lane); continue; } r -= I_OUT;
        transpose_item(p.w_pq, D, 2048, 2048, nullptr, (bf16_t*)(ws + WS_WPQ), scr, r, lane);
    }
    const int gt = blockIdx.x * NTHREADS + tid, NGT = gridDim.x * NTHREADS;
    { bf16_t* wq = (bf16_t*)(ws + WS_WUQ);
      for (int i = gt; i < 4 * 64 * 256 / 8; i += NGT) { const int hd = i / (64 * 32), rem = i % (64 * 32); *(u32x4*)(wq + ((size_t)hd * 256 + 192) * 256 + (size_t)rem * 8) = (u32x4){0u, 0u, 0u, 0u}; } }
    { bf16_t* skb = (bf16_t*)(ws + WS_SKB);
      for (int i = gt; i < PH * 2 * NKEYS * 128 / 4; i += NGT) { const f32x4 v = ((const f32x4*)p.sub_keys)[i]; u32x2 o; o.x = cvt_pk_bf16(v[0], v[1]); o.y = cvt_pk_bf16(v[2], v[3]); ((u32x2*)skb)[i] = o; } }
    { float* rt = (float*)(ws + WS_ROPE);
      for (int i = gt; i < 64 * 16; i += NGT) { const int pos = i >> 4, j = i & 15; const float inv = powf(10000.f, -(float)j * (2.0f / 32.0f)); const float ang = (float)pos * inv;
          rt[2 * i] = cosf(ang); rt[2 * i + 1] = sinf(ang); } }
}

__device__ __forceinline__ void quant_experts(const Params& p, LAS unsigned char* lds, int vb, int nvb, const int tidx) {
    const int lane = tidx & 63, wave = tidx >> 6; unsigned char* ws = p.ws;
    unsigned* eu8 = (unsigned*)(ws + WS_EU8); unsigned* ev8 = (unsigned*)(ws + WS_EV8); float* su = (float*)(ws + WS_SU); float* sv = (float*)(ws + WS_SV);
    LAS unsigned* stg = (LAS unsigned*)(lds + wave * 4096);
    __syncthreads();
    constexpr int NUU = NEXP / 4;
    for (int u = vb * NWAVES + wave; u < NUU + NEXP; u += nvb * NWAVES) {
        if (u < NUU) { const int i = u >> 5, x = (u >> 2) & 7, q = u & 3, c0 = (x - i) & 7;
#pragma unroll
            for (int mm = 0; mm < 4; ++mm) { const int e = i * 128 + 8 * (4 * q + mm) + c0; const float* src = p.expert_u + (size_t)e * D;
                f32x4 v[4]; float m = 0.f;
#pragma unroll
                for (int j = 0; j < 4; ++j) { v[j] = ((const f32x4*)src)[lane + 64 * j]; m = fmaxf(m, fmaxf(fmaxf(fabsf(v[j][0]), fabsf(v[j][1])), fmaxf(fabsf(v[j][2]), fabsf(v[j][3])))); }
                m = fmaxf(wave_max(m), 1e-30f); const float inv = 127.f / m;
#pragma unroll
                for (int j = 0; j < 4; ++j) stg[mm * 256 + lane + 64 * j] = q8pack(v[j], inv, 0);
                if (lane == 0) su[e] = m * (1.f / 127.f); }
            asm volatile("s_waitcnt lgkmcnt(0)" ::: "memory");
            const int ll = lane & 31, mm = ll >> 3, dw = ll & 7;
#pragma unroll
            for (int t = 0; t < 16; ++t) { const int cs = 2 * t + (lane >> 5);
                eu8[((size_t)(x * 32 + cs) * 2048 + i * 16 + 4 * q + mm) * 8 + dw] = stg[mm * 256 + cs * 8 + dw]; }
            asm volatile("s_waitcnt lgkmcnt(0)" ::: "memory");
        } else { const int e = u - NUU; quant_row<true>(p.expert_v + (size_t)e * D, ev8, sv + e, 0, lane, e); } }
}
__device__ __forceinline__ void norm_mod_row(const float* src, const float* g, const float* sh, const float* sc, bf16_t* dst, int lane) {
    f32x4 v[4]; float s = 0.f;
#pragma unroll
    for (int j = 0; j < 4; ++j) { v[j] = ((const f32x4*)src)[lane + 64 * j]; s += (v[j][0] * v[j][0] + v[j][1] * v[j][1]) + (v[j][2] * v[j][2] + v[j][3] * v[j][3]); }
    const float rstd = rsqrtf(wave_sum(s) * (1.f / D) + EPS);
#pragma unroll
    for (int j = 0; j < 4; ++j) { const int i4 = lane + 64 * j; const f32x4 gg = ((const f32x4*)g)[i4], s1 = ((const f32x4*)sc)[i4], h1 = ((const f32x4*)sh)[i4];
        const f32x4 o = v[j] * rstd * gg * (s1 + 1.f) + h1; u32x2 w; w.x = cvt_pk_bf16(o[0], o[1]); w.y = cvt_pk_bf16(o[2], o[3]); ((u32x2*)dst)[i4] = w; }
}
__device__ __forceinline__ void phase_hnorm(const Params& p, const int tidx) {
    const int lane = tidx & 63, wave = tidx >> 6;
    const int gw = blockIdx.x * NWAVES + wave, NGW = gridDim.x * NWAVES;
    const float* mod = (const float*)(p.ws + WS_MOD); bf16_t* hb = (bf16_t*)(p.ws + WS_HB);
    f32x4 na[4] = {}, nb[4] = {};
    auto srcof = [&](int row) { return row < NLAT ? p.x + (size_t)row * D : p.ctx + (size_t)(row - NLAT) * D; };
    auto fetch = [&](f32x4 (&d)[4], int row) { if (row < NTOK) { const float* s_ = srcof(row);
#pragma unroll
        for (int j = 0; j < 4; ++j) d[j] = ((const f32x4*)s_)[lane + 64 * j]; } };
    auto finish = [&](const f32x4 (&v)[4], int row) {
        const int mr = row < NLAT ? row / T : 8; const float* sh = mod + (size_t)mr * NMOD, * sc = sh + D; bf16_t* dst = hb + (size_t)row * D;
        float s = 0.f;
#pragma unroll
        for (int j = 0; j < 4; ++j) s += (v[j][0] * v[j][0] + v[j][1] * v[j][1]) + (v[j][2] * v[j][2] + v[j][3] * v[j][3]);
        const float rstd = rsqrtf(wave_sum_fast(s) * (1.f / D) + EPS);
#pragma unroll
        for (int j = 0; j < 4; ++j) { const int i4 = lane + 64 * j; const f32x4 gg = ((const f32x4*)p.g_norm1)[i4], s1 = ((const f32x4*)sc)[i4], h1 = ((const f32x4*)sh)[i4];
            const f32x4 o = v[j] * rstd * gg * (s1 + 1.f) + h1; u32x2 w; w.x = cvt_pk_bf16(o[0], o[1]); w.y = cvt_pk_bf16(o[2], o[3]); ((u32x2*)dst)[i4] = w; } };
    fetch(na, gw); fetch(nb, gw + NGW);
    for (int row = gw; row < NTOK; row += 2 * NGW) {
        f32x4 ca[4];
#pragma unroll
        for (int j = 0; j < 4; ++j) ca[j] = na[j];
        fetch(na, row + 2 * NGW);
        finish(ca, row);
        if (row + NGW < NTOK) {
#pragma unroll
            for (int j = 0; j < 4; ++j) ca[j] = nb[j];
            fetch(nb, row + 3 * NGW);
            finish(ca, row + NGW);
        }
    }
}

__device__ __forceinline__ int ml_row0(int b, int blk) { return blk == 0 ? NLAT + b * TC : b * T + (blk - 1) * MCH; }
__device__ __forceinline__ void conv_silu8(const bf16_t* cols, const LAS float* cw, int row, int seg_lo, int seg_hi, int ch0, float (&o)[8]) {
    const u32x4 z = {0u, 0u, 0u, 0u};
    const u32x4 a = (row - 1 >= seg_lo) ? *(const u32x4*)(cols + (size_t)(row - 1) * INCP + C_MQ + ch0) : z;
    const u32x4 b = *(const u32x4*)(cols + (size_t)row * INCP + C_MQ + ch0);
    const u32x4 c = (row + 1 < seg_hi) ? *(const u32x4*)(cols + (size_t)(row + 1) * INCP + C_MQ + ch0) : z;
    f32x4 w0[2], w1[2], w2[2];
#pragma unroll
    for (int q = 0; q < 2; ++q) { w0[q] = *(const LAS f32x4*)(cw + ch0 + 4 * q); w1[q] = *(const LAS f32x4*)(cw + 512 + ch0 + 4 * q); w2[q] = *(const LAS f32x4*)(cw + 1024 + ch0 + 4 * q); }
#pragma unroll
    for (int i = 0; i < 4; ++i) { const int q = i >> 1, e = 2 * (i & 1);
        o[2 * i] = siluf(w0[q][e] * bf_lo(a[i]) + w1[q][e] * bf_lo(b[i]) + w2[q][e] * bf_lo(c[i]));
        o[2 * i + 1] = siluf(w0[q][e + 1] * bf_hi(a[i]) + w1[q][e + 1] * bf_hi(b[i]) + w2[q][e + 1] * bf_hi(c[i])); }
}
__device__ __forceinline__ void conv_silu8_g(const bf16_t* cols, const float* convw, int row, int seg_lo, int seg_hi, int ch0, float (&o)[8]) {
    const u32x4 z = {0u, 0u, 0u, 0u};
    const u32x4 a = (row - 1 >= seg_lo) ? *(const u32x4*)(cols + (size_t)(row - 1) * INCP + C_MQ + ch0) : z;
    const u32x4 b = *(const u32x4*)(cols + (size_t)row * INCP + C_MQ + ch0);
    const u32x4 c = (row + 1 < seg_hi) ? *(const u32x4*)(cols + (size_t)(row + 1) * INCP + C_MQ + ch0) : z;
#pragma unroll
    for (int i = 0; i < 4; ++i) {
        const float w0a = convw[0 * 512 + ch0 + 2 * i], w1a = convw[1 * 512 + ch0 + 2 * i], w2a = convw[2 * 512 + ch0 + 2 * i];
        const float w0b = convw[0 * 512 + ch0 + 2 * i + 1], w1b = convw[1 * 512 + ch0 + 2 * i + 1], w2b = convw[2 * 512 + ch0 + 2 * i + 1];
        o[2 * i] = siluf(w0a * bf_lo(a[i]) + w1a * bf_lo(b[i]) + w2a * bf_lo(c[i]));
        o[2 * i + 1] = siluf(w0b * bf_hi(a[i]) + w1b * bf_hi(b[i]) + w2b * bf_hi(c[i]));
    }
}
__device__ __forceinline__ float scan_sum256(LAS float* sc, float v, int tid) {
    const int i = tid & 255; __syncthreads(); sc[tid] = v; __syncthreads();
#pragma unroll
    for (int off = 1; off < 256; off <<= 1) { float t = sc[tid]; if (i >= off) t += sc[tid - off]; __syncthreads(); sc[tid] = t; __syncthreads(); }
    return sc[tid];
}
__device__ __forceinline__ float scan_max256(LAS float* sc, float v, int tid) {
    const int i = tid & 255; __syncthreads(); sc[tid] = v; __syncthreads();
#pragma unroll
    for (int off = 1; off < 256; off <<= 1) { float t = sc[tid]; if (i >= off) t = fmaxf(t, sc[tid - off]); __syncthreads(); sc[tid] = t; __syncthreads(); }
    return sc[tid];
}

constexpr int VT_LD = 264;
__device__ __forceinline__ void ml_summary_unit(const Params& p, LAS unsigned char* lds, int unit, const int tidx) {
    const int tid = tidx, lane = tid & 63, wave = tid >> 6;
    const int blk = unit % 17, h = (unit / 17) % MH, b = unit / (17 * MH);
    const int row0 = ml_row0(b, blk), seg_lo = blk == 0 ? NLAT + b * TC : b * T, seg_hi = blk == 0 ? seg_lo + TC : seg_lo + T;
    const bf16_t* cols = (const bf16_t*)(p.ws + WS_COLS); const float* gates = (const float*)(p.ws + WS_GATES);
    LAS bf16_t* vT = (LAS bf16_t*)lds;
    LAS bf16_t* kfT = vT + 128 * VT_LD;
    LAS bf16_t* kbT = kfT + 64 * VT_LD;
    LAS float* sc = (LAS float*)(kbT + 64 * VT_LD);
    LAS float* wgt = sc + 512;
    LAS float* red = wgt + 512;
    LAS float* cw = red + 16;
    u32x4 vpre[8];
    { const int t_ = tid & 255, hf_ = tid >> 8;
#pragma unroll
      for (int c8 = 0; c8 < 8; ++c8) vpre[c8] = *(const u32x4*)(cols + (size_t)(row0 + t_) * INCP + C_MV + h * MDV + 64 * hf_ + 8 * c8); }
    __syncthreads();
    if (tid < 384) ((LAS f32x4*)cw)[tid] = ((const f32x4*)p.conv_qk)[tid];
    const int d = tid >> 8, i = tid & 255, tau = d ? 255 - i : i;
    const float graw_i = gates[(size_t)(row0 + tau) * 16 + d * 4 + h], graw_f = gates[(size_t)(row0 + tau) * 16 + 8 + d * 4 + h];
    const float ig = graw_i + p.b_igate[d * 4 + h], lf = logsigmoidf_(graw_f + p.b_fgate[d * 4 + h]);
    const float cum = scan_sum256(sc, lf, tid);
    const float F = sc[d * 256 + 255];
    const float a = (F - cum) + ig;
    const float mloc = scan_max256(sc, a, tid);
    const float mx = sc[d * 256 + 255];
    (void)mloc;
    wgt[d * 256 + tau] = __expf(a - mx);
    if (i == 0) { float* ms = (float*)(p.ws + WS_MSCAL) + ((((size_t)d * NB + b) * MH + h) * 17 + blk) * 2; ms[0] = F; ms[1] = mx; }
    __syncthreads();
    { const int t = tid & 255, hf = tid >> 8; const int row = row0 + t;
      const float wf = wgt[t], wb = wgt[256 + t];
#pragma unroll
      for (int c8 = 0; c8 < 8; ++c8) { const int ch = 64 * hf + 8 * c8; const u32x4 v = vpre[c8];
#pragma unroll
          for (int q = 0; q < 4; ++q) { vT[(ch + 2 * q) * VT_LD + t] = (bf16_t)(v[q] & 0xffffu); vT[(ch + 2 * q + 1) * VT_LD + t] = (bf16_t)(v[q] >> 16); } }
#pragma unroll 1
      for (int c8 = 0; c8 < 4; ++c8) { const int ch = 32 * hf + 8 * c8; float kv[8]; conv_silu8(cols, cw, row, seg_lo, seg_hi, 256 + h * MDK + ch, kv);
#pragma unroll
          for (int q = 0; q < 8; ++q) { kfT[(ch + q) * VT_LD + t] = f2bf(kv[q] * wf); kbT[(ch + q) * VT_LD + t] = f2bf(kv[q] * wb); } }
    }
    __syncthreads();
    { const int dvb = wave & 3, dkb = wave >> 2, r = lane & 31, hh = lane >> 5;
      f32x16 accf = {}, accb = {};
#pragma unroll 2
      for (int ks = 0; ks < 16; ++ks) { const int t0 = 16 * ks + 8 * hh;
          const bf16x8 av = *(const LAS bf16x8*)(vT + (dvb * 32 + r) * VT_LD + t0);
          const bf16x8 bf = *(const LAS bf16x8*)(kfT + (dkb * 32 + r) * VT_LD + t0);
          const bf16x8 bb = *(const LAS bf16x8*)(kbT + (dkb * 32 + r) * VT_LD + t0);
          accf = __builtin_amdgcn_mfma_f32_32x32x16_bf16(av, bf, accf, 0, 0, 0);
          accb = __builtin_amdgcn_mfma_f32_32x32x16_bf16(av, bb, accb, 0, 0, 0); }
      float* Uf = (float*)(p.ws + WS_U) + ((((size_t)0 * NB + b) * MH + h) * 17 + blk) * (MDV * MDK);
      float* Ub = (float*)(p.ws + WS_U) + ((((size_t)1 * NB + b) * MH + h) * 17 + blk) * (MDV * MDK);
#pragma unroll
      for (int q = 0; q < 16; ++q) { const int dv = dvb * 32 + crow(q, hh), dk = dkb * 32 + r; Uf[dv * MDK + dk] = accf[q]; Ub[dv * MDK + dk] = accb[q]; }
    }
    if (tid < 128) { const int dd = tid >> 6, dk = tid & 63; const LAS bf16_t* rowp = (dd ? kbT : kfT) + dk * VT_LD; float s = 0.f;
        for (int t = 0; t < 256; ++t) s += bf2f(rowp[t]);
        ((float*)(p.ws + WS_NL))[((((size_t)dd * NB + b) * MH + h) * 17 + blk) * MDK + dk] = s; }
    (void)red;
}

__device__ __forceinline__ int ml_blkof(int d, int j) { return d == 0 ? j : (j == 0 ? 0 : 17 - j); }
__device__ __forceinline__ void phase_ml_scan(const Params& p, const int tidx) {
    const int gt = blockIdx.x * NTHREADS + tidx, NGT = gridDim.x * NTHREADS;
    const float* ms = (const float*)(p.ws + WS_MSCAL); const float* U = (const float*)(p.ws + WS_U); const float* NL = (const float*)(p.ws + WS_NL);
    bf16_t* cst = (bf16_t*)(p.ws + WS_CST); float* nst = (float*)(p.ws + WS_NST); float* mst = (float*)(p.ws + WS_MST);
    constexpr int EPS_ = MDV * MDK + MDK;
    for (int e = gt; e < 64 * EPS_; e += NGT) {
        const int s = e / EPS_, el = e % EPS_;
        const int d = s / (NB * MH);
        float u[16];
#pragma unroll
        for (int j = 0; j < 16; ++j) { const int blk = ml_blkof(d, j); u[j] = (el < MDV * MDK) ? U[((size_t)s * 17 + blk) * (MDV * MDK) + el] : NL[((size_t)s * 17 + blk) * MDK + (el - MDV * MDK)]; }
        float m = 0.f, C = 0.f;
#pragma unroll
        for (int j = 0; j < 16; ++j) { const int blk = ml_blkof(d, j); const float F = ms[((size_t)s * 17 + blk) * 2], ml = ms[((size_t)s * 17 + blk) * 2 + 1];
            const float mn = fmaxf(F + m, ml); C = __expf(F + m - mn) * C + __expf(ml - mn) * u[j]; m = mn;
            if (el < MDV * MDK) cst[((size_t)s * 16 + j) * (MDV * MDK) + el] = f2bf(C); else nst[((size_t)s * 16 + j) * MDK + (el - MDV * MDK)] = C;
            if (el == 0) mst[(size_t)s * 16 + j] = m; }
    }
}

constexpr int QK_LD = 72;
__device__ __forceinline__ void ml_output_unit(const Params& p, LAS unsigned char* lds, int unit, const int tidx) {
    const int tid = tidx, lane = tid & 63, wave = tid >> 6;
    const int ib = unit % NBLK, h = (unit / NBLK) % MH, b = unit / (NBLK * MH);
    const int blk = ib + 1, row0 = ml_row0(b, blk), seg_lo = b * T, seg_hi = seg_lo + T;
    const bf16_t* cols = (const bf16_t*)(p.ws + WS_COLS); const float* gates = (const float*)(p.ws + WS_GATES);
    LAS bf16_t* vT = (LAS bf16_t*)lds;
    LAS bf16_t* qs = vT + 128 * VT_LD;
    LAS bf16_t* ks_ = qs + 256 * QK_LD;
    LAS float* sc = (LAS float*)(ks_ + 256 * QK_LD);
    LAS float* alpha = sc + 512;
    LAS float* beta = alpha + 512, *sint = beta + 512, *flr = sint + 512;
    LAS float* nv = flr + 512;
    LAS float* cw = nv + 128;
    u32x4 vpre[8];
    { const int t_ = tid & 255, hf_ = tid >> 8;
#pragma unroll
      for (int c8 = 0; c8 < 8; ++c8) vpre[c8] = *(const u32x4*)(cols + (size_t)(row0 + t_) * INCP + C_MV + h * MDV + 64 * hf_ + 8 * c8); }
    __syncthreads();
    if (tid < 384) ((LAS f32x4*)cw)[tid] = ((const f32x4*)p.conv_qk)[tid];
    {
        const int d = tid >> 8, i = tid & 255, tau = d ? 255 - i : i;
        const float graw_i = gates[(size_t)(row0 + tau) * 16 + d * 4 + h], graw_f = gates[(size_t)(row0 + tau) * 16 + 8 + d * 4 + h];
        const float ig = graw_i + p.b_igate[d * 4 + h], lf = logsigmoidf_(graw_f + p.b_fgate[d * 4 + h]);
        const float cum = scan_sum256(sc, lf, tid);
        const float bt = ig - cum;
        const float pm = scan_max256(sc, bt, tid);
        const int sidx = d == 0 ? ib : 15 - ib;
        const int s = (d * NB + b) * MH + h;
        const float mprev = ((const float*)(p.ws + WS_MST))[(size_t)s * 16 + sidx];
        const float mt = fmaxf(cum + mprev, cum + pm);
        alpha[d * 256 + tau] = cum - mt; beta[d * 256 + tau] = bt; sint[d * 256 + tau] = __expf(cum + mprev - mt); flr[d * 256 + tau] = __expf(-mt);
        if (i < 64) nv[d * 64 + i] = ((const float*)(p.ws + WS_NST))[((size_t)s * 16 + sidx) * MDK + i];
    }
    {
        const int t = tid & 255, hf = tid >> 8; const int row = row0 + t;
#pragma unroll
        for (int c8 = 0; c8 < 8; ++c8) { const int ch = 64 * hf + 8 * c8; const u32x4 v = vpre[c8];
#pragma unroll
            for (int q = 0; q < 4; ++q) { vT[(ch + 2 * q) * VT_LD + t] = (bf16_t)(v[q] & 0xffffu); vT[(ch + 2 * q + 1) * VT_LD + t] = (bf16_t)(v[q] >> 16); } }
#pragma unroll
        for (int c8 = 0; c8 < 4; ++c8) { const int ch = 32 * hf + 8 * c8; float kv[8], qv[8];
            conv_silu8(cols, cw, row, seg_lo, seg_hi, 256 + h * MDK + ch, kv); conv_silu8(cols, cw, row, seg_lo, seg_hi, h * MDK + ch, qv);
            u32x4 kw, qw;
#pragma unroll
            for (int q = 0; q < 4; ++q) { kw[q] = cvt_pk_bf16(kv[2 * q], kv[2 * q + 1]); qw[q] = cvt_pk_bf16(qv[2 * q] * 0.125f, qv[2 * q + 1] * 0.125f); }
            *(LAS u32x4*)(ks_ + t * QK_LD + ch) = kw; *(LAS u32x4*)(qs + t * QK_LD + ch) = qw; }
    }
    const int c = lane & 31, hh = lane >> 5, tq = 32 * wave + c;
    bf16x8 cpre[16];
    { const bf16_t* C0 = (const bf16_t*)(p.ws + WS_CST) + ((size_t)(((0 * NB + b) * MH + h)) * 16 + ib) * (MDV * MDK);
#pragma unroll
      for (int i = 0; i < 16; ++i) cpre[i] = *(const bf16x8*)(C0 + (size_t)((i >> 2) * 32 + c) * MDK + 16 * (i & 3) + 8 * hh); }
    __syncthreads();
    bf16x8 qf[4];
#pragma unroll
    for (int ks = 0; ks < 4; ++ks) qf[ks] = *(const LAS bf16x8*)(qs + tq * QK_LD + 16 * ks + 8 * hh);
    f32x16 hsum[4];
#pragma unroll
    for (int dvb = 0; dvb < 4; ++dvb) hsum[dvb] = (f32x16){};
#pragma unroll
    for (int d = 0; d < 2; ++d) {
        const int sidx = d == 0 ? ib : 15 - ib; const int s = (d * NB + b) * MH + h;
        const bf16_t* Cst = (const bf16_t*)(p.ws + WS_CST) + ((size_t)s * 16 + sidx) * (MDV * MDK);
        const float al = alpha[d * 256 + tq], si = sint[d * 256 + tq], fl = flr[d * 256 + tq];
        f32x16 acc[4];
        if (d == 1) {
#pragma unroll
            for (int i = 8; i < 16; ++i) cpre[i] = *(const bf16x8*)(Cst + (size_t)((i >> 2) * 32 + c) * MDK + 16 * (i & 3) + 8 * hh); }
#pragma unroll
        for (int dvb = 0; dvb < 4; ++dvb) { f32x16 t = {};
#pragma unroll
            for (int ks = 0; ks < 4; ++ks) t = __builtin_amdgcn_mfma_f32_32x32x16_bf16(cpre[dvb * 4 + ks], qf[ks], t, 0, 0, 0);
            acc[dvb] = t * si; }
        if (d == 0) { const bf16_t* C1 = (const bf16_t*)(p.ws + WS_CST) + ((size_t)(((1 * NB + b) * MH + h)) * 16 + (15 - ib)) * (MDV * MDK);
#pragma unroll
            for (int i = 0; i < 8; ++i) cpre[i] = *(const bf16x8*)(C1 + (size_t)((i >> 2) * 32 + c) * MDK + 16 * (i & 3) + 8 * hh); }
        float nq = 0.f;
#pragma unroll
        for (int j = 0; j < 32; ++j) nq += nv[d * 64 + 32 * hh + j] * bf2f(qs[tq * QK_LD + 32 * hh + j]);
        nq += __shfl_xor(nq, 32);
        float den = 0.f;
        const int sb_lo = d == 0 ? 0 : wave, sb_hi = d == 0 ? wave : 7;
#pragma unroll 1
        for (int sb = sb_lo; sb <= sb_hi; ++sb) {
            f32x16 st = {};
#pragma unroll
            for (int ks = 0; ks < 4; ++ks) { const bf16x8 af = *(const LAS bf16x8*)(ks_ + (32 * sb + c) * QK_LD + 16 * ks + 8 * hh); st = __builtin_amdgcn_mfma_f32_32x32x16_bf16(af, qf[ks], st, 0, 0, 0); }
#pragma unroll
            for (int q = 0; q < 16; ++q) { const int sg = 32 * sb + crow(q, hh); const float w = __expf(al + beta[d * 256 + sg]) * st[q];
                const bool ok = d == 0 ? (sg <= tq) : (sg >= tq); st[q] = ok ? w : 0.f; den += st[q]; }
            bf16x8 wf[2];
#pragma unroll
            for (int s2 = 0; s2 < 2; ++s2) { u32x4 w; w.x = cvt_pk_bf16(st[8 * s2 + 0], st[8 * s2 + 1]); w.y = cvt_pk_bf16(st[8 * s2 + 2], st[8 * s2 + 3]); w.z = cvt_pk_bf16(st[8 * s2 + 4], st[8 * s2 + 5]); w.w = cvt_pk_bf16(st[8 * s2 + 6], st[8 * s2 + 7]);
                wf[s2] = __builtin_bit_cast(bf16x8, w); }
#pragma unroll
            for (int dvb = 0; dvb < 4; ++dvb)
#pragma unroll
                for (int s2 = 0; s2 < 2; ++s2) { const LAS bf16_t* vp = vT + (dvb * 32 + c) * VT_LD + 32 * sb + 16 * s2 + 4 * hh;
                    const s16x4 lo = *(const LAS s16x4*)vp, hi = *(const LAS s16x4*)(vp + 8);
                    const bf16x8 af = {lo[0], lo[1], lo[2], lo[3], hi[0], hi[1], hi[2], hi[3]};
                    acc[dvb] = __builtin_amdgcn_mfma_f32_32x32x16_bf16(af, wf[s2], acc[dvb], 0, 0, 0); }
        }
        den += __shfl_xor(den, 32);
        const float dt = den + si * nq; const float inv = 1.f / fmaxf(fabsf(dt), fl);
#pragma unroll
        for (int dvb = 0; dvb < 4; ++dvb) hsum[dvb] += acc[dvb] * inv;
    }
    float ss = 0.f;
#pragma unroll
    for (int dvb = 0; dvb < 4; ++dvb)
#pragma unroll
        for (int q = 0; q < 16; ++q) ss += hsum[dvb][q] * hsum[dvb][q];
    ss += __shfl_xor(ss, 32);
    const float rstd = rsqrtf(ss * (1.f / MDV) + EPS);
    const int row = row0 + tq; bf16_t* mix = (bf16_t*)(p.ws + WS_MIX) + (size_t)row * D + 512 + h * MDV;
    const bf16_t* orow = cols + (size_t)row * INCP + C_MO + h * MDV;
#pragma unroll
    for (int dvb = 0; dvb < 4; ++dvb)
#pragma unroll
        for (int q4 = 0; q4 < 4; ++q4) { const int dv = dvb * 32 + 8 * q4 + 4 * hh; const u32x2 ow = *(const u32x2*)(orow + dv); const f32x4 gg = *(const f32x4*)(p.g_mlstm + h * MDV + dv);
            const float o0 = sigmoidf_(bf_lo(ow.x)) * hsum[dvb][4 * q4 + 0] * rstd * gg[0], o1 = sigmoidf_(bf_hi(ow.x)) * hsum[dvb][4 * q4 + 1] * rstd * gg[1];
            const float o2 = sigmoidf_(bf_lo(ow.y)) * hsum[dvb][4 * q4 + 2] * rstd * gg[2], o3 = sigmoidf_(bf_hi(ow.y)) * hsum[dvb][4 * q4 + 3] * rstd * gg[3];
            u32x2 w; w.x = cvt_pk_bf16(o0, o1); w.y = cvt_pk_bf16(o2, o3); *(u32x2*)(mix + dv) = w; }
}

__device__ __forceinline__ void phase_mla_fin(const Params& p, LAS unsigned char* lds, const int tidx) {
    const int lane = tidx & 63, wave = tidx >> 6;
    const int gw = blockIdx.x * NWAVES + wave, NGW = gridDim.x * NWAVES;
    LAS float* sq = (LAS float*)(lds + wave * 8192);
    const bf16_t* cols = (const bf16_t*)(p.ws + WS_COLS); const bf16_t* qraw = (const bf16_t*)(p.ws + WS_QRAW); const bf16_t* kvraw = (const bf16_t*)(p.ws + WS_KVRAW);
    const float* ssq = (const float*)(p.ws + WS_SSQ); const float* rt = (const float*)(p.ws + WS_ROPE);
    bf16_t* Q = (bf16_t*)(p.ws + WS_Q); bf16_t* Kb = (bf16_t*)(p.ws + WS_K); bf16_t* VT = (bf16_t*)(p.ws + WS_VT);
#pragma unroll 2
    for (int row = gw; row < NLAT; row += NGW) {
        const int b = row / T; const int t = row % T; const int prow = t >> 6, pcol = t & 63;
        const f32x4 sq4 = *(const f32x4*)(ssq + (size_t)row * 8);
        const float rq = rsqrtf(((sq4[0] + sq4[1]) + (sq4[2] + sq4[3])) * (1.f / 256.f) + EPS);
        {
            const bf16_t* qp = qraw + (size_t)row * 768 + 12 * lane;
            const u32x2 a0 = *(const u32x2*)qp, a1 = *(const u32x2*)(qp + 4), a2 = *(const u32x2*)(qp + 8);
            float v[12] = {bf_lo(a0.x), bf_hi(a0.x), bf_lo(a0.y), bf_hi(a0.y), bf_lo(a1.x), bf_hi(a1.x), bf_lo(a1.y), bf_hi(a1.y), bf_lo(a2.x), bf_hi(a2.x), bf_lo(a2.y), bf_hi(a2.y)};
            float s = 0.f;
#pragma unroll
            for (int q = 0; q < 12; ++q) { v[q] *= rq; s += v[q] * v[q]; }
            s = row_sum_f(s);
            const float rh = rsqrtf(s * (1.f / 192.f) + EPS);
            const int hd = lane >> 4, off = (lane & 15) * 12;
#pragma unroll
            for (int q = 0; q < 12; ++q) sq[12 * lane + q] = v[q] * rh * p.g_qn[off + q];
            asm volatile("s_waitcnt lgkmcnt(0)" ::: "memory");
            bf16_t* qo = Q + (((size_t)b * NH + hd) * T + t) * DQK + off;
            float o[12];
#pragma unroll
            for (int q = 0; q < 12; ++q) { const int dd = off + q; float val = sq[12 * lane + q];
                if (dd >= 128) { const int j = dd - 128, part = j >> 5, jj = j & 31, fi = jj & 15; const bool second = jj >= 16; const int pos = part ? pcol : prow;
                    const float cs = rt[(pos * 16 + fi) * 2], sn = rt[(pos * 16 + fi) * 2 + 1];
                    const float pt = sq[hd * 192 + 128 + part * 32 + (jj ^ 16)];
                    val = second ? (val * cs + pt * sn) : (val * cs - pt * sn); }
                o[q] = val; }
            u32x2 w0, w1, w2; w0.x = cvt_pk_bf16(o[0], o[1]); w0.y = cvt_pk_bf16(o[2], o[3]); w1.x = cvt_pk_bf16(o[4], o[5]); w1.y = cvt_pk_bf16(o[6], o[7]); w2.x = cvt_pk_bf16(o[8], o[9]); w2.y = cvt_pk_bf16(o[10], o[11]);
            *(u32x2*)qo = w0; *(u32x2*)(qo + 4) = w1; *(u32x2*)(qo + 8) = w2;
            asm volatile("s_waitcnt lgkmcnt(0)" ::: "memory");
        }
    }
}

constexpr int AK_LD = 192;
constexpr int A_KBYTES = 64 * AK_LD * 2, A_VBYTES = 64 * DV * 2;
constexpr int AQ_LD = 72;
__device__ __forceinline__ void attn_unit(const Params& p, LAS unsigned char* lds, int unit, const int tidx) {
    const int tid = tidx, lane = tid & 63, wave = tid >> 6;
    const int qb = unit % (T / 256), h = (unit / (T / 256)) % NH, b = unit / ((T / 256) * NH);
    const bf16_t* Q = (const bf16_t*)(p.ws + WS_Q) + (((size_t)b * NH + h) * T + qb * 256) * DQK;
    const bf16_t* Kg = (const bf16_t*)(p.ws + WS_K) + ((size_t)b * NH + h) * NKEY * DQK;
    const bf16_t* Vg = (const bf16_t*)(p.ws + WS_VT) + ((size_t)b * NH + h) * NKEY * DV;
    const int c = lane & 31, hh = lane >> 5, tq = 32 * wave + c;
    constexpr float CS = 0.07216878364870322f * 1.4426950408889634f;
    bf16x8 qf[8];
#pragma unroll
    for (int ks = 0; ks < 8; ++ks) qf[ks] = *(const bf16x8*)(Q + (size_t)tq * DQK + 16 * ks + 8 * hh);
    LAS bf16_t* Qr = (LAS bf16_t*)(lds + 2 * (A_KBYTES + A_VBYTES));
    __syncthreads();
#pragma unroll
    for (int ks = 8; ks < 12; ++ks) *(LAS bf16x8*)(Qr + tq * AQ_LD + 16 * (ks - 8) + 8 * hh) = *(const bf16x8*)(Q + (size_t)tq * DQK + 16 * ks + 8 * hh);
    f32x16 o[4];
#pragma unroll
    for (int dvb = 0; dvb < 4; ++dvb) o[dvb] = (f32x16){};
    float m = -INFINITY, l = 0.f;
    unsigned ksrc[3];
#pragma unroll
    for (int i = 0; i < 3; ++i) { const unsigned P = 8192u * i + 16u * (unsigned)tid, r = P / 384u, cq = (P % 384u) >> 4; ksrc[i] = r * 384u + ((cq ^ ((r >> 1) & 7u)) << 4); }
    unsigned kadr[12];
#pragma unroll
    for (int ks = 0; ks < 12; ++ks) kadr[ks] = (unsigned)c * 384u + ((((unsigned)(2 * ks + hh)) ^ (((unsigned)c >> 1) & 7u)) << 4);
    unsigned vsrc[2];
#pragma unroll
    for (int i = 0; i < 2; ++i) { const unsigned P = 8192u * i + 16u * (unsigned)tid, r = P >> 8, cq = (P >> 4) & 15u; vsrc[i] = r * 256u + ((cq ^ (((r & 3u) << 2) | ((r >> 2) & 3u))) << 4); }
    unsigned vbs[4][2];
    { const unsigned q_ = ((unsigned)lane >> 2) & 3u, p_ = (unsigned)lane & 3u, gh = ((unsigned)lane >> 4) & 1u;
#pragma unroll
      for (int dvb = 0; dvb < 4; ++dvb)
#pragma unroll
          for (int hi = 0; hi < 2; ++hi) { const unsigned row = 8u * hi + 4u * (unsigned)hh + q_, f_ = ((row & 3u) << 2) | ((row >> 2) & 3u), ch = 4u * dvb + 2u * gh + (p_ >> 1);
              vbs[dvb][hi] = (unsigned)(size_t)lds + (unsigned)(2 * A_KBYTES) + 256u * row + 16u * (ch ^ f_) + 8u * (p_ & 1u); } }
    auto dma_k = [&](int kt, int buf) { const char* kb = (const char*)Kg + (size_t)kt * (64 * DQK * 2);
#pragma unroll
        for (int i = 0; i < 3; ++i) __builtin_amdgcn_global_load_lds((const unsigned*)(kb + ksrc[i]), (LAS unsigned*)(lds + buf * A_KBYTES + i * 8192 + wave * 1024), 16, 0, 0); };
    auto dma_v = [&](int kt, int buf) { const char* vb = (const char*)Vg + (size_t)kt * (64 * DV * 2);
#pragma unroll
        for (int i = 0; i < 2; ++i) __builtin_amdgcn_global_load_lds((const unsigned*)(vb + vsrc[i]), (LAS unsigned*)(lds + 2 * A_KBYTES + buf * A_VBYTES + i * 8192 + wave * 1024), 16, 0, 0); };
    constexpr int NT = NKEY / 64;
    f32x16 p0 = {}, p1 = {}; bf16x8 pf[4] = {};
#define AT_QK(kbuf) do { const LAS bf16_t* Ks = (const LAS bf16_t*)(lds + (kbuf) * A_KBYTES); p0 = (f32x16){}; p1 = (f32x16){}; \
        _Pragma("unroll") for (int ks = 0; ks < 12; ++ks) { \
            const bf16x8 a0 = *(const LAS bf16x8*)((const LAS unsigned char*)Ks + kadr[ks]), a1 = *(const LAS bf16x8*)((const LAS unsigned char*)Ks + kadr[ks] + 12288); \
            const bf16x8 qv = ks < 8 ? qf[ks < 8 ? ks : 0] : *(const LAS bf16x8*)(Qr + tq * AQ_LD + 16 * (ks - 8) + 8 * hh); \
            p0 = __builtin_amdgcn_mfma_f32_32x32x16_bf16(a0, qv, p0, 0, 0, 0); p1 = __builtin_amdgcn_mfma_f32_32x32x16_bf16(a1, qv, p1, 0, 0, 0); } } while (0)
#define AT_SM() do { float mx = p0[0]; \
        _Pragma("unroll") for (int q = 1; q < 16; ++q) mx = fmaxf(mx, p0[q]); \
        _Pragma("unroll") for (int q = 0; q < 16; ++q) mx = fmaxf(mx, p1[q]); \
        { auto r_ = __builtin_amdgcn_permlane32_swap(__float_as_uint(mx), __float_as_uint(mx), false, false); mx = fmaxf(__uint_as_float(r_[0]), __uint_as_float(r_[1])); } \
        const float mxs = mx * CS; \
        if (!__all(mxs <= m + 8.0f)) { const float mn = fmaxf(m, mxs), al = __builtin_amdgcn_exp2f(m - mn); m = mn; l *= al; \
            _Pragma("unroll") for (int dvb = 0; dvb < 4; ++dvb) o[dvb] *= al; } \
        float ps = 0.f; \
        _Pragma("unroll") for (int q = 0; q < 16; ++q) { p0[q] = __builtin_amdgcn_exp2f(fmaf(p0[q], CS, -m)); p1[q] = __builtin_amdgcn_exp2f(fmaf(p1[q], CS, -m)); ps += p0[q] + p1[q]; } \
        { auto r_ = __builtin_amdgcn_permlane32_swap(__float_as_uint(ps), __float_as_uint(ps), false, false); ps = __uint_as_float(r_[0]) + __uint_as_float(r_[1]); } \
        l += ps; \
        _Pragma("unroll") for (int s2 = 0; s2 < 2; ++s2) { u32x4 w; \
            w.x = cvt_pk_bf16(p0[8 * s2 + 0], p0[8 * s2 + 1]); w.y = cvt_pk_bf16(p0[8 * s2 + 2], p0[8 * s2 + 3]); w.z = cvt_pk_bf16(p0[8 * s2 + 4], p0[8 * s2 + 5]); w.w = cvt_pk_bf16(p0[8 * s2 + 6], p0[8 * s2 + 7]); pf[s2] = __builtin_bit_cast(bf16x8, w); \
            w.x = cvt_pk_bf16(p1[8 * s2 + 0], p1[8 * s2 + 1]); w.y = cvt_pk_bf16(p1[8 * s2 + 2], p1[8 * s2 + 3]); w.z = cvt_pk_bf16(p1[8 * s2 + 4], p1[8 * s2 + 5]); w.w = cvt_pk_bf16(p1[8 * s2 + 6], p1[8 * s2 + 7]); pf[2 + s2] = __builtin_bit_cast(bf16x8, w); } } while (0)
#define AT_TR(dst, base, off_) asm volatile("ds_read_b64_tr_b16 %0, %1 offset:%2" : "=v"(dst) : "v"(base), "n"(off_))
#define AT_PLD(L, H, dvb, vo_) do { _Pragma("unroll") for (int s4 = 0; s4 < 4; ++s4) { AT_TR(L[s4], vbs[dvb][0] + (vo_), 4096 * s4); AT_TR(H[s4], vbs[dvb][1] + (vo_), 4096 * s4); } } while (0)
#define AT_PMM(L, H, dvb) do { __builtin_amdgcn_sched_barrier(0); \
        _Pragma("unroll") for (int s4 = 0; s4 < 4; ++s4) { const u32x4 w_ = {L[s4].x, L[s4].y, H[s4].x, H[s4].y}; \
            o[dvb] = __builtin_amdgcn_mfma_f32_32x32x16_bf16(__builtin_bit_cast(bf16x8, w_), pf[s4], o[dvb], 0, 0, 0); } \
        __builtin_amdgcn_sched_barrier(0); } while (0)
#define AT_WL(n_) asm volatile("s_waitcnt lgkmcnt(" #n_ ")" ::: "memory")
#define AT_PV(vbuf) do { const unsigned vo__ = (unsigned)((vbuf) * A_VBYTES); u32x2 la_[4], ha_[4], lb_[4], hb_[4]; \
        AT_PLD(la_, ha_, 0, vo__); AT_PLD(lb_, hb_, 1, vo__); AT_WL(8); AT_PMM(la_, ha_, 0); \
        AT_PLD(la_, ha_, 2, vo__); AT_WL(8); AT_PMM(lb_, hb_, 1); \
        AT_PLD(lb_, hb_, 3, vo__); AT_WL(8); AT_PMM(la_, ha_, 2); \
        AT_WL(0); AT_PMM(lb_, hb_, 3); } while (0)
    __syncthreads();
    dma_k(0, 0);
    const bool grpA = __builtin_amdgcn_readfirstlane(wave) < 4;
    if (grpA) {
#pragma unroll 1
        for (int j = 0; j <= NT; ++j) {
            asm volatile("s_waitcnt vmcnt(0)" ::: "memory"); __syncthreads();
            if (j + 1 < NT) dma_k(j + 1, (j + 1) & 1);
            if (j < NT) dma_v(j, j & 1);
            if (j > 0) AT_PV((j - 1) & 1);
            if (j < NT) { AT_QK(j & 1); AT_SM(); }
        }
    } else {
#pragma unroll 1
        for (int j = 0; j <= NT; ++j) {
            asm volatile("s_waitcnt vmcnt(0)" ::: "memory"); __syncthreads();
            if (j + 1 < NT) dma_k(j + 1, (j + 1) & 1);
            if (j < NT) dma_v(j, j & 1);
            if (j > 0) { AT_SM(); AT_PV((j - 1) & 1); }
            if (j < NT) AT_QK(j & 1);
        }
    }
#undef AT_QK
#undef AT_SM
#undef AT_PV
#undef AT_PLD
#undef AT_PMM
#undef AT_WL
#undef AT_TR
    const float inv = 1.f / l;
    bf16_t* mix = (bf16_t*)(p.ws + WS_MIX) + (size_t)(b * T + qb * 256 + tq) * D + h * DV;
#pragma unroll
    for (int dvb = 0; dvb < 4; ++dvb)
#pragma unroll
        for (int q4 = 0; q4 < 4; ++q4) { const int dv = dvb * 32 + 8 * q4 + 4 * hh; u32x2 w; w.x = cvt_pk_bf16(o[dvb][4 * q4] * inv, o[dvb][4 * q4 + 1] * inv); w.y = cvt_pk_bf16(o[dvb][4 * q4 + 2] * inv, o[dvb][4 * q4 + 3] * inv); *(u32x2*)(mix + dv) = w; }
}

__device__ __forceinline__ void phase_h2(const Params& p, const int tidx) {
    const int lane = tidx & 63, wave = tidx >> 6;
    const int gw = blockIdx.x * NWAVES + wave, NGW = gridDim.x * NWAVES;
    const float* mod = (const float*)(p.ws + WS_MOD); bf16_t* h2 = (bf16_t*)(p.ws + WS_H2);
    unsigned* h2q = (unsigned*)(p.ws + WS_H2Q); float* hs = (float*)(p.ws + WS_HS);
    u32x2 na[4] = {}, nb[4] = {}; const bf16_t* x1b = (const bf16_t*)(p.ws + WS_X1B);
    const int bw = gw & 7, rw = gw >> 3, S = NGW >> 3;
    f32x4 ga[4], hb_[4];
    { const float* sh = mod + (size_t)bw * NMOD + 3 * D, * sc = mod + (size_t)bw * NMOD + 4 * D;
#pragma unroll
      for (int j = 0; j < 4; ++j) { const int i4 = lane + 64 * j; ga[j] = ((const f32x4*)p.g_norm2)[i4] * (((const f32x4*)sc)[i4] + 1.f); hb_[j] = ((const f32x4*)sh)[i4]; } }
    auto fetch = [&](u32x2 (&d)[4], int r) { if (r < T) { const bf16_t* s_ = x1b + (size_t)(bw * T + r) * D;
#pragma unroll
        for (int j = 0; j < 4; ++j) d[j] = ((const u32x2*)s_)[lane + 64 * j]; } };
    auto unpk = [](u32x2 w) { f32x4 r; r[0] = __uint_as_float(w.x << 16); r[1] = __uint_as_float(w.x & 0xffff0000u); r[2] = __uint_as_float(w.y << 16); r[3] = __uint_as_float(w.y & 0xffff0000u); return r; };
    auto finish = [&](f32x4 (&v)[4], int r) { const int row = bw * T + r;
        float s = 0.f;
#pragma unroll
        for (int j = 0; j < 4; ++j) s += (v[j][0] * v[j][0] + v[j][1] * v[j][1]) + (v[j][2] * v[j][2] + v[j][3] * v[j][3]);
        const float rstd = rsqrtf(wave_sum_fast(s) * (1.f / D) + EPS); float m = 0.f;
#pragma unroll
        for (int j = 0; j < 4; ++j) { const int i4 = lane + 64 * j;
            v[j] = v[j] * rstd * ga[j] + hb_[j]; u32x2 w; w.x = cvt_pk_bf16(v[j][0], v[j][1]); w.y = cvt_pk_bf16(v[j][2], v[j][3]); ((u32x2*)(h2 + (size_t)row * D))[i4] = w;
            m = fmaxf(m, fmaxf(fmaxf(fabsf(v[j][0]), fabsf(v[j][1])), fmaxf(fabsf(v[j][2]), fabsf(v[j][3])))); }
        m = fmaxf(wave_max_fast(m), 1e-30f); const float inv = 127.f / m;
#pragma unroll
        for (int j = 0; j < 4; ++j) { const int d_ = lane + 64 * j; h2q[((size_t)(d_ >> 3) * NLAT + row) * 8 + (d_ & 7)] = q8pack(v[j], inv, 0); }
        if (lane == 0) hs[row] = m * (1.f / 127.f); };
    u32x2 nc[4] = {}, nd[4] = {};
    fetch(na, rw); fetch(nb, rw + S); fetch(nc, rw + 2 * S); fetch(nd, rw + 3 * S);
    for (int r = rw; r < T; r += 4 * S) {
        f32x4 ca[4];
#pragma unroll
        for (int j = 0; j < 4; ++j) ca[j] = unpk(na[j]);
        fetch(na, r + 4 * S);
        finish(ca, r);
        if (r + S < T) {
#pragma unroll
            for (int j = 0; j < 4; ++j) ca[j] = unpk(nb[j]);
            fetch(nb, r + 5 * S);
            finish(ca, r + S);
        }
        if (r + 2 * S < T) {
#pragma unroll
            for (int j = 0; j < 4; ++j) ca[j] = unpk(nc[j]);
            fetch(nc, r + 6 * S);
            finish(ca, r + 2 * S);
        }
        if (r + 3 * S < T) {
#pragma unroll
            for (int j = 0; j < 4; ++j) ca[j] = unpk(nd[j]);
            fetch(nd, r + 7 * S);
            finish(ca, r + 3 * S);
        }
    }
}

__device__ __forceinline__ unsigned ord_key(float v) { const unsigned u = __float_as_uint(v); return (u & 0x80000000u) ? ~u : (u | 0x80000000u); }
__device__ __forceinline__ float ord_val(unsigned k) { const unsigned u = (k & 0x80000000u) ? (k & 0x7fffffffu) : ~k; return __uint_as_float(u); }
__device__ __forceinline__ unsigned med3u(unsigned a, unsigned b, unsigned c) { const unsigned mx = a > b ? a : b, mn = a > b ? b : a; const unsigned t = mx < c ? mx : c; return mn > t ? mn : t; }
__device__ __forceinline__ void ins16(unsigned (&top)[16], unsigned x) {
    unsigned n[16];
    n[0] = top[0] > x ? top[0] : x;
#pragma unroll
    for (int i = 1; i < 16; ++i) n[i] = med3u(x, top[i - 1], top[i]);
#pragma unroll
    for (int i = 0; i < 16; ++i) top[i] = n[i];
}
#define TK_CE(a, b) do { const unsigned hi_ = (a) > (b) ? (a) : (b), lo_ = (a) > (b) ? (b) : (a); (a) = hi_; (b) = lo_; } while (0)
__device__ __forceinline__ void sort16d(unsigned (&k_)[16]) { TK_CE(k_[0], k_[1]); TK_CE(k_[2], k_[3]); TK_CE(k_[0], k_[2]); TK_CE(k_[1], k_[3]); TK_CE(k_[1], k_[2]); TK_CE(k_[4], k_[5]); TK_CE(k_[6], k_[7]); TK_CE(k_[4], k_[6]); TK_CE(k_[5], k_[7]); TK_CE(k_[5], k_[6]); TK_CE(k_[0], k_[4]); TK_CE(k_[2], k_[6]); TK_CE(k_[2], k_[4]); TK_CE(k_[1], k_[5]); TK_CE(k_[3], k_[7]); TK_CE(k_[3], k_[5]); TK_CE(k_[1], k_[2]); TK_CE(k_[3], k_[4]); TK_CE(k_[5], k_[6]); TK_CE(k_[8], k_[9]); TK_CE(k_[10], k_[11]); TK_CE(k_[8], k_[10]); TK_CE(k_[9], k_[11]); TK_CE(k_[9], k_[10]); TK_CE(k_[12], k_[13]); TK_CE(k_[14], k_[15]); TK_CE(k_[12], k_[14]); TK_CE(k_[13], k_[15]); TK_CE(k_[13], k_[14]); TK_CE(k_[8], k_[12]); TK_CE(k_[10], k_[14]); TK_CE(k_[10], k_[12]); TK_CE(k_[9], k_[13]); TK_CE(k_[11], k_[15]); TK_CE(k_[11], k_[13]); TK_CE(k_[9], k_[10]); TK_CE(k_[11], k_[12]); TK_CE(k_[13], k_[14]); TK_CE(k_[0], k_[8]); TK_CE(k_[4], k_[12]); TK_CE(k_[4], k_[8]); TK_CE(k_[2], k_[10]); TK_CE(k_[6], k_[14]); TK_CE(k_[6], k_[10]); TK_CE(k_[2], k_[4]); TK_CE(k_[6], k_[8]); TK_CE(k_[10], k_[12]); TK_CE(k_[1], k_[9]); TK_CE(k_[5], k_[13]); TK_CE(k_[5], k_[9]); TK_CE(k_[3], k_[11]); TK_CE(k_[7], k_[15]); TK_CE(k_[7], k_[11]); TK_CE(k_[3], k_[5]); TK_CE(k_[7], k_[9]); TK_CE(k_[11], k_[13]); TK_CE(k_[1], k_[2]); TK_CE(k_[3], k_[4]); TK_CE(k_[5], k_[6]); TK_CE(k_[7], k_[8]); TK_CE(k_[9], k_[10]); TK_CE(k_[11], k_[12]); TK_CE(k_[13], k_[14]); }
__device__ __forceinline__ void merge16d(unsigned (&cur)[16], const unsigned (&k_)[16]) { unsigned t_[16];
#pragma unroll
    for (int i = 0; i < 16; ++i) t_[i] = cur[i] > k_[15 - i] ? cur[i] : k_[15 - i];
    TK_CE(t_[0], t_[8]); TK_CE(t_[1], t_[9]); TK_CE(t_[2], t_[10]); TK_CE(t_[3], t_[11]); TK_CE(t_[4], t_[12]); TK_CE(t_[5], t_[13]); TK_CE(t_[6], t_[14]); TK_CE(t_[7], t_[15]); TK_CE(t_[0], t_[4]); TK_CE(t_[1], t_[5]); TK_CE(t_[2], t_[6]); TK_CE(t_[3], t_[7]); TK_CE(t_[8], t_[12]); TK_CE(t_[9], t_[13]); TK_CE(t_[10], t_[14]); TK_CE(t_[11], t_[15]); TK_CE(t_[0], t_[2]); TK_CE(t_[1], t_[3]); TK_CE(t_[4], t_[6]); TK_CE(t_[5], t_[7]); TK_CE(t_[8], t_[10]); TK_CE(t_[9], t_[11]); TK_CE(t_[12], t_[14]); TK_CE(t_[13], t_[15]); TK_CE(t_[0], t_[1]); TK_CE(t_[2], t_[3]); TK_CE(t_[4], t_[5]); TK_CE(t_[6], t_[7]); TK_CE(t_[8], t_[9]); TK_CE(t_[10], t_[11]); TK_CE(t_[12], t_[13]); TK_CE(t_[14], t_[15]);
#pragma unroll
    for (int i = 0; i < 16; ++i) cur[i] = t_[i]; }
__device__ __forceinline__ void peer_topk_unit(const Params& p, LAS unsigned char* lds, int unit, const int tidx_in) {
    int tidx = tidx_in; asm volatile("" : "+v"(tidx));
    const int lane = tidx & 63, h = tidx >> 6;
    const int c = lane & 31, hh = lane >> 5, tok = unit * 32 + c;
    const bf16_t* qp = (const bf16_t*)(p.ws + WS_QP) + (size_t)tok * 2048 + h * 256;
    const bf16_t* skb = (const bf16_t*)(p.ws + WS_SKB) + (size_t)h * 2 * NKEYS * 128;
    unsigned top[2][16];
    {
        unsigned cur[16], sav[16];
#pragma unroll
        for (int i = 0; i < 16; ++i) sav[i] = 0u;
        bf16x8 qf[8], afA[8], afB[8], afC[8];
#define TK_LOADA(dst, pp_, kb_) do { _Pragma("unroll") for (int ks = 0; ks < 8; ++ks) dst[ks] = *(const bf16x8*)(skb + ((size_t)(pp_) * NKEYS + (kb_) * 32 + c) * 128 + 16 * ks + 8 * hh); } while (0)
#define TK_LOADQ(pp_) do { _Pragma("unroll") for (int ks = 0; ks < 8; ++ks) qf[ks] = *(const bf16x8*)(qp + (pp_) * 128 + 16 * ks + 8 * hh); } while (0)
#define TK_MMA(af, sacc) do { _Pragma("unroll") for (int q = 0; q < 16; ++q) sacc[q] = 64.f; \
        _Pragma("unroll") for (int ks = 0; ks < 8; ++ks) sacc = __builtin_amdgcn_mfma_f32_32x32x16_bf16(af[ks], qf[ks], sacc, 0, 0, 0); } while (0)
#define TK_SEL(sacc, kb_) do { unsigned kk_[16]; _Pragma("unroll") for (int q = 0; q < 16; ++q) kk_[q] = (__float_as_uint(fmaxf(sacc[q], 0.f)) & ~127u) | (unsigned)((kb_) * 32 + crow(q, hh)); \
        sort16d(kk_); if ((kb_) == 0) { _Pragma("unroll") for (int q = 0; q < 16; ++q) cur[q] = kk_[q]; } else merge16d(cur, kk_); } while (0)
#define TK_HALF() do { unsigned oth[16]; _Pragma("unroll") for (int i = 0; i < 16; ++i) { auto r_ = __builtin_amdgcn_permlane32_swap(cur[i], cur[i], false, false); oth[i] = hh ? r_[0] : r_[1]; } \
        merge16d(cur, oth); } while (0)
        { f32x16 sa;
          TK_LOADQ(0); TK_LOADA(afA, 0, 0); TK_LOADA(afB, 0, 1);
          TK_LOADA(afC, 0, 2); TK_MMA(afA, sa); TK_SEL(sa, 0);
          TK_LOADA(afA, 0, 3); TK_MMA(afB, sa); TK_SEL(sa, 1);
          TK_LOADA(afB, 1, 0); TK_MMA(afC, sa); TK_SEL(sa, 2);
          TK_LOADA(afC, 1, 1); TK_MMA(afA, sa); TK_LOADQ(1); TK_SEL(sa, 3);
          TK_HALF();
#pragma unroll
          for (int i = 0; i < 16; ++i) sav[i] = cur[i];
          TK_LOADA(afA, 1, 2); TK_MMA(afB, sa); TK_SEL(sa, 0);
          TK_LOADA(afB, 1, 3); TK_MMA(afC, sa); TK_SEL(sa, 1);
          TK_MMA(afA, sa); TK_SEL(sa, 2);
          TK_MMA(afB, sa); TK_SEL(sa, 3);
          TK_HALF(); }
#undef TK_LOADA
#undef TK_LOADQ
#undef TK_MMA
#undef TK_SEL
#undef TK_HALF
#pragma unroll
        for (int i = 0; i < 16; ++i) { top[0][i] = sav[i]; top[1][i] = cur[i]; }
    }
    float va[16], vb[16];
#pragma unroll
    for (int i = 0; i < 16; ++i) { va[i] = __uint_as_float(top[0][i] & ~127u) - 112.f; vb[i] = __uint_as_float(top[1][i] & ~127u); }
    unsigned best[16];
#pragma unroll
    for (int j = 0; j < 16; ++j) best[j] = (__float_as_uint(fmaxf(va[0] + vb[j], 0.f)) & ~255u) | (unsigned)j;
    sort16d(best);
    { unsigned g_[16];
      g_[0] = (__float_as_uint(fmaxf(va[1] + vb[0], 0.f)) & ~255u) | 16u;
      g_[1] = (__float_as_uint(fmaxf(va[1] + vb[1], 0.f)) & ~255u) | 17u;
      g_[2] = (__float_as_uint(fmaxf(va[1] + vb[2], 0.f)) & ~255u) | 18u;
      g_[3] = (__float_as_uint(fmaxf(va[1] + vb[3], 0.f)) & ~255u) | 19u;
      g_[4] = (__float_as_uint(fmaxf(va[1] + vb[4], 0.f)) & ~255u) | 20u;
      g_[5] = (__float_as_uint(fmaxf(va[1] + vb[5], 0.f)) & ~255u) | 21u;
      g_[6] = (__float_as_uint(fmaxf(va[1] + vb[6], 0.f)) & ~255u) | 22u;
      g_[7] = (__float_as_uint(fmaxf(va[1] + vb[7], 0.f)) & ~255u) | 23u;
      g_[8] = (__float_as_uint(fmaxf(va[2] + vb[0], 0.f)) & ~255u) | 32u;
      g_[9] = (__float_as_uint(fmaxf(va[2] + vb[1], 0.f)) & ~255u) | 33u;
      g_[10] = (__float_as_uint(fmaxf(va[2] + vb[2], 0.f)) & ~255u) | 34u;
      g_[11] = (__float_as_uint(fmaxf(va[2] + vb[3], 0.f)) & ~255u) | 35u;
      g_[12] = (__float_as_uint(fmaxf(va[2] + vb[4], 0.f)) & ~255u) | 36u;
      g_[13] = (__float_as_uint(fmaxf(va[3] + vb[0], 0.f)) & ~255u) | 48u;
      g_[14] = (__float_as_uint(fmaxf(va[3] + vb[1], 0.f)) & ~255u) | 49u;
      g_[15] = (__float_as_uint(fmaxf(va[3] + vb[2], 0.f)) & ~255u) | 50u;
      sort16d(g_); merge16d(best, g_);
      g_[0] = (__float_as_uint(fmaxf(va[3] + vb[3], 0.f)) & ~255u) | 51u;
      g_[1] = (__float_as_uint(fmaxf(va[4] + vb[0], 0.f)) & ~255u) | 64u;
      g_[2] = (__float_as_uint(fmaxf(va[4] + vb[1], 0.f)) & ~255u) | 65u;
      g_[3] = (__float_as_uint(fmaxf(va[4] + vb[2], 0.f)) & ~255u) | 66u;
      g_[4] = (__float_as_uint(fmaxf(va[5] + vb[0], 0.f)) & ~255u) | 80u;
      g_[5] = (__float_as_uint(fmaxf(va[5] + vb[1], 0.f)) & ~255u) | 81u;
      g_[6] = (__float_as_uint(fmaxf(va[6] + vb[0], 0.f)) & ~255u) | 96u;
      g_[7] = (__float_as_uint(fmaxf(va[6] + vb[1], 0.f)) & ~255u) | 97u;
      g_[8] = (__float_as_uint(fmaxf(va[7] + vb[0], 0.f)) & ~255u) | 112u;
      g_[9] = (__float_as_uint(fmaxf(va[7] + vb[1], 0.f)) & ~255u) | 113u;
      g_[10] = (__float_as_uint(fmaxf(va[8] + vb[0], 0.f)) & ~255u) | 128u;
      g_[11] = (__float_as_uint(fmaxf(va[9] + vb[0], 0.f)) & ~255u) | 144u;
      g_[12] = (__float_as_uint(fmaxf(va[10] + vb[0], 0.f)) & ~255u) | 160u;
      g_[13] = (__float_as_uint(fmaxf(va[11] + vb[0], 0.f)) & ~255u) | 176u;
      g_[14] = (__float_as_uint(fmaxf(va[12] + vb[0], 0.f)) & ~255u) | 192u;
      g_[15] = (__float_as_uint(fmaxf(va[13] + vb[0], 0.f)) & ~255u) | 208u;
      sort16d(g_); merge16d(best, g_); }
    ins16(best, (__float_as_uint(fmaxf(va[14] + vb[0], 0.f)) & ~255u) | 224u);
    ins16(best, (__float_as_uint(fmaxf(va[15] + vb[0], 0.f)) & ~255u) | 240u);
    float sv[16]; float mx = -INFINITY;
#pragma unroll
    for (int i = 0; i < 16; ++i) { sv[i] = __uint_as_float(best[i] & ~255u); mx = fmaxf(mx, sv[i]); }
    float sum = 0.f;
#pragma unroll
    for (int i = 0; i < 16; ++i) { sv[i] = __expf(sv[i] - mx); sum += sv[i]; }
    const float inv = 1.f / sum;
    int eid[16]; unsigned tsel[16]; const unsigned hmask = hh ? 0xffffffffu : 0u;
#pragma unroll
    for (int q = 0; q < 16; ++q) tsel[q] = ((top[1][q] & hmask) | (top[0][q] & ~hmask)) & 127u;
    unsigned pk_[4];
#pragma unroll
    for (int w = 0; w < 4; ++w) pk_[w] = tsel[4 * w] | (tsel[4 * w + 1] << 8) | (tsel[4 * w + 2] << 16) | (tsel[4 * w + 3] << 24);
#pragma unroll
    for (int i = 0; i < 16; ++i) { const unsigned pi = best[i] & 255u; const unsigned sel = hh ? (pi & 15u) : (pi >> 4);
        const unsigned t0_ = (sel & 4u) ? pk_[1] : pk_[0], t1_ = (sel & 4u) ? pk_[3] : pk_[2], dw_ = (sel & 8u) ? t1_ : t0_;
        const unsigned mine_ = (dw_ >> ((sel & 3u) * 8u)) & 127u;
        auto r_ = __builtin_amdgcn_permlane32_swap(mine_, mine_, false, false); const unsigned oth_ = hh ? r_[0] : r_[1];
        eid[i] = hh ? (int)(oth_ * NKEYS + mine_) : (int)(mine_ * NKEYS + oth_); }
    LAS unsigned long long* cnt = (LAS unsigned long long*)lds;
    __syncthreads();
    if (hh == 0) { unsigned long long mine = 0ull;
#pragma unroll
        for (int i = 0; i < 16; ++i) mine += 1ull << (8 * pe_slice(eid[i]));
        cnt[c * 8 + h] = mine; }
    __syncthreads();
    {
        unsigned long long tot = 0ull, bhead = 0ull;
#pragma unroll
        for (int h2 = 0; h2 < 8; ++h2) { const unsigned long long w = cnt[c * 8 + h2]; tot += w; bhead += (h2 < h) ? w : 0ull; }
        unsigned long long incl = tot; incl += incl << 8; incl += incl << 16; incl += incl << 32;
        const unsigned long long start = incl << 8;
        unsigned long long base = start + bhead;
        LAS u32x2* lp_ = (LAS u32x2*)(lds + 4096); LAS float* ls_ = (LAS float*)(lds + 4096 + 32768);
        const float* su_t = (const float*)(p.ws + WS_SU); const float* sv_t = (const float*)(p.ws + WS_SV);
#pragma unroll
        for (int i = 0; i < 16; ++i) { const int sh = 8 * pe_slice(eid[i]); const unsigned pos = (unsigned)(base >> sh) & 0xffu; base += 1ull << sh;
            if ((i >> 3) == hh) { lp_[c * 128 + pos] = (u32x2){(unsigned)eid[i], __float_as_uint(sv[i] * inv * sv_t[eid[i]])}; ls_[c * 128 + pos] = su_t[eid[i]]; } }
        __syncthreads();
        { const int tok0 = unit * 32; const int tid_ = tidx;
          u32x4* gp = (u32x4*)((u32x2*)(p.ws + WS_CE) + (size_t)tok0 * 128); u32x4* gs = (u32x4*)((float*)(p.ws + WS_SUE) + (size_t)tok0 * 128);
#pragma unroll
          for (int r = 0; r < 4; ++r) { const int i4 = tid_ + 512 * r; gp[i4] = *(const LAS u32x4*)((LAS unsigned*)lp_ + 4 * i4); }
#pragma unroll
          for (int r = 0; r < 2; ++r) { const int i4 = tid_ + 512 * r; gs[i4] = *(const LAS u32x4*)(ls_ + 4 * i4); } }
        if (h == 0 && hh == 0) { unsigned char* of = (unsigned char*)(p.ws + WS_OFFS) + (size_t)tok * 16; *(unsigned long long*)of = start; of[8] = 128; }
    }
}

__device__ __forceinline__ float ub0(unsigned w) { float f; asm("v_cvt_f32_ubyte0 %0, %1" : "=v"(f) : "v"(w)); return f; }
__device__ __forceinline__ float ub1(unsigned w) { float f; asm("v_cvt_f32_ubyte1 %0, %1" : "=v"(f) : "v"(w)); return f; }
__device__ __forceinline__ float ub2(unsigned w) { float f; asm("v_cvt_f32_ubyte2 %0, %1" : "=v"(f) : "v"(w)); return f; }
__device__ __forceinline__ float ub3(unsigned w) { float f; asm("v_cvt_f32_ubyte3 %0, %1" : "=v"(f) : "v"(w)); return f; }
__device__ __forceinline__ void fma_ub4(float& a0, float& a1, float& a2, float& a3, float c, unsigned w) {
    float t0, t1, t2, t3;
    asm("v_cvt_f32_ubyte0 %4, %9\n\tv_cvt_f32_ubyte1 %5, %9\n\tv_cvt_f32_ubyte2 %6, %9\n\tv_cvt_f32_ubyte3 %7, %9\n\t"
        "v_fmac_f32 %0, %8, %4\n\tv_fmac_f32 %1, %8, %5\n\tv_fmac_f32 %2, %8, %6\n\tv_fmac_f32 %3, %8, %7"
        : "+v"(a0), "+v"(a1), "+v"(a2), "+v"(a3), "=&v"(t0), "=&v"(t1), "=&v"(t2), "=&v"(t3) : "v"(c), "v"(w));
}
__device__ __forceinline__ void fma_ub4m(float& a0, float& a1, float& a2, float& a3, float c, unsigned w, unsigned k64, unsigned s01, unsigned s23) {
    unsigned h0, h1;
    asm("v_perm_b32 %4, %7, %6, %8\n\tv_perm_b32 %5, %7, %6, %9\n\t"
        "v_fma_mix_f32 %0, %4, %10, %0 op_sel:[0,0,0] op_sel_hi:[1,0,0]\n\tv_fma_mix_f32 %1, %4, %10, %1 op_sel:[1,0,0] op_sel_hi:[1,0,0]\n\t"
        "v_fma_mix_f32 %2, %5, %10, %2 op_sel:[0,0,0] op_sel_hi:[1,0,0]\n\tv_fma_mix_f32 %3, %5, %10, %3 op_sel:[1,0,0] op_sel_hi:[1,0,0]"
        : "+v"(a0), "+v"(a1), "+v"(a2), "+v"(a3), "=&v"(h0), "=&v"(h1) : "v"(w), "v"(k64), "v"(s01), "v"(s23), "v"(c));
}
__device__ __forceinline__ int idot16(const u32x4 a, const u32x4 b, int acc) {
    acc = __builtin_amdgcn_sdot4((int)a.x, (int)b.x, acc, false); acc = __builtin_amdgcn_sdot4((int)a.y, (int)b.y, acc, false);
    acc = __builtin_amdgcn_sdot4((int)a.z, (int)b.z, acc, false); acc = __builtin_amdgcn_sdot4((int)a.w, (int)b.w, acc, false); return acc;
}
__device__ __forceinline__ float gelu_erf(float v) {
    const float av = fabsf(v), t = __builtin_amdgcn_rcpf(fmaf(av, 0.2316418882f, 1.0f));
    float q = fmaf(t, 0.5307027145f, -0.7265760135f); q = fmaf(q, t, 0.7107068705f); q = fmaf(q, t, -0.142248368f); q = fmaf(q, t, 0.127414796f); q *= t;
    const float e = __builtin_amdgcn_exp2f(v * v * -0.72134752044f), m = v * (q * e);
    return v < 0.f ? m : v - m;
}
#ifndef UKMAIN
#define UKMAIN 32
#endif
__device__ __forceinline__ void phase_peer_u(const Params& p, LAS unsigned char* lds, const int tidx) {
    const int lane = tidx & 63, wave = tidx >> 6, l32 = lane & 31, hf = lane >> 5, par = lane & 1;
    const int x = blockIdx.x & 7, nbx = ((int)gridDim.x - x + 7) >> 3, bl = (int)blockIdx.x >> 3;
    const int tpb = (NLAT + nbx - 1) / nbx, t0 = bl * tpb, t1 = min(NLAT, t0 + tpb);
    const int nsweep = (max(t1 - t0, 0) + NTHREADS - 1) / NTHREADS, nit = nsweep * 32;
    const unsigned char* tabg = (const unsigned char*)(p.ws + WS_EU8) + (size_t)x * (32 * 65536);
    const unsigned char* h2q = (const unsigned char*)(p.ws + WS_H2Q);
    const float* sue = (const float*)(p.ws + WS_SUE); const float* hs = (const float*)(p.ws + WS_HS);
    const u32x2* ce = (const u32x2*)(p.ws + WS_CE); const unsigned char* offs = (const unsigned char*)(p.ws + WS_OFFS);
    u32x2* cdst = p.dup ? (u32x2*)(p.ws + WS_CE + 48 * MiB) : (u32x2*)(p.ws + WS_CE);
    if (nit == 0) return;
    const unsigned wreg = (unsigned)wave * 8192u;
    auto stage = [&](int buf, int cs) { const unsigned char* g = tabg + (size_t)cs * 65536 + wreg + lane * 16;
#pragma unroll
        for (int i = 0; i < 8; ++i) __builtin_amdgcn_global_load_lds((const unsigned*)(g + i * 1024), (LAS unsigned*)(lds + buf * 65536 + wreg + i * 1024), 16, 0, 0); };
    int acc[32]; unsigned ids[16]; int o0 = 0, n = 0, tk = t0, nch = 0; float hsv = 0.f;
    u32x4 hA = {}, hB = {}, nA = {}, nB = {};
#pragma unroll
    for (int k = 0; k < 32; ++k) acc[k] = 0;
#pragma unroll
    for (int k = 0; k < 16; ++k) ids[k] = 0;
    stage(0, 0);
    for (int it = 0; it <= nit; it += 32) {
        asm volatile("s_waitcnt vmcnt(0)" ::: "memory"); __syncthreads();
        {
            LAS unsigned* st = (LAS unsigned*)(lds + ((it + 1) & 1) * 65536 + wreg);
            if (it > 0) {
#pragma unroll
                for (int j = 0; j < 8; ++j) *(LAS f32x4*)(st + lane * 32 + 4 * j) = (f32x4){(float)acc[4 * j], (float)acc[4 * j + 1], (float)acc[4 * j + 2], (float)acc[4 * j + 3]};
                asm volatile("s_waitcnt lgkmcnt(0)" ::: "memory");
                { u32x2 pr_[32]; float su_[32];
#pragma unroll
                  for (int i = 0; i < 32; ++i) {
                    const int oa = __builtin_amdgcn_readlane(o0, 2 * i), ob = __builtin_amdgcn_readlane(o0, 2 * i + 1);
                    const int ta = __builtin_amdgcn_readlane(tk, 2 * i), tb = __builtin_amdgcn_readlane(tk, 2 * i + 1);
                    const int oi = hf ? ob : oa, tki = hf ? tb : ta;
                    const size_t idx = (size_t)tki * 128 + min(oi + l32, 127); pr_[i] = ce[idx]; su_[i] = sue[idx]; }
#pragma unroll
                  for (int i = 0; i < 32; ++i) {
                    const int oa = __builtin_amdgcn_readlane(o0, 2 * i), ob = __builtin_amdgcn_readlane(o0, 2 * i + 1), na_ = __builtin_amdgcn_readlane(n, 2 * i), nb_ = __builtin_amdgcn_readlane(n, 2 * i + 1);
                    const float ha = __uint_as_float((unsigned)__builtin_amdgcn_readlane((int)__float_as_uint(hsv), 2 * i)), hb = __uint_as_float((unsigned)__builtin_amdgcn_readlane((int)__float_as_uint(hsv), 2 * i + 1));
                    const int ta = __builtin_amdgcn_readlane(tk, 2 * i), tb = __builtin_amdgcn_readlane(tk, 2 * i + 1);
                    const int ti = 2 * i + hf, oi = hf ? ob : oa, ni = min(hf ? nb_ : na_, UKMAIN), tki = hf ? tb : ta;
                    const float z = __uint_as_float(st[ti * 32 + l32]) * su_[i] * (hf ? hb : ha); const float c_ = __uint_as_float(pr_[i].y) * gelu_erf(z);
                    if (l32 < ni) ((float*)(cdst + (size_t)tki * 128 + oi + l32))[1] = c_; } }
                { unsigned long long hvm = __ballot(n > UKMAIN);
                  while (hvm) { const int i = (int)__builtin_ctzll(hvm); hvm &= hvm - 1ull;
                    const int ni = __builtin_amdgcn_readlane(n, i), oi = __builtin_amdgcn_readlane(o0, i), tki = __builtin_amdgcn_readlane(tk, i);
                    const float hsi = __uint_as_float((unsigned)__builtin_amdgcn_readlane((int)__float_as_uint(hsv), i));
                    const u32x4 h_ = *(const u32x4*)(h2q + ((size_t)(lane >> 1) * NLAT + tki) * 32 + par * 16);
                    for (int j0 = UKMAIN; j0 < ni; j0 += 8) {
                        u32x2 pr_[8]; float su_[8]; u32x4 a_[8];
#pragma unroll
                        for (int q = 0; q < 8; ++q) { const size_t idx = (size_t)tki * 128 + oi + min(j0 + q, ni - 1); pr_[q] = ce[idx]; su_[q] = sue[idx]; }
#pragma unroll
                        for (int q = 0; q < 8; ++q) a_[q] = *(const u32x4*)(tabg + ((size_t)(lane >> 1) * 2048 + pe_local(pr_[q].x)) * 32 + par * 16);
                        float mine = 0.f, myg = 0.f, mys = 0.f;
#pragma unroll
                        for (int q = 0; q < 8; ++q) { const float d = wave_sum((float)idot16(a_[q], h_, 0));
                            const bool me = lane == q; mine = me ? d : mine; myg = me ? __uint_as_float(pr_[q].y) : myg; mys = me ? su_[q] : mys; }
                        if (lane < 8 && j0 + lane < ni) { const float z = mine * mys * hsi; ((float*)(cdst + (size_t)tki * 128 + oi + j0 + lane))[1] = myg * gelu_erf(z); } } } }
                asm volatile("s_waitcnt lgkmcnt(0)" ::: "memory");
            }
            if (it == nit) break;
            {
              LAS unsigned* hist = (LAS unsigned*)(lds + 131072); LAS unsigned* pre = hist + 64; LAS unsigned* perm = hist + 128;
              const int swb = t0 + (it >> 5) * NTHREADS, tok0 = swb + tidx; const bool tv0 = tok0 < t1; const int tkc = tv0 ? tok0 : t1 - 1;
              const unsigned o2 = *(const unsigned short*)(offs + (size_t)tkc * 16 + x); const unsigned o0a = o2 & 0xffu, na = tv0 ? (o2 >> 8) - o0a : 0u;
              const unsigned bin = 32u - min(na, 32u);
              if (tidx < 64) hist[tidx] = 0u;
              __syncthreads();
              const unsigned slot = __hip_atomic_fetch_add(hist + bin, 1u, __ATOMIC_RELAXED, __HIP_MEMORY_SCOPE_WORKGROUP);
              __syncthreads();
              if (wave == 0) { unsigned v = hist[lane]; const unsigned own = v;
#pragma unroll
                  for (int o = 1; o < 64; o <<= 1) { const unsigned t_ = (unsigned)__shfl_up((int)v, o); v += (lane >= o) ? t_ : 0u; }
                  pre[lane] = v - own; }
              __syncthreads();
              { const unsigned r = pre[bin] + slot, oct = r >> 6, w_ = oct < 4u ? oct : 11u - oct;
                perm[w_ * 64u + (r & 63u)] = (unsigned)(tkc - swb) | (o0a << 9) | (na << 17); }
              __syncthreads();
              const unsigned pm = perm[tidx]; tk = swb + (int)(pm & 511u); o0 = (int)((pm >> 9) & 0xffu); n = (int)(pm >> 17); hsv = hs[tk]; }
            { unsigned ev_[32];
#pragma unroll
              for (int i = 0; i < 32; ++i) {
                const int oa = __builtin_amdgcn_readlane(o0, 2 * i), ob = __builtin_amdgcn_readlane(o0, 2 * i + 1);
                const int ta = __builtin_amdgcn_readlane(tk, 2 * i), tb = __builtin_amdgcn_readlane(tk, 2 * i + 1);
                const int oi = hf ? ob : oa, tki = hf ? tb : ta;
                ev_[i] = ce[(size_t)tki * 128 + min(oi + l32, 127)].x; }
#pragma unroll
              for (int i = 0; i < 32; ++i) {
                const int na_ = __builtin_amdgcn_readlane(n, 2 * i), nb_ = __builtin_amdgcn_readlane(n, 2 * i + 1);
                const int ti = 2 * i + hf, ni = min(hf ? nb_ : na_, UKMAIN);
                st[ti * 32 + l32] = (l32 < ni) ? (pe_local(ev_[i]) << 5) : 0u; } }
            asm volatile("s_waitcnt lgkmcnt(0)" ::: "memory");
            { const unsigned po = (unsigned)par * 16u * 0x10001u;
#pragma unroll
              for (int j = 0; j < 8; ++j) { const u32x4 q = *(const LAS u32x4*)(st + lane * 32 + 4 * j); ids[2 * j] = (q.x | (q.y << 16)) + po; ids[2 * j + 1] = (q.z | (q.w << 16)) + po; } }
            asm volatile("s_waitcnt lgkmcnt(0)" ::: "memory");
            { const int nm = min(n, UKMAIN); const int mx = __builtin_amdgcn_readfirstlane((int)wave_max_fast((float)nm)); nch = (mx + 3) >> 2; }
#pragma unroll
            for (int k = 0; k < 32; ++k) acc[k] = 0;
            { const unsigned char* hp = h2q + (size_t)tk * 32; nA = *(const u32x4*)(hp + par * 16); nB = *(const u32x4*)(hp + (par ^ 1) * 16); }
        }
        u32x4 ra[4][2], rb[4][2];
#define PU_OF(k) ((((k) & 1) ? (ids[(k) >> 1] >> 16) : (ids[(k) >> 1] & 0xffffu)))
#define PU_LD(R, c) do { _Pragma("unroll") for (int q_ = 0; q_ < 4; ++q_) { const unsigned of_ = PU_OF(4 * (c) + q_); const unsigned a0_ = lA + of_, a1_ = lB + of_; \
            asm volatile("ds_read_b128 %0, %1" : "=v"(R[q_][0]) : "v"(a0_)); asm volatile("ds_read_b128 %0, %1" : "=v"(R[q_][1]) : "v"(a1_)); } } while (0)
#define PU_WAIT(n) asm volatile("s_waitcnt lgkmcnt(" #n ")" ::: "memory")
#define PU_CP(R, c) do { _Pragma("unroll") for (int q_ = 0; q_ < 4; ++q_) acc[4 * (c) + q_] = idot16(R[q_][1], hB, idot16(R[q_][0], hA, acc[4 * (c) + q_])); } while (0)
#define PU_BODY(N) do { if ((N) > 0) { PU_LD(ra, 0); \
            _Pragma("unroll") for (int c = 0; c < (N); c += 2) { \
                if (c + 1 < (N)) { PU_LD(rb, c + 1); PU_WAIT(8); } else PU_WAIT(0); \
                __builtin_amdgcn_sched_barrier(0); PU_CP(ra, c); __builtin_amdgcn_sched_barrier(0); \
                if (c + 1 < (N)) { if (c + 2 < (N)) { PU_LD(ra, c + 2); PU_WAIT(8); } else PU_WAIT(0); \
                    __builtin_amdgcn_sched_barrier(0); PU_CP(rb, c + 1); __builtin_amdgcn_sched_barrier(0); } } } } while (0)
#define PU_RUN(N) do { _Pragma("unroll 1") for (int cs = 0; cs < 32; ++cs) { const int ii = it + cs; \
            if (cs > 0) { asm volatile("s_waitcnt vmcnt(0)" ::: "memory"); __syncthreads(); }        \
            if (ii + 1 < nit) stage((ii + 1) & 1, (cs + 1) & 31); \
            hA = nA; hB = nB; \
            if (cs < 31) { const unsigned char* hp = h2q + ((size_t)(cs + 1) * NLAT + tk) * 32; nA = *(const u32x4*)(hp + par * 16); nB = *(const u32x4*)(hp + (par ^ 1) * 16); } \
            const unsigned lA = (unsigned)(size_t)lds + (unsigned)((ii & 1) * 65536), lB = lA + 16u - 32u * (unsigned)par;     \
            PU_BODY(N); } } while (0)
        switch (nch) { case 1: PU_RUN(1); break; case 2: PU_RUN(2); break; case 3: PU_RUN(3); break; case 4: PU_RUN(4); break;
                       case 5: PU_RUN(5); break; case 6: PU_RUN(6); break; case 7: PU_RUN(7); break; case 8: PU_RUN(8); break; default: PU_RUN(0); break; }
#undef PU_RUN
#undef PU_BODY
#undef PU_OF
#undef PU_LD
#undef PU_WAIT
#undef PU_CP
    }
}
__device__ __forceinline__ void phase_peer_v(const Params& p, LAS unsigned char* lds, const int tidx) {
    const int lane = tidx & 63, wave = tidx >> 6;
    const int x = blockIdx.x & 7, nbx = ((int)gridDim.x - x + 7) >> 3, wl = ((int)blockIdx.x >> 3) * NWAVES + wave, wstride = nbx * NWAVES;
    const unsigned char* ev8 = (const unsigned char*)(p.ws + WS_EV8) + (size_t)x * (NEXP * 128);
    const unsigned cgo = (unsigned)(lane & 7) * 16u;
    const u32x4* ce4 = (const u32x4*)(p.ws + WS_CE); const float* mod = (const float*)(p.ws + WS_MOD);
    LAS int* le = (LAS int*)(lds + wave * 2048);
    LAS unsigned char* lc8 = (LAS unsigned char*)(lds + wave * 2048 + 1536);
    const int rg = lane >> 3, cg = lane & 7; const bool b3 = lane & 8;
    const int colo = cg * 16 + ((lane & 32) ? 8 : 0) + ((lane & 16) ? 4 : 0) + (b3 ? 2 : 0);
    const int ntok_w = (NLAT - wl + wstride - 1) / wstride;
    const float pscale = p.dup ? 0.f : DBG_PSCALE; const bf16_t* x1b = (const bf16_t*)(p.ws + WS_X1B);
    float n_c0 = 0.f, n_c1 = 0.f; int n_e0 = 0, n_e1 = 0;
    auto fetch = [&](int i) { if (i < ntok_w) { const u32x4 q_ = ce4[(size_t)(wl + wstride * i) * 64 + lane]; n_e0 = (int)q_.x; n_c0 = __uint_as_float(q_.y); n_e1 = (int)q_.z; n_c1 = __uint_as_float(q_.w); } };
    auto stage = [&](int buf, float& cscale) {
        const float cm = fmaxf(wave_max_fast(fmaxf(fabsf(n_c0), fabsf(n_c1))), 1e-30f); const float inv = 127.f / cm; cscale = cm * (1.f / 127.f);
        *(LAS u32x2*)(le + buf * 128 + 2 * lane) = (u32x2){(unsigned)n_e0, (unsigned)n_e1};
        lc8[buf * 128 + ((2 * lane) & 7) * 16 + (lane >> 2)] = (unsigned char)(__float2int_rn(n_c0 * inv) & 0xff);
        lc8[buf * 128 + ((2 * lane + 1) & 7) * 16 + (lane >> 2)] = (unsigned char)(__float2int_rn(n_c1 * inv) & 0xff);
        asm volatile("s_waitcnt lgkmcnt(0)" ::: "memory"); };
    u32x4 ra[16], rb[16], rc[16]; float csa = 0.f, csb = 0.f, csc = 0.f; int gb_ = -1; f32x2 gq_ = {0.f, 0.f};
#define PV_LOAD(buf, R) do { _Pragma("unroll") for (int it = 0; it < 16; ++it) { const unsigned e_ = (unsigned)le[(buf) * 128 + 8 * it + rg]; R[it] = *(const u32x4*)(ev8 + ((e_ << 7) | cgo)); } } while (0)
#define PV_T4(r0, r1, r2, r3, cq_, A0, A1, A2, A3) do { \
        const unsigned t0 = __builtin_amdgcn_perm(r1, r0, 0x05010400u), t1 = __builtin_amdgcn_perm(r1, r0, 0x07030602u); \
        const unsigned u0 = __builtin_amdgcn_perm(r3, r2, 0x05010400u), u1 = __builtin_amdgcn_perm(r3, r2, 0x07030602u); \
        A0 = __builtin_amdgcn_sdot4((int)__builtin_amdgcn_perm(u0, t0, 0x05040100u), (int)(cq_), A0, false); \
        A1 = __builtin_amdgcn_sdot4((int)__builtin_amdgcn_perm(u0, t0, 0x07060302u), (int)(cq_), A1, false); \
        A2 = __builtin_amdgcn_sdot4((int)__builtin_amdgcn_perm(u1, t1, 0x05040100u), (int)(cq_), A2, false); \
        A3 = __builtin_amdgcn_sdot4((int)__builtin_amdgcn_perm(u1, t1, 0x07060302u), (int)(cq_), A3, false); } while (0)
#define PV_COMP(buf, R, i_, cs_) do { int acc[16]; \
        const int tok = wl + wstride * (i_); const int b = tok / T; float* op = p.out + (size_t)tok * D + x * 128 + colo; \
        if (b != gb_) { gb_ = b; gq_ = *(const f32x2*)(mod + (size_t)b * NMOD + 5 * D + x * 128 + colo) * pscale; }     \
        const unsigned xw_ = *(const unsigned*)(x1b + (size_t)tok * D + x * 128 + colo); f32x2 xv; xv[0] = __uint_as_float(xw_ << 16); xv[1] = __uint_as_float(xw_ & 0xffff0000u); const f32x2 gg = gq_ * (cs_); \
        const u32x4 cq = *(const LAS u32x4*)(lc8 + (buf) * 128 + rg * 16); \
        _Pragma("unroll") for (int q = 0; q < 16; ++q) acc[q] = 0; \
        _Pragma("unroll") for (int a = 0; a < 4; ++a) { const unsigned cqa = cq[a]; \
            PV_T4(R[4 * a].x, R[4 * a + 1].x, R[4 * a + 2].x, R[4 * a + 3].x, cqa, acc[0], acc[1], acc[2], acc[3]); \
            PV_T4(R[4 * a].y, R[4 * a + 1].y, R[4 * a + 2].y, R[4 * a + 3].y, cqa, acc[4], acc[5], acc[6], acc[7]); \
            PV_T4(R[4 * a].z, R[4 * a + 1].z, R[4 * a + 2].z, R[4 * a + 3].z, cqa, acc[8], acc[9], acc[10], acc[11]); \
            PV_T4(R[4 * a].w, R[4 * a + 1].w, R[4 * a + 2].w, R[4 * a + 3].w, cqa, acc[12], acc[13], acc[14], acc[15]); } \
        int a8[8], a4[4], a2[2]; \
        _Pragma("unroll") for (int q = 0; q < 8; ++q) { auto r_ = __builtin_amdgcn_permlane32_swap((unsigned)acc[q], (unsigned)acc[8 + q], false, false); a8[q] = (int)r_[0] + (int)r_[1]; } \
        _Pragma("unroll") for (int q = 0; q < 4; ++q) { auto r_ = __builtin_amdgcn_permlane16_swap((unsigned)a8[q], (unsigned)a8[4 + q], false, false); a4[q] = (int)r_[0] + (int)r_[1]; } \
        _Pragma("unroll") for (int q = 0; q < 2; ++q) { const int snd = b3 ? a4[q] : a4[2 + q], kp = b3 ? a4[2 + q] : a4[q]; a2[q] = kp + dppi<0x128>(snd); } \
        f32x2 rr; rr[0] = xv[0] + gg[0] * (float)a2[0]; rr[1] = xv[1] + gg[1] * (float)a2[1]; *(f32x2*)op = rr; } while (0)
    if (ntok_w > 0) { fetch(0); stage(0, csa); fetch(1); PV_LOAD(0, ra); }
    if (ntok_w > 1) { stage(1, csb); fetch(2); PV_LOAD(1, rb); }
    for (int i = 0; i < ntok_w; i += 3) {
        if (i + 2 < ntok_w) { stage(2, csc); fetch(i + 3); PV_LOAD(2, rc); }
        PV_COMP(0, ra, i, csa);
        if (i + 3 < ntok_w) { stage(0, csa); fetch(i + 4); PV_LOAD(0, ra); }
        if (i + 1 < ntok_w) PV_COMP(1, rb, i + 1, csb);
        if (i + 4 < ntok_w) { stage(1, csb); fetch(i + 5); PV_LOAD(1, rb); }
        if (i + 2 < ntok_w) PV_COMP(2, rc, i + 2, csc);
    }
#undef PV_LOAD
#undef PV_T4
#undef PV_COMP
}

#ifndef DBG_CHECK
#define DBG_CHECK 0
#endif
#ifndef DBG_SEL
#define DBG_SEL 4
#endif
__device__ __forceinline__ int dbg_tok(int slot) { return slot * 128 + 37; }
__device__ __forceinline__ float block_sum(float v, LAS float* red, const int tidx) {
    v = wave_sum(v); __syncthreads(); if ((tidx & 63) == 0) red[tidx >> 6] = v; __syncthreads();
    float s = 0.f; for (int w = 0; w < 8; ++w) s += red[w]; return s;
}
__device__ __forceinline__ void dbg_peer_check(const Params& p, LAS unsigned char* lds, const int tidx) {
    const int tid = tidx, lane = tid & 63, wave = tid >> 6;
    LAS float* h2f = (LAS float*)lds;
    LAS float* q = h2f + 1024;
    LAS float* sp = q + 2048;
    LAS float* topv = sp + 256;
    LAS int* topi = (LAS int*)(topv + 32);
    LAS float* cv = (LAS float*)(topi + 32);
    LAS float* bestv = cv + 256;
    LAS int* eref = (LAS int*)(bestv + 16);
    LAS float* gref = (LAS float*)(eref + 128);
    LAS float* wref = gref + 128;
    LAS float* red = wref + 128;
    for (int slot = blockIdx.x; slot < 256; slot += gridDim.x) {
        const int tok = dbg_tok(slot);
        const bf16_t* h2 = (const bf16_t*)(p.ws + WS_H2) + (size_t)tok * D;
        __syncthreads();
        for (int i = tid; i < D; i += NTHREADS) h2f[i] = bf2f(h2[i]);
        __syncthreads();
        for (int n = tid; n < 2048; n += NTHREADS) { float s = 0.f; for (int k = 0; k < D; ++k) s += h2f[k] * p.w_pq[(size_t)k * 2048 + n]; q[n] = s; }
        __syncthreads();
        for (int h = 0; h < PH; ++h) {
            if (tid < 256) { const int pp = tid >> 7, k = tid & 127; float s = 0.f; const float* sk = p.sub_keys + ((size_t)(h * 2 + pp) * NKEYS + k) * 128;
                for (int d = 0; d < 128; ++d) s += q[h * 256 + pp * 128 + d] * sk[d]; sp[tid] = s; }
            __syncthreads();
            if (tid < 256) { const int pp = tid >> 7, k = tid & 127; const float v = sp[tid]; int r = 0;
                for (int k2 = 0; k2 < 128; ++k2) { const float v2 = sp[pp * 128 + k2]; r += (v2 > v || (v2 == v && k2 < k)) ? 1 : 0; }
                if (r < 16) { topv[pp * 16 + r] = v; topi[pp * 16 + r] = k; } }
            __syncthreads();
            if (tid < 256) cv[tid] = topv[tid >> 4] + topv[16 + (tid & 15)];
            __syncthreads();
            if (tid < 256) { const float v = cv[tid]; int r = 0;
                for (int t2 = 0; t2 < 256; ++t2) { const float v2 = cv[t2]; r += (v2 > v || (v2 == v && t2 < tid)) ? 1 : 0; }
                if (r < 16) { bestv[r] = v; eref[h * 16 + r] = topi[tid >> 4] * NKEYS + topi[16 + (tid & 15)]; } }
            __syncthreads();
            if (tid < 16) { float mx = bestv[0]; for (int i = 1; i < 16; ++i) mx = fmaxf(mx, bestv[i]); float sum = 0.f; for (int i = 0; i < 16; ++i) sum += expf(bestv[i] - mx);
                gref[h * 16 + tid] = expf(bestv[tid] - mx) / sum; }
            __syncthreads();
        }
        float terr = 0.f, tden = 0.f;
        { const bf16_t* eub = (const bf16_t*)(p.ws + WS_EU);
          for (int k = 0; k < 128; ++k) { const size_t e = (size_t)eref[k]; for (int d = tid; d < D; d += NTHREADS) { const float a = p.expert_u[e * D + d], bq = bf2f(eub[e * D + d]); terr += (a - bq) * (a - bq); tden += a * a; } } }
        terr = block_sum(terr, red, tidx); tden = block_sum(tden, red, tidx);
        for (int kk = 0; kk < 16; ++kk) { const int k = wave * 16 + kk; const float* ur = p.expert_u + (size_t)eref[k] * D; float s = 0.f;
            for (int d = lane; d < D; d += 64) s += ur[d] * h2f[d];
            s = wave_sum(s); if (lane == 0) wref[k] = gref[k] * 0.5f * s * (1.f + erff(s * 0.70710678118654752f)); }
        __syncthreads();
        const float* pf = (const float*)(p.ws + WS_DBGP) + (size_t)slot * D;
        float num = 0.f, den = 0.f;
        for (int d = tid; d < D; d += NTHREADS) { float o = 0.f; for (int k = 0; k < 128; ++k) o += wref[k] * p.expert_v[(size_t)eref[k] * D + d];
            const float f = pf[d]; num += (f - o) * (f - o); den += o * o; }
        num = block_sum(num, red, tidx); den = block_sum(den, red, tidx);
        const int* ef = (const int*)(p.ws + WS_EIDX) + (size_t)tok * 128; const float* gf = (const float*)(p.ws + WS_GW) + (size_t)tok * 128;
        float miss = 0.f, gerr = 0.f, gden = 0.f, werr = 0.f, wden = 0.f; const float* wf = (const float*)(p.ws + WS_DBGP + MiB) + (size_t)slot * 128;
        if (tid < 128) { const int e = ef[tid]; int found = -1; for (int k = 0; k < 128; ++k) if (eref[k] == e && (k >> 4) == (tid >> 4)) found = k;
            if (found < 0) miss = 1.f; else { const float dg = gf[tid] - gref[found]; gerr = dg * dg; gden = gref[found] * gref[found]; const float dw = wf[tid] - wref[found]; werr = dw * dw; wden = wref[found] * wref[found]; } }
        werr = block_sum(werr, red, tidx); wden = block_sum(wden, red, tidx);
        miss = block_sum(miss, red, tidx); gerr = block_sum(gerr, red, tidx); gden = block_sum(gden, red, tidx);
        if (tid == 0) { float* r = (float*)(p.ws + WS_DBGR) + slot * 8; r[0] = num; r[1] = den; r[2] = miss; r[3] = gerr; r[4] = gden; r[5] = werr; r[6] = wden; r[7] = terr / tden; }
    }
}
__device__ __forceinline__ void dbg_report(const Params& p, const int tidx) {
    const float* r = (const float*)(p.ws + WS_DBGR);
    float num = 0.f, den = 0.f, miss = 0.f, gerr = 0.f, gden = 0.f, werr = 0.f, wden = 0.f;
    for (int s = 0; s < 256; ++s) { num += r[s * 8]; den += r[s * 8 + 1]; miss += r[s * 8 + 2]; gerr += r[s * 8 + 3]; gden += r[s * 8 + 4]; werr += r[s * 8 + 5]; wden += r[s * 8 + 6]; }
    float val = 0.f;
    if (DBG_SEL == 1) val = num / den;
    if (DBG_SEL == 2) val = miss / (256.f * 128.f);
    if (DBG_SEL == 3) val = gerr / gden;
    if (DBG_SEL == 5) { float t = 0.f; for (int s = 0; s < 256; ++s) t += r[s * 8 + 7]; val = t / 256.f; }
    if (DBG_SEL == 4) val = werr / wden;
    const float sc = 1.f + sqrtf(fminf(val, 100.f));
    const int gt = blockIdx.x * NTHREADS + tidx, NGT = gridDim.x * NTHREADS;
    for (int i = gt; i < NLAT * D / 4; i += NGT) ((f32x4*)p.out)[i] = ((const f32x4*)p.x)[i] * sc;
}

#define XB_TMO      128
#define XB_XCNT(j)  (256  + 64 * (j))
#define XB_XSUB(j)  (1280 + 64 * (j))
#define XB_XGEN(j)  (2304 + 64 * (j))
#define XB_TOP      3328
#define XB_TOPGEN   3392
#define XCD_BAR_WORDS 3456
#define XB_SPIN_CAP (1u << 22)
__device__ __forceinline__ unsigned xb_ld(unsigned* p)              { return __hip_atomic_load(p, __ATOMIC_RELAXED, __HIP_MEMORY_SCOPE_AGENT); }
__device__ __forceinline__ unsigned xb_add(unsigned* p, unsigned v) { return __hip_atomic_fetch_add(p, v, __ATOMIC_RELAXED, __HIP_MEMORY_SCOPE_AGENT); }
__device__ __forceinline__ unsigned xb_xcc_id() { return (unsigned)__builtin_amdgcn_s_getreg((3 << 11) | 20) & 0xFu; }
#define XB_SPIN(cond, bar) do { unsigned _sp = 0; while (cond) { __builtin_amdgcn_s_sleep(1); \
    if ((++_sp & 255u) == 0u) { if (xb_ld(&(bar)[XB_TMO])) break; if (_sp > XB_SPIN_CAP) { atomicAdd(&(bar)[XB_TMO], 1u); break; } } } } while (0)
struct XcdBarrier { unsigned* bar; unsigned x; volatile LAS unsigned* st; };
__device__ __forceinline__ XcdBarrier xcd_barrier_post(unsigned* bar, volatile LAS unsigned* st) {
    XcdBarrier b; b.bar = bar; b.x = xb_xcc_id(); b.st = st;
    if (threadIdx.x == 0) (void)xb_add(&bar[XB_XCNT(b.x)], 1u);
    return b;
}
__device__ __forceinline__ void xcd_barrier_complete(unsigned* bar, unsigned x, unsigned& nloc, unsigned& nx) {
    const unsigned G = gridDim.x * gridDim.y * gridDim.z;
    unsigned sum, cnt, mine, sp = 0u;
    for (;;) {
        sum = 0u; cnt = 0u; mine = 0u;
#pragma unroll
        for (unsigned j = 0; j < 16; ++j) { const unsigned c = xb_ld(&bar[XB_XCNT(j)]); sum += c; cnt += (c > 0u) ? 1u : 0u; mine = (j == x) ? c : mine; }
        if (sum == G) break;
        __builtin_amdgcn_s_sleep(1);
        if ((++sp & 255u) == 0u) { if (xb_ld(&bar[XB_TMO])) break; if (sp > XB_SPIN_CAP) { atomicAdd(&bar[XB_TMO], 1u); break; } }
    }
    nloc = mine > 0u ? mine : 1u; nx = cnt > 0u ? cnt : 1u;
}
__device__ __forceinline__ void xcd_barrier(const XcdBarrier& b, const int tidx) {
    asm volatile("s_waitcnt vmcnt(0)" ::: "memory");
    __syncthreads();
    if (tidx == 0) {
        unsigned* bar = b.bar;
        __builtin_amdgcn_s_waitcnt(0);
        unsigned nloc = b.st[0], nx = b.st[1];
        if (nloc == 0u) { xcd_barrier_complete(bar, b.x, nloc, nx); b.st[0] = nloc; b.st[1] = nx; }
        const unsigned old = xb_add(&bar[XB_XSUB(b.x)], 1u);
        const unsigned gen = old / nloc;
        if (old + 1u == (gen + 1u) * nloc) {
            __builtin_amdgcn_fence(__ATOMIC_RELEASE, "agent");
            asm volatile("s_waitcnt vmcnt(0)" ::: "memory");
            const unsigned og = xb_add(&bar[XB_TOP], 1u);
            const unsigned tg = og / nx;
            if (og + 1u == (tg + 1u) * nx) xb_add(&bar[XB_TOPGEN], 1u);
            else XB_SPIN(xb_ld(&bar[XB_TOPGEN]) == tg, bar);
            xb_add(&bar[XB_XGEN(b.x)], 1u);
            __builtin_amdgcn_fence(__ATOMIC_ACQUIRE, "agent");
            asm volatile("s_waitcnt vmcnt(0)" ::: "memory");
        } else {
            XB_SPIN(xb_ld(&bar[XB_XGEN(b.x)]) == gen, bar);
            __builtin_amdgcn_fence(__ATOMIC_ACQUIRE, "agent");
            asm volatile("s_waitcnt vmcnt(0)" ::: "memory");
        }
    }
    __syncthreads();
}
constexpr int NPHASE = 12 + 2 * DBG_CHECK;
constexpr int LDS_BYTES = 160 * 1024;
typedef const __attribute__((address_space(4))) Params* KargPtr;
#if defined(__HIP_DEVICE_COMPILE__)
#define PLOAD() KargPtr kq_ = kp; asm volatile("" : "+s"(kq_)); const Params p = *kq_; unsigned char* ws = p.ws; (void)ws; const int tidx = (wave_s << 6) | lane_id_v()
#else
#define PLOAD() const Params p = p_unused; unsigned char* ws = p.ws; (void)ws; const int tidx = (wave_s << 6) | lane_id_v()
#endif
__global__ void __launch_bounds__(NTHREADS, 2) mega(Params p_unused) {
    extern __shared__ __attribute__((aligned(16))) unsigned char lds_raw[];
    LAS unsigned char* lds = (LAS unsigned char*)lds_raw;
    KargPtr kp = (KargPtr)__builtin_amdgcn_kernarg_segment_ptr();
    const int lo = kp->ph_lo, hi = kp->ph_hi;
    const int G = gridDim.x, bid = blockIdx.x;
    const int wave_s = __builtin_amdgcn_readfirstlane(threadIdx.x >> 6);
#if !MK_MULTI && !MK_CGSYNC
    volatile LAS unsigned* xst = (volatile LAS unsigned*)(lds + LDS_BYTES - 64);
    if (threadIdx.x < 2) xst[threadIdx.x] = 0u;
    __syncthreads();
    const XcdBarrier xbar = xcd_barrier_post((unsigned*)(kp->ws + WS_BAR), xst);
#endif
#ifndef PHMASK
#define PHMASK 0xFFFFF
#endif
#define IN(k) (((PHMASK >> (k)) & 1) && lo <= (k) && (k) < hi)
#define TIDX() ((wave_s << 6) | lane_id_v())
#if MK_MULTI
#define SEAM(k) do { } while (0)
#else
#if MK_CGSYNC
#define SEAM(k) do { if (IN(k) && IN((k) + 1)) cg::this_grid().sync(); } while (0)
#else
#define SEAM(k) do { if (IN(k) && IN((k) + 1)) xcd_barrier(xbar, (wave_s << 6) | lane_id_v()); } while (0)
#endif
#endif
    if (IN(0)) { PLOAD(); phase_prep(p, lds, tidx); }
    SEAM(0);
    if (IN(1)) { PLOAD(); phase_hnorm(p, tidx); }
    SEAM(1);
    if (IN(2)) { PLOAD(); pg8::Gemm g{(const bf16_t*)(ws + WS_HB), (const bf16_t*)(ws + WS_WIN), NTOK, INCP, D, D, D, 0}; pg8::StaticOrder S; S.init(NTOK, INCP, G, bid);
        pg8::EpiCols E{(bf16_t*)(ws + WS_COLS), (float*)(ws + WS_GATES), (float*)(ws + WS_SSQ)}; pg8::gemm_phase(lds, g, S, E, tidx);
        { const int nt = (NTOK / 256) * (INCP / 256), extra = nt % G;
          if (extra == 0 || extra >= G) quant_experts(p, lds, bid, G, TIDX()); else if (bid >= extra) quant_experts(p, lds, bid - extra, G - extra, TIDX()); } }
    SEAM(2);
    if (IN(3)) { PLOAD();
        { pg8::Gemm g{(const bf16_t*)(ws + WS_COLS) + C_CQ, (const bf16_t*)(ws + WS_WUQ), NLAT, 1024, 256, INCP, 256, 0}; pg8::StaticOrder S; S.init(NLAT, 1024, G, bid);
          const int t_ = TIDX(); pg8::EpiQ E{(const float*)(ws + WS_SSQ), p.g_qn, (const float*)(ws + WS_ROPE), (bf16_t*)(ws + WS_Q), lds + 128 * 1024, t_}; pg8::gemm_phase(lds, g, S, E, t_); }
        { pg8::Gemm g{(const bf16_t*)(ws + WS_COLS) + C_CKV, (const bf16_t*)(ws + WS_WUKV), NTOK, 1024, 128, INCP, 128, 0}; pg8::StaticOrder S; S.init(NTOK, 1024, G, bid);
          const int t_ = TIDX(); pg8::EpiKV E{(const bf16_t*)(ws + WS_COLS), (const float*)(ws + WS_SSQ), p.g_kn, (const float*)(ws + WS_ROPE), (bf16_t*)(ws + WS_K), (bf16_t*)(ws + WS_VT), lds + 128 * 1024, t_}; pg8::gemm_phase(lds, g, S, E, t_); }
        { const int t_ = TIDX(); for (int u = (bid + G / 2) % G; u < NB * MH * 17; u += G) ml_summary_unit(p, lds, u, t_); }
    }
    SEAM(3);
    if (IN(4)) { PLOAD(); phase_ml_scan(p, tidx); }
    SEAM(4);
    if (IN(5)) { PLOAD();
        if (!p.dup || DUP_SUB == 0) { const int t_ = TIDX(); for (int u = bid; u < NB * NH * (T / 256); u += G) attn_unit(p, lds, u, t_); }
        if (!p.dup || DUP_SUB == 1) { const int t_ = TIDX(); for (int u = bid; u < NB * MH * NBLK; u += G) ml_output_unit(p, lds, u, t_); }
    }
    SEAM(5);
    if (IN(6)) { PLOAD(); pg8::Gemm g{(const bf16_t*)(ws + WS_MIX), (const bf16_t*)(ws + WS_WOUT), NLAT, D, D, D, D, 0}; pg8::StaticOrder S; S.init(NLAT, D, G, bid);
        pg8::EpiResid E{p.x, (bf16_t*)(ws + WS_X1B), (const float*)(ws + WS_MOD), 2 * D, (DBG_MODE == 1 || DBG_MODE == 5) ? 0.f : 1.f}; pg8::gemm_phase(lds, g, S, E, tidx); }
    SEAM(6);
#if DBG_MODE == 0 || DBG_MODE == 5
    if (IN(7)) { PLOAD(); phase_h2(p, tidx); }
    SEAM(7);
    if (IN(8)) { PLOAD(); pg8::Gemm g{(const bf16_t*)(ws + WS_H2), (const bf16_t*)(ws + WS_WPQ), NLAT, 2048, D, D, D, 0}; pg8::StaticOrder S; S.init(NLAT, 2048, G, bid);
        pg8::EpiBf16 E{(bf16_t*)(ws + WS_QP), 2048}; pg8::gemm_phase(lds, g, S, E, tidx); }
    SEAM(8);
    if (IN(9)) { PLOAD(); for (int u = bid; u < NLAT / 32; u += G) peer_topk_unit(p, lds, u, tidx); }
    SEAM(9);
    if (IN(10)) { PLOAD(); phase_peer_u(p, lds, tidx); }
    SEAM(10);
    if (IN(11)) { PLOAD(); phase_peer_v(p, lds, tidx); }
#endif
#if DBG_CHECK
    SEAM(11);
    if (IN(12)) { PLOAD(); dbg_peer_check(p, lds, tidx); }
    SEAM(12);
    if (IN(13)) { PLOAD(); dbg_report(p, tidx); }
#endif
#undef IN
#undef SEAM
}

extern "C" void kernel_launch(void* const* d_in, const int* in_sizes, int n_in, void* d_out, int out_size, void* d_ws, size_t ws_size, hipStream_t stream) {
    static int grid = 0;
    if (grid == 0) {
        if (n_in != 24 || out_size != NLAT * D || ws_size < WS_END) { fprintf(stderr, "kernel_launch: unexpected shapes (n_in %d out %d ws %zu, need %zu)\n", n_in, out_size, ws_size, (size_t)WS_END); grid = -1; return; }
        int dev = 0, cus = 0, per_cu = 0;
        hipGetDevice(&dev); hipDeviceGetAttribute(&cus, hipDeviceAttributeMultiprocessorCount, dev);
        hipFuncSetAttribute((const void*)mega, hipFuncAttributeMaxDynamicSharedMemorySize, LDS_BYTES);
        hipOccupancyMaxActiveBlocksPerMultiprocessor(&per_cu, (const void*)mega, NTHREADS, LDS_BYTES);
        (void)hipGetLastError();
        if (per_cu < 1) { fprintf(stderr, "kernel_launch: occupancy query says %d blocks per CU\n", per_cu); per_cu = 1; }
        grid = cus;
    }
    if (grid < 0) return;
    Params p{};
    const float** pp = (const float**)&p;
    for (int i = 0; i < 24; ++i) pp[i] = (const float*)d_in[i];
    p.out = (float*)d_out; p.ws = (unsigned char*)d_ws;
#if MK_MULTI
    for (int ph = 0; ph < NPHASE; ++ph) for (int rep = 0; rep <= ((DUP_MASK >> ph) & 1); ++rep) { p.ph_lo = ph; p.ph_hi = ph + 1; p.dup = rep; hipLaunchKernelGGL(mega, dim3(grid), dim3(NTHREADS), LDS_BYTES, stream, p); }
#else
    p.ph_lo = 0; p.ph_hi = NPHASE;
#if MK_CGSYNC
    void* args[] = {&p};
    hipError_t e = hipLaunchCooperativeKernel((void*)mega, dim3(grid), dim3(NTHREADS), args, LDS_BYTES, stream);
    if (e != hipSuccess) fprintf(stderr, "cooperative launch failed: %s (grid %d)\n", hipGetErrorString(e), grid);
#else
    (void)hipMemsetAsync((char*)d_ws + WS_BAR, 0, XCD_BAR_WORDS * 4, stream);
    hipLaunchKernelGGL(mega, dim3(grid), dim3(NTHREADS), LDS_BYTES, stream, p);
#endif
#endif
}
```
